# Optimizing an MI355X kernel written in HIP

```python
import functools
import jax, jax.numpy as jnp
from jax import lax
import numpy as np

D_MODEL = 1024
BATCH = 4
SEQ = 4096
DEPTH = 1
DEC_BATCH = 128
DEC_SEQ = 4
PAST_LEN = 8192
PAGE_SIZE = 128

MIX_WIDTH = D_MODEL
HEAD_DIM = 64
RWKV_WIDTH = MIX_WIDTH // 2
RWKV_HEADS = RWKV_WIDTH // HEAD_DIM
ATTN_WIDTH = MIX_WIDTH - RWKV_WIDTH
ATTN_HEADS = ATTN_WIDTH // HEAD_DIM
KV_HEADS = 2
GROUP = ATTN_HEADS // KV_HEADS
DECAY_LORA = 64
AAA_LORA = 64
GATE_LORA = 128
N_RW_COLS = 3 * RWKV_WIDTH + DECAY_LORA + AAA_LORA + GATE_LORA
N_IN_COLS = N_RW_COLS + ATTN_WIDTH + 2 * KV_HEADS * HEAD_DIM
LNX_EPS = 64e-5
WINDOW = 128
ATT_BLOCK = 128
ATTN_SCALE = HEAD_DIM ** -0.5
ROPE_THETA = 500000.0
ROT_DIM = HEAD_DIM // 4
N_META = 16
N_KEYS = 128
N_EXPERTS = N_KEYS * N_KEYS
PEER_HEADS = 8
PEER_TOPK = 16
D_KEY = 256
D_HALF = D_KEY // 2
PEER_BLOCK = 256
NORM_EPS = 1e-5
NEG_INF = -1e30
F32 = jnp.float32

kernel_name = 'hymba_rwkv7_swa_sink_peer_step'


def rmsnorm(x, g):
    xf = x.astype(F32)
    y = xf * lax.rsqrt(jnp.mean(xf * xf, axis=-1, keepdims=True) + NORM_EPS)
    return (y * g.astype(F32)).astype(x.dtype)


def rope_partial(x, pos):
    half = ROT_DIM // 2
    inv_freq = ROPE_THETA ** (-jnp.arange(0, ROT_DIM, 2, dtype=F32) / ROT_DIM)
    ang = pos.astype(F32)[:, None] * inv_freq[None, :]
    cos = jnp.cos(ang)[None, :, None, :]
    sin = jnp.sin(ang)[None, :, None, :]
    xr = x[..., :ROT_DIM].astype(F32)
    x1, x2 = xr[..., :half], xr[..., half:]
    rot = jnp.concatenate([x1 * cos - x2 * sin, x2 * cos + x1 * sin], axis=-1).astype(x.dtype)
    return jnp.concatenate([rot, x[..., ROT_DIM:]], axis=-1)


def sink_probs(scores, mask, sinks):
    s = jnp.where(mask, scores, NEG_INF)
    sk = sinks.astype(F32)[:, :, None, None]
    m = jnp.maximum(jnp.max(s, axis=-1, keepdims=True), sk)
    p = jnp.exp(s - m)
    return p / (jnp.sum(p, axis=-1, keepdims=True) + jnp.exp(sk - m))


def attend_banded(q, k, v, sinks):
    B, L = q.shape[:2]
    front = (-L) % ATT_BLOCK
    n_blk = (L + front) // ATT_BLOCK
    padw = ((0, 0), (front, 0), (0, 0), (0, 0))
    qb = jnp.pad(q, padw).reshape(B, n_blk, ATT_BLOCK, KV_HEADS, GROUP, HEAD_DIM)
    kb = jnp.pad(k, padw).reshape(B, n_blk, ATT_BLOCK, KV_HEADS, HEAD_DIM)
    vb = jnp.pad(v, padw).reshape(B, n_blk, ATT_BLOCK, KV_HEADS, HEAD_DIM)
    prev = lambda t: jnp.pad(t, ((0, 0), (1, 0), (0, 0), (0, 0), (0, 0)))[:, :-1]
    keys = jnp.concatenate([prev(kb), kb], axis=2)
    vals = jnp.concatenate([prev(vb), vb], axis=2)
    qpos = (jnp.arange(L + front) - front).reshape(n_blk, ATT_BLOCK)
    kpos = jnp.concatenate([qpos - ATT_BLOCK, qpos], axis=1)
    dlt = qpos[:, :, None] - kpos[:, None, :]
    mask = (kpos[:, None, :] >= 0) & (dlt >= 0) & (dlt < WINDOW)
    scores = jnp.einsum('bnqkgd,bnskd->bnkgqs', qb, keys).astype(F32) * ATTN_SCALE
    p = sink_probs(scores, mask[None, :, None, None], sinks.reshape(KV_HEADS, GROUP))
    out = jnp.einsum('bnkgqs,bnskd->bnqkgd', p.astype(v.dtype), vals)
    out = out.reshape(B, L + front, ATTN_WIDTH)[:, front:]
    keep = min(WINDOW, L)
    return out, k[:, L - keep:], v[:, L - keep:]


def attend_window(q, k, v, sinks, k_buf, v_buf):
    B, S = q.shape[:2]
    wb = k_buf.shape[1]
    keys = jnp.concatenate([k_buf.astype(k.dtype), k], axis=1)
    vals = jnp.concatenate([v_buf.astype(v.dtype), v], axis=1)
    qpos = PAST_LEN + jnp.arange(S)
    kpos = jnp.concatenate([PAST_LEN - wb + jnp.arange(wb), qpos])
    dlt = qpos[:, None] - kpos[None, :]
    mask = (dlt >= 0) & (dlt < WINDOW)
    qg = q.reshape(B, S, KV_HEADS, GROUP, HEAD_DIM)
    scores = jnp.einsum('bqkgd,bskd->bkgqs', qg, keys).astype(F32) * ATTN_SCALE
    p = sink_probs(scores, mask, sinks.reshape(KV_HEADS, GROUP))
    out = jnp.einsum('bkgqs,bskd->bqkgd', p.astype(v.dtype), vals).reshape(B, S, ATTN_WIDTH)
    return out, keys[:, -wb:], vals[:, -wb:]


def wkv7_scan(r, decay, k, v, a_vec, b_vec, s0):
    def step(S, inp):
        r_t, w_t, k_t, v_t, a_t, b_t = inp
        sa = jnp.einsum('bhij,bhj->bhi', S, a_t)
        S = S * w_t[:, :, None, :] + sa[..., :, None] * b_t[:, :, None, :] + v_t[..., :, None] * k_t[:, :, None, :]
        y = jnp.einsum('bhij,bhj->bhi', S, r_t)
        return S, y
    xs = tuple(jnp.moveaxis(t, 1, 0) for t in (r, decay, k, v, a_vec, b_vec))
    S, ys = lax.scan(step, s0, xs)
    return jnp.moveaxis(ys, 0, 1), S


def rwkv7_time_mix(p, p_prev_row, s0, lp):
    B, T, _ = p.shape
    p_prev = jnp.concatenate([p_prev_row[:, None, :].astype(p.dtype), p[:, :-1]], axis=1)
    m = (p + (p_prev - p) * lp['mu_shift']).astype(F32)
    c = RWKV_WIDTH
    cuts = [c, 2 * c, 3 * c, 3 * c + DECAY_LORA, 3 * c + DECAY_LORA + AAA_LORA]
    xr, xk, xv, xw, xa, xg = jnp.split(m, cuts, axis=-1)
    w = -jax.nn.softplus(-(lp['w0'] + jnp.tanh(xw) @ lp['w_lora_w2'])) - 0.5
    decay = jnp.exp(-jnp.exp(w))
    a = jax.nn.sigmoid(lp['a0'] + xa @ lp['w_lora_a2'])
    g = jax.nn.sigmoid(xg) @ lp['w_lora_g2']
    heads = lambda t: t.reshape(B, T, RWKV_HEADS, HEAD_DIM)
    kk = heads(xk * lp['k_k'])
    kk = kk / jnp.maximum(jnp.sqrt(jnp.sum(kk * kk, axis=-1, keepdims=True)), 1e-12)
    kmod = xk * (1.0 + (a - 1.0) * lp['k_a'])
    r_h, k_h, v_h, a_h = heads(xr), heads(kmod), heads(xv), heads(a)
    y, S = wkv7_scan(r_h, heads(decay), k_h, v_h, -kk, kk * a_h, s0.astype(F32))
    mean = jnp.mean(y, axis=-1, keepdims=True)
    var = jnp.mean(jnp.square(y - mean), axis=-1, keepdims=True)
    y = ((y - mean) * lax.rsqrt(var + LNX_EPS)).reshape(B, T, RWKV_WIDTH) * lp['lnx_w'] + lp['lnx_b']
    y = y + (jnp.sum(r_h * k_h * lp['r_k'], axis=-1, keepdims=True) * v_h).reshape(B, T, RWKV_WIDTH)
    y = y * g
    return y.astype(p.dtype), S


def peer(h, lp):
    shp = h.shape
    t = h.reshape(-1, D_MODEL)
    n = t.shape[0]
    n_blk = -(-n // PEER_BLOCK)
    blocks = jnp.pad(t, ((0, n_blk * PEER_BLOCK - n), (0, 0))).reshape(n_blk, PEER_BLOCK, D_MODEL)
    w_query, sub_keys, eu, ev = lp['w_query'], lp['sub_keys'], lp['expert_u'], lp['expert_v']

    def block(hb):
        q = (hb @ w_query).reshape(PEER_BLOCK, PEER_HEADS, 2, D_HALF).astype(F32)
        s = jnp.einsum('thcd,cnd->thcn', q, sub_keys.astype(F32))
        s1, i1 = lax.top_k(s[:, :, 0], PEER_TOPK)
        s2, i2 = lax.top_k(s[:, :, 1], PEER_TOPK)
        cand = (s1[..., :, None] + s2[..., None, :]).reshape(PEER_BLOCK, PEER_HEADS, PEER_TOPK * PEER_TOPK)
        cidx = (i1[..., :, None] * N_KEYS + i2[..., None, :]).reshape(PEER_BLOCK, PEER_HEADS, PEER_TOPK * PEER_TOPK)
        top, sel = lax.top_k(cand, PEER_TOPK)
        idx = jnp.take_along_axis(cidx, sel, axis=-1).reshape(PEER_BLOCK, PEER_HEADS * PEER_TOPK)
        gate = jax.nn.softmax(top, axis=-1).reshape(PEER_BLOCK, PEER_HEADS * PEER_TOPK)
        pre = jnp.einsum('td,tkd->tk', hb, eu[idx]).astype(F32)
        act = jax.nn.gelu(pre, approximate=False) * gate
        return jnp.einsum('tk,tkd->td', act.astype(hb.dtype), ev[idx])

    out = lax.map(block, blocks).reshape(-1, D_MODEL)[:n]
    return out.reshape(shp)


def trunk_layer(x, pos, prev_h, s0, attend, lp):
    B, T = x.shape[:2]
    h = rmsnorm(x, lp['norm1_g'])
    proj = h @ lp['w_in']
    prev_proj = prev_h.astype(h.dtype) @ lp['w_in'][:, :N_RW_COLS]
    y_rw, s_new = rwkv7_time_mix(proj[..., :N_RW_COLS], prev_proj, s0, lp)
    o = N_RW_COLS
    q = proj[..., o:o + ATTN_WIDTH].reshape(B, T, ATTN_HEADS, HEAD_DIM)
    o += ATTN_WIDTH
    k = proj[..., o:o + KV_HEADS * HEAD_DIM].reshape(B, T, KV_HEADS, HEAD_DIM)
    o += KV_HEADS * HEAD_DIM
    v = proj[..., o:o + KV_HEADS * HEAD_DIM].reshape(B, T, KV_HEADS, HEAD_DIM)
    q = rope_partial(q, pos)
    k = rope_partial(k, pos)
    y_at, k_keep, v_keep = attend(q, k, v, lp['attn_sinks'])
    x = x + jnp.concatenate([y_rw, y_at], axis=-1) @ lp['w_out']
    x = x + peer(rmsnorm(x, lp['norm2_g']), lp)
    return x, (k_keep, v_keep, s_new, h[:, -1])


def setup_inputs(seed: int = 0) -> dict:
    key = jax.random.key(seed)
    ks = jax.random.split(key, 28)
    nrm = lambda k, shp, sc: jax.random.normal(k, shp, F32) * sc
    wb = min(WINDOW, PAST_LEN)
    return {
        'x_prompt': nrm(ks[0], (BATCH, SEQ, D_MODEL), 1.0),
        'x_sample': nrm(ks[1], (DEC_BATCH, DEC_SEQ, D_MODEL), 1.0),
        'cache_k_win': nrm(ks[2], (DEPTH, DEC_BATCH, wb, KV_HEADS, HEAD_DIM), 1.0),
        'cache_v_win': nrm(ks[3], (DEPTH, DEC_BATCH, wb, KV_HEADS, HEAD_DIM), 1.0),
        'state_wkv': nrm(ks[4], (DEPTH, DEC_BATCH, RWKV_HEADS, HEAD_DIM, HEAD_DIM), 0.1),
        'state_shift': nrm(ks[5], (DEPTH, DEC_BATCH, D_MODEL), 1.0),
        'meta_tokens': nrm(ks[6], (N_META, D_MODEL), 1.0),
        'norm1_g': 1.0 + nrm(ks[7], (DEPTH, D_MODEL), 0.02),
        'w_in': nrm(ks[8], (DEPTH, D_MODEL, N_IN_COLS), D_MODEL ** -0.5),
        'mu_shift': jax.random.uniform(ks[9], (DEPTH, N_RW_COLS), F32),
        'w0': jax.random.uniform(ks[10], (DEPTH, RWKV_WIDTH), F32, -6.0, -1.0),
        'w_lora_w2': nrm(ks[11], (DEPTH, DECAY_LORA, RWKV_WIDTH), 0.1),
        'a0': nrm(ks[12], (DEPTH, RWKV_WIDTH), 0.1),
        'w_lora_a2': nrm(ks[13], (DEPTH, AAA_LORA, RWKV_WIDTH), 0.1),
        'w_lora_g2': nrm(ks[14], (DEPTH, GATE_LORA, RWKV_WIDTH), GATE_LORA ** -0.5),
        'k_k': 0.85 + nrm(ks[15], (DEPTH, RWKV_WIDTH), 0.02),
        'k_a': 1.0 + nrm(ks[16], (DEPTH, RWKV_WIDTH), 0.02),
        'r_k': nrm(ks[17], (DEPTH, RWKV_HEADS, HEAD_DIM), 0.1),
        'lnx_w': 1.0 + nrm(ks[18], (DEPTH, RWKV_WIDTH), 0.02),
        'lnx_b': nrm(ks[19], (DEPTH, RWKV_WIDTH), 0.02),
        'attn_sinks': nrm(ks[20], (DEPTH, ATTN_HEADS), 0.5),
        'w_out': nrm(ks[21], (DEPTH, MIX_WIDTH, D_MODEL), MIX_WIDTH ** -0.5),
        'norm2_g': 1.0 + nrm(ks[22], (DEPTH, D_MODEL), 0.02),
        'w_query': nrm(ks[23], (DEPTH, D_MODEL, PEER_HEADS * D_KEY), D_MODEL ** -0.5),
        'sub_keys': nrm(ks[24], (DEPTH, 2, N_KEYS, D_HALF), D_HALF ** -0.5),
        'expert_u': nrm(ks[25], (DEPTH, N_EXPERTS, D_MODEL), D_MODEL ** -0.5),
        'expert_v': nrm(ks[26], (DEPTH, N_EXPERTS, D_MODEL), 0.2),
        'final_norm_g': 1.0 + nrm(ks[27], (D_MODEL,), 0.02),
    }


def reference(x_prompt, x_sample, cache_k_win, cache_v_win, state_wkv, state_shift, meta_tokens, norm1_g, w_in, mu_shift, w0, w_lora_w2, a0, w_lora_a2, w_lora_g2, k_k, k_a, r_k, lnx_w, lnx_b, attn_sinks, w_out, norm2_g, w_query, sub_keys, expert_u, expert_v, final_norm_g):
    B = x_prompt.shape[0]
    meta = jnp.broadcast_to(meta_tokens[None].astype(x_prompt.dtype), (B, N_META, D_MODEL))
    xp = jnp.concatenate([meta, x_prompt], axis=1)
    xs = x_sample
    pos_p = jnp.arange(N_META + x_prompt.shape[1])
    pos_s = PAST_LEN + jnp.arange(x_sample.shape[1])
    new_p = []
    new_s = []
    for l in range(DEPTH):
        lp = dict(norm1_g=norm1_g[l], w_in=w_in[l], mu_shift=mu_shift[l], w0=w0[l], w_lora_w2=w_lora_w2[l],
                  a0=a0[l], w_lora_a2=w_lora_a2[l], w_lora_g2=w_lora_g2[l], k_k=k_k[l], k_a=k_a[l], r_k=r_k[l],
                  lnx_w=lnx_w[l], lnx_b=lnx_b[l], attn_sinks=attn_sinks[l], w_out=w_out[l], norm2_g=norm2_g[l],
                  w_query=w_query[l], sub_keys=sub_keys[l], expert_u=expert_u[l], expert_v=expert_v[l])
        xp, st_p = trunk_layer(xp, pos_p, jnp.zeros((B, D_MODEL), xp.dtype),
                               jnp.zeros((B, RWKV_HEADS, HEAD_DIM, HEAD_DIM), F32), attend_banded, lp)
        xs, st_s = trunk_layer(xs, pos_s, state_shift[l], state_wkv[l],
                               functools.partial(attend_window, k_buf=cache_k_win[l], v_buf=cache_v_win[l]), lp)
        new_p.append(st_p)
        new_s.append(st_s)
    stk = lambda sts, i: jnp.stack([st[i] for st in sts], axis=0)
    y_prompt = rmsnorm(xp, final_norm_g)[:, N_META:]
    y_sample = rmsnorm(xs, final_norm_g)
    return (y_prompt, y_sample,
            stk(new_p, 0), stk(new_p, 1), stk(new_p, 2).astype(state_wkv.dtype), stk(new_p, 3),
            stk(new_s, 0), stk(new_s, 1), stk(new_s, 2).astype(state_wkv.dtype), stk(new_s, 3))
```

```cpp
#include <hip/hip_runtime.h>
#include <hip/hip_cooperative_groups.h>
#include <cstdio>
#include <cstdint>
namespace cg = cooperative_groups;

typedef unsigned short u16;
using bf16x8 = __attribute__((ext_vector_type(8))) short;
using f32x4 = __attribute__((ext_vector_type(4))) float;
using half2v = __attribute__((ext_vector_type(2))) _Float16;

#ifndef MULTI_LAUNCH
#define MULTI_LAUNCH 0
#endif

constexpr int D = 1024, NIN = 2560;
constexpr int LP = 4112, NB = 4, TP = NB * LP;
constexpr int SB = 128, TS = 512;
constexpr int TTOK = TP + TS;
constexpr int PREV0 = TTOK;
constexpr int MROWS = 17152;
constexpr int TPAD = 17024;
constexpr int NOUT = 16896;
constexpr int PAST = 8192;
constexpr int NPH = 11;

constexpr size_t O_YP = 0;
constexpr size_t O_KWP = 17301504, O_VWP = 17367040, O_WKVP = 17432576, O_SHP = 17563648;
constexpr size_t O_KWS = 17567744, O_VWS = 19664896, O_WKVS = 21762048, O_SHS = 25956352;

constexpr size_t WS_WIN = 0;
constexpr size_t WS_WOUT = WS_WIN + 2560ull * 1024 * 2;
constexpr size_t WS_WQ = WS_WOUT + 1024ull * 1024 * 2;
constexpr size_t WS_SUBK = WS_WQ + 2048ull * 1024 * 2;
constexpr size_t WS_W2W = WS_SUBK + 2ull * 128 * 128 * 2;
constexpr size_t WS_W2A = WS_W2W + 512ull * 64 * 2;
constexpr size_t WS_W2G = WS_W2A + 512ull * 64 * 2;
constexpr size_t WS_B = WS_W2G + 512ull * 128 * 2;
constexpr size_t WS_C = WS_B + (size_t)MROWS * 1024 * 2;
constexpr size_t WS_D = WS_C + (size_t)MROWS * NIN * 2;
constexpr size_t WS_E = WS_D + (size_t)TPAD * 512 * 8;
constexpr size_t WS_END = WS_E + (size_t)TPAD * 512 * 4;
constexpr size_t WS_DEC = WS_D, WS_A = WS_D + (size_t)TPAD * 512 * 4, WS_G = WS_A + (size_t)TPAD * 512 * 2;
constexpr size_t WS_EU = WS_D, WS_EV = WS_D + 16384ull * 1024 * 2;
constexpr size_t WS_Q = WS_C, WS_IDX = WS_C + (size_t)NOUT * 2048 * 2, WS_GATE = WS_IDX + (size_t)NOUT * 128 * 4;
static_assert(WS_EV + 16384ull * 1024 * 2 <= WS_E, "expert tables overflow region D");
static_assert(WS_GATE + (size_t)NOUT * 128 * 4 <= WS_D, "idx/gate overflow region C");
static_assert(WS_END <= 256ull * 1024 * 1024, "workspace too large");

constexpr int SMEM_BYTES = 36864;

struct Params {
  const float *x_prompt, *x_sample, *cache_k, *cache_v, *state_wkv, *state_shift, *meta, *norm1_g, *w_in, *mu, *w0,
      *w2w, *a0, *w2a, *w2g, *k_k, *k_a, *r_k, *lnx_w, *lnx_b, *sinks, *w_out, *norm2_g, *w_query, *sub_keys, *eu,
      *ev, *final_g;
  float* out;
  char* ws;
};

__constant__ double INVF[8] = {1.0, 0.19392274474868576, 0.03760603093086393, 0.007292664737217109,
                               0.001414213562373095, 0.0002742481756762073, 5.318295896944988e-05,
                               1.031338537721246e-05};

__device__ __forceinline__ u16 f2bf(float f) {
  unsigned u = __float_as_uint(f);
  u += 0x7fffu + ((u >> 16) & 1u);
  return (u16)(u >> 16);
}
__device__ __forceinline__ float bf2f(u16 h) { return __uint_as_float(((unsigned)h) << 16); }
__device__ __forceinline__ float bflo(unsigned u) { return __uint_as_float(u << 16); }
__device__ __forceinline__ float bfhi(unsigned u) { return __uint_as_float(u & 0xffff0000u); }
__device__ __forceinline__ unsigned pack2bf(float a, float b) { return (unsigned)f2bf(a) | ((unsigned)f2bf(b) << 16); }
__device__ __forceinline__ u16 f2h(float f) {
  _Float16 h = (_Float16)f;
  return __builtin_bit_cast(u16, h);
}

template <int CTRL>
__device__ __forceinline__ float dppf(float x) {
  return __int_as_float(__builtin_amdgcn_update_dpp(0, __float_as_int(x), CTRL, 0xF, 0xF, false));
}
__device__ __forceinline__ float red4(float x) {
  x += dppf<0xB1>(x);
  x += dppf<0x4E>(x);
  return x;
}
__device__ __forceinline__ float red8(float x) {
  x = red4(x);
  x += dppf<0x141>(x);
  return x;
}
__device__ __forceinline__ float red16(float x) {
  x = red8(x);
  x += dppf<0x140>(x);
  return x;
}
__device__ __forceinline__ float redmax16(float x) {
  x = fmaxf(x, dppf<0xB1>(x));
  x = fmaxf(x, dppf<0x4E>(x));
  x = fmaxf(x, dppf<0x141>(x));
  x = fmaxf(x, dppf<0x140>(x));
  return x;
}
__device__ __forceinline__ float rdlane(float x, int l) {
  return __int_as_float(__builtin_amdgcn_readlane(__float_as_int(x), l));
}
__device__ __forceinline__ float wave_sum(float x) {
  x = red16(x);
  return rdlane(x, 0) + rdlane(x, 16) + rdlane(x, 32) + rdlane(x, 48);
}
__device__ __forceinline__ f32x4 mfma16(bf16x8 a, bf16x8 b, f32x4 c) {
  return __builtin_amdgcn_mfma_f32_16x16x32_bf16(a, b, c, 0, 0, 0);
}
__device__ __forceinline__ float sigmoidf_(float x) { return 1.f / (1.f + __expf(-x)); }

template <class Epi>
__device__ __forceinline__ void gemm_tile(const u16* __restrict__ A, int lda, const u16* __restrict__ Bt, int ldb, int K,
                                          char* smem, Epi epi) {
  const int tid = threadIdx.x, wid = tid >> 6, lane = tid & 63, wr = wid >> 1, wc = wid & 1, fr = lane & 15,
            fq = lane >> 4;
  u16* SA = (u16*)smem;
  u16* SB = SA + 128 * 32;
  f32x4 acc[4][4];
#pragma unroll
  for (int m = 0; m < 4; ++m)
#pragma unroll
    for (int n = 0; n < 4; ++n) acc[m][n] = f32x4{0.f, 0.f, 0.f, 0.f};
  const int nk = K / 32;
  for (int kt = 0; kt < nk; ++kt) {
#pragma unroll
    for (int i = 0; i < 2; ++i) {
      int b = tid * 16 + i * 4096, r = b / 64, c = (b % 64) / 2;
      __builtin_amdgcn_global_load_lds((const unsigned*)(A + (size_t)r * lda + kt * 32 + c),
                                       (__attribute__((address_space(3))) unsigned*)((char*)SA + b), 16, 0, 0);
      __builtin_amdgcn_global_load_lds((const unsigned*)(Bt + (size_t)r * ldb + kt * 32 + c),
                                       (__attribute__((address_space(3))) unsigned*)((char*)SB + b), 16, 0, 0);
    }
    asm volatile("s_waitcnt vmcnt(0)" ::: "memory");
    __syncthreads();
    bf16x8 At[4], Bl[4];
#pragma unroll
    for (int m = 0; m < 4; ++m) At[m] = *(const bf16x8*)((const char*)SA + (wr * 64 + m * 16 + fr) * 64 + fq * 16);
#pragma unroll
    for (int n = 0; n < 4; ++n) Bl[n] = *(const bf16x8*)((const char*)SB + (wc * 64 + n * 16 + fr) * 64 + fq * 16);
#pragma unroll
    for (int m = 0; m < 4; ++m)
#pragma unroll
      for (int n = 0; n < 4; ++n) acc[m][n] = mfma16(At[m], Bl[n], acc[m][n]);
    __syncthreads();
  }
#pragma unroll
  for (int m = 0; m < 4; ++m)
#pragma unroll
    for (int n = 0; n < 4; ++n)
#pragma unroll
      for (int j = 0; j < 4; ++j) epi(wr * 64 + m * 16 + fq * 4 + j, wc * 64 + n * 16 + fr, acc[m][n][j]);
}

__device__ void transpose_task(const float* __restrict__ src, int K, int N, u16* __restrict__ dst, int tile, char* smem) {
  const int tid = threadIdx.x;
  int tn = N / 64;
  int k0 = (tile / tn) * 64, n0 = (tile % tn) * 64;
  float* t = (float*)smem;
#pragma unroll 4
  for (int it = 0; it < 16; ++it) {
    int k = it * 4 + (tid >> 6), n = tid & 63;
    t[n * 65 + k] = src[(size_t)(k0 + k) * N + n0 + n];
  }
  __syncthreads();
#pragma unroll 4
  for (int it = 0; it < 16; ++it) {
    int n = it * 4 + (tid >> 6), k = tid & 63;
    dst[(size_t)(n0 + n) * K + k0 + k] = f2bf(t[n * 65 + k]);
  }
  __syncthreads();
}

__device__ void norm1_task(const Params& p, int task) {
  const int wave = threadIdx.x >> 6, lane = threadIdx.x & 63;
  int row = task * 4 + wave;
  u16* h = (u16*)(p.ws + WS_B) + (size_t)row * D;
  const float* src = nullptr;
  bool donorm = true;
  float* shout = nullptr;
  if (row < TP) {
    int b = row / LP, t = row % LP;
    src = (t < 16) ? p.meta + (size_t)t * D : p.x_prompt + ((size_t)b * 4096 + (t - 16)) * D;
    if (t == LP - 1) shout = p.out + O_SHP + (size_t)b * D;
  } else if (row < TTOK) {
    int r = row - TP;
    src = p.x_sample + (size_t)r * D;
    if ((r & 3) == 3) shout = p.out + O_SHS + (size_t)(r >> 2) * D;
  } else if (row < TTOK + SB) {
    src = p.state_shift + (size_t)(row - TTOK) * D;
    donorm = false;
  }
  if (!src) {
#pragma unroll
    for (int i = 0; i < 4; ++i) *(uint2*)(h + (i * 64 + lane) * 4) = uint2{0u, 0u};
    return;
  }
  float4 v[4];
  float ss = 0.f;
#pragma unroll
  for (int i = 0; i < 4; ++i) {
    v[i] = ((const float4*)src)[i * 64 + lane];
    ss += v[i].x * v[i].x + v[i].y * v[i].y + v[i].z * v[i].z + v[i].w * v[i].w;
  }
  float sc = 1.f;
  if (donorm) {
    ss = wave_sum(ss);
    sc = rsqrtf(ss * (1.f / 1024.f) + 1e-5f);
  }
#pragma unroll
  for (int i = 0; i < 4; ++i) {
    float4 y = v[i];
    if (donorm) {
      float4 g = ((const float4*)p.norm1_g)[i * 64 + lane];
      y.x *= sc * g.x; y.y *= sc * g.y; y.z *= sc * g.z; y.w *= sc * g.w;
    }
    *(uint2*)(h + (i * 64 + lane) * 4) = uint2{pack2bf(y.x, y.y), pack2bf(y.z, y.w)};
    if (shout) ((float4*)shout)[i * 64 + lane] = y;
  }
}

__device__ void phase0(const Params& p, char* smem) {
  constexpr int N_NORM = MROWS / 4;
  constexpr int T_WIN = 16 * 40, T_WOUT = 16 * 16, T_WQ = 16 * 32, T_W2W = 8, T_W2A = 8, T_W2G = 16, T_SUBK = 32;
  constexpr int TOT = N_NORM + T_WIN + T_WOUT + T_WQ + T_W2W + T_W2A + T_W2G + T_SUBK;
  for (int task = blockIdx.x; task < TOT; task += gridDim.x) {
    int t = task;
    if (t < N_NORM) { norm1_task(p, t); continue; }
    t -= N_NORM;
    if (t < T_WIN) { transpose_task(p.w_in, 1024, 2560, (u16*)(p.ws + WS_WIN), t, smem); continue; }
    t -= T_WIN;
    if (t < T_WOUT) { transpose_task(p.w_out, 1024, 1024, (u16*)(p.ws + WS_WOUT), t, smem); continue; }
    t -= T_WOUT;
    if (t < T_WQ) { transpose_task(p.w_query, 1024, 2048, (u16*)(p.ws + WS_WQ), t, smem); continue; }
    t -= T_WQ;
    if (t < T_W2W) { transpose_task(p.w2w, 64, 512, (u16*)(p.ws + WS_W2W), t, smem); continue; }
    t -= T_W2W;
    if (t < T_W2A) { transpose_task(p.w2a, 64, 512, (u16*)(p.ws + WS_W2A), t, smem); continue; }
    t -= T_W2A;
    if (t < T_W2G) { transpose_task(p.w2g, 128, 512, (u16*)(p.ws + WS_W2G), t, smem); continue; }
    t -= T_W2G;
    {
      int e = (t * 256 + threadIdx.x) * 4;
      float4 v = *(const float4*)(p.sub_keys + e);
      *(uint2*)((u16*)(p.ws + WS_SUBK) + e) = uint2{pack2bf(v.x, v.y), pack2bf(v.z, v.w)};
    }
  }
}

__device__ void phase1(const Params& p, char* smem) {
  const u16* hbuf = (const u16*)(p.ws + WS_B);
  const u16* wt = (const u16*)(p.ws + WS_WIN);
  u16* proj = (u16*)(p.ws + WS_C);
  constexpr int NT = 20, MT = MROWS / 128;
  for (int tile = blockIdx.x; tile < MT * NT; tile += gridDim.x) {
    int mt = tile / NT, nt = tile % NT;
    u16* crow = proj + (size_t)mt * 128 * NIN + nt * 128;
    gemm_tile(hbuf + (size_t)mt * 128 * D, D, wt + (size_t)nt * 128 * D, D, D, smem,
              [&](int r, int c, float v) { crow[(size_t)r * NIN + c] = f2bf(v); });
  }
}

__device__ void prepass_task(const Params& p, int task) {
  const int wave = threadIdx.x >> 6, lane = threadIdx.x & 63;
  int row = task * 4 + wave;
  if (row >= TTOK) return;
  u16* proj = (u16*)(p.ws + WS_C);
  u16* act = (u16*)(p.ws + WS_E);
  bool isP = row < TP;
  int b, t, prow;
  float pos;
  if (isP) { b = row / LP; t = row % LP; prow = t > 0 ? row - 1 : -1; pos = (float)t; }
  else { int r = row - TP; b = r >> 2; t = r & 3; prow = t > 0 ? row - 1 : PREV0 + b; pos = (float)(PAST + t); }
  u16* pr = proj + (size_t)row * NIN;
  const u16* pp = prow >= 0 ? proj + (size_t)prow * NIN : nullptr;
  {
    int c = 1536 + lane * 4;
    uint2 a = *(const uint2*)(pr + c);
    uint2 bq = pp ? *(const uint2*)(pp + c) : uint2{0u, 0u};
    float4 mu = *(const float4*)(p.mu + c);
    float x[4] = {bflo(a.x), bfhi(a.x), bflo(a.y), bfhi(a.y)};
    float xp[4] = {bflo(bq.x), bfhi(bq.x), bflo(bq.y), bfhi(bq.y)};
    float mm[4] = {mu.x, mu.y, mu.z, mu.w};
    float o[4];
#pragma unroll
    for (int i = 0; i < 4; ++i) {
      float m = x[i] + (xp[i] - x[i]) * mm[i];
      float r;
      if (lane < 16) r = tanhf(m);
      else if (lane < 32) r = m;
      else r = sigmoidf_(m);
      o[i] = r;
    }
    *(uint2*)(act + (size_t)row * 256 + lane * 4) = uint2{pack2bf(o[0], o[1]), pack2bf(o[2], o[3])};
  }
  float* kwin = nullptr;
  float* vwin = nullptr;
  if (isP) {
    if (t >= LP - 128) {
      kwin = p.out + O_KWP + ((size_t)b * 128 + (t - (LP - 128))) * 128;
      vwin = p.out + O_VWP + ((size_t)b * 128 + (t - (LP - 128))) * 128;
    }
  } else {
    kwin = p.out + O_KWS + ((size_t)b * 128 + 124 + t) * 128;
    vwin = p.out + O_VWS + ((size_t)b * 128 + 124 + t) * 128;
  }
  for (int it = lane; it < 80; it += 64) {
    int hh = it >> 3, d = it & 7;
    int col = 1792 + hh * 64 + d;
    float x1 = bf2f(pr[col]), x2 = bf2f(pr[col + 8]);
    double rev = (double)pos * INVF[d] * 0.15915494309189535;
    float fr = (float)(rev - floor(rev));
    float sn = __builtin_amdgcn_sinf(fr), cs = __builtin_amdgcn_cosf(fr);
    float r1 = x1 * cs - x2 * sn, r2 = x2 * cs + x1 * sn;
    pr[col] = f2bf(r1);
    pr[col + 8] = f2bf(r2);
    if (hh >= 8 && kwin) {
      kwin[(hh - 8) * 64 + d] = r1;
      kwin[(hh - 8) * 64 + d + 8] = r2;
    }
  }
  if (kwin) {
#pragma unroll
    for (int i = 0; i < 2; ++i) {
      int idx = lane * 2 + i;
      if ((idx & 63) >= 16) kwin[idx] = bf2f(pr[2304 + idx]);
      vwin[idx] = bf2f(pr[2432 + idx]);
    }
  }
}

__device__ void phase2(const Params& p) {
  constexpr int N_PRE = TTOK / 4;
  constexpr int N_CP = 256;
  for (int task = blockIdx.x; task < N_PRE + N_CP; task += gridDim.x) {
    if (task < N_PRE) { prepass_task(p, task); continue; }
    int t = task - N_PRE;
    int which = t >> 7, b = t & 127;
    const float4* src = (const float4*)((which ? p.cache_v : p.cache_k) + (size_t)b * 16384 + 512);
    float4* dst = (float4*)(p.out + (which ? O_VWS : O_KWS) + (size_t)b * 16384);
    for (int i = threadIdx.x; i < 3968; i += 256) dst[i] = src[i];
  }
}

__device__ void phase3(const Params& p, char* smem) {
  const u16* act = (const u16*)(p.ws + WS_E);
  float* dec = (float*)(p.ws + WS_DEC);
  u16* ab = (u16*)(p.ws + WS_A);
  u16* gb = (u16*)(p.ws + WS_G);
  constexpr int MT = TPAD / 128;
  for (int tile = blockIdx.x; tile < MT * 12; tile += gridDim.x) {
    int which = tile % 3, rest = tile / 3;
    int nt = rest & 3, mt = rest >> 2;
    size_t r0 = (size_t)mt * 128;
    int c0 = nt * 128;
    if (which == 0) {
      gemm_tile(act + r0 * 256, 256, (const u16*)(p.ws + WS_W2W) + (size_t)c0 * 64, 64, 64, smem,
                [&](int r, int c, float v) {
                  float lw = p.w0[c0 + c] + v;
                  float nx = -lw;
                  float sp = fmaxf(nx, 0.f) + log1pf(__expf(-fabsf(nx)));
                  float w = -sp - 0.5f;
                  dec[(r0 + r) * 512 + c0 + c] = __expf(-__expf(w));
                });
    } else if (which == 1) {
      gemm_tile(act + r0 * 256 + 64, 256, (const u16*)(p.ws + WS_W2A) + (size_t)c0 * 64, 64, 64, smem,
                [&](int r, int c, float v) { ab[(r0 + r) * 512 + c0 + c] = f2bf(sigmoidf_(p.a0[c0 + c] + v)); });
    } else {
      gemm_tile(act + r0 * 256 + 128, 256, (const u16*)(p.ws + WS_W2G) + (size_t)c0 * 128, 128, 128, smem,
                [&](int r, int c, float v) { gb[(r0 + r) * 512 + c0 + c] = f2bf(v); });
    }
  }
}

__device__ void scan_task(const Params& p, char* smem, int rowbase, int T, int prevrow, int h, int rg,
                          const float* __restrict__ s_in, float* __restrict__ s_out) {
  const int tid = threadIdx.x, wave = tid >> 6, lane = tid & 63, l16 = lane & 15;
  const int il = wave * 4 + (lane >> 4), i = rg * 16 + il, j0 = l16 * 4;
  const u16* proj = (const u16*)(p.ws + WS_C);
  const float* dec = (const float*)(p.ws + WS_DEC);
  const u16* ab = (const u16*)(p.ws + WS_A);
  float* yraw = (float*)(p.ws + WS_E);
  float* buf = (float*)smem;
  float* ybuf = (float*)(smem + 24576);
  float S0 = 0.f, S1 = 0.f, S2 = 0.f, S3 = 0.f;
  if (s_in) {
    float4 s = *(const float4*)(s_in + i * 64 + j0);
    S0 = s.x; S1 = s.y; S2 = s.z; S3 = s.w;
  }
  const int tt = tid >> 4, cgp = tid & 15, col = h * 64 + cgp * 4;
  const float4 mu_r = *(const float4*)(p.mu + col), mu_k = *(const float4*)(p.mu + 512 + col),
               mu_v = *(const float4*)(p.mu + 1024 + col);
  const float4 kkw = *(const float4*)(p.k_k + col), kaw = *(const float4*)(p.k_a + col);
  const int nchunk = (T + 15) >> 4;
  uint2 rr = {0, 0}, rk = {0, 0}, rv = {0, 0}, qr = {0, 0}, qk = {0, 0}, qv = {0, 0}, av = {0, 0};
  float4 dc = {0, 0, 0, 0};
  auto issue = [&](int c) {
    int t = c * 16 + tt;
    if (t < T) {
      int row = rowbase + t;
      int prow = t > 0 ? row - 1 : prevrow;
      const u16* pr = proj + (size_t)row * NIN + col;
      rr = *(const uint2*)(pr);
      rk = *(const uint2*)(pr + 512);
      rv = *(const uint2*)(pr + 1024);
      if (prow >= 0) {
        const u16* pq = proj + (size_t)prow * NIN + col;
        qr = *(const uint2*)(pq);
        qk = *(const uint2*)(pq + 512);
        qv = *(const uint2*)(pq + 1024);
      } else {
        qr = uint2{0, 0}; qk = uint2{0, 0}; qv = uint2{0, 0};
      }
      dc = *(const float4*)(dec + (size_t)row * 512 + col);
      av = *(const uint2*)(ab + (size_t)row * 512 + col);
    }
  };
  issue(0);
  for (int c = 0; c < nchunk; ++c) {
    {
      float xr[4] = {bflo(rr.x), bfhi(rr.x), bflo(rr.y), bfhi(rr.y)};
      float xk[4] = {bflo(rk.x), bfhi(rk.x), bflo(rk.y), bfhi(rk.y)};
      float xv[4] = {bflo(rv.x), bfhi(rv.x), bflo(rv.y), bfhi(rv.y)};
      float pr_[4] = {bflo(qr.x), bfhi(qr.x), bflo(qr.y), bfhi(qr.y)};
      float pk_[4] = {bflo(qk.x), bfhi(qk.x), bflo(qk.y), bfhi(qk.y)};
      float pv_[4] = {bflo(qv.x), bfhi(qv.x), bflo(qv.y), bfhi(qv.y)};
      float aa[4] = {bflo(av.x), bfhi(av.x), bflo(av.y), bfhi(av.y)};
      float mur[4] = {mu_r.x, mu_r.y, mu_r.z, mu_r.w}, muk[4] = {mu_k.x, mu_k.y, mu_k.z, mu_k.w},
            muv[4] = {mu_v.x, mu_v.y, mu_v.z, mu_v.w};
      float kw[4] = {kkw.x, kkw.y, kkw.z, kkw.w}, ka[4] = {kaw.x, kaw.y, kaw.z, kaw.w};
      float kkv[4], ss = 0.f;
#pragma unroll
      for (int e = 0; e < 4; ++e) {
        xr[e] = xr[e] + (pr_[e] - xr[e]) * mur[e];
        xk[e] = xk[e] + (pk_[e] - xk[e]) * muk[e];
        xv[e] = xv[e] + (pv_[e] - xv[e]) * muv[e];
        kkv[e] = xk[e] * kw[e];
        ss += kkv[e] * kkv[e];
      }
      ss = red16(ss);
      float inv = 1.f / fmaxf(sqrtf(ss), 1e-12f);
      float4 o_r, o_w, o_k, o_a, o_b, o_v;
      float nk[4], kb[4], km[4];
#pragma unroll
      for (int e = 0; e < 4; ++e) {
        float kk = kkv[e] * inv;
        nk[e] = -kk;
        kb[e] = kk * aa[e];
        km[e] = xk[e] * (1.f + (aa[e] - 1.f) * ka[e]);
      }
      o_r = float4{xr[0], xr[1], xr[2], xr[3]};
      o_w = dc;
      o_k = float4{km[0], km[1], km[2], km[3]};
      o_a = float4{nk[0], nk[1], nk[2], nk[3]};
      o_b = float4{kb[0], kb[1], kb[2], kb[3]};
      o_v = float4{xv[0], xv[1], xv[2], xv[3]};
      float* bt = buf + tt * 384 + cgp * 4;
      *(float4*)(bt) = o_r;
      *(float4*)(bt + 64) = o_w;
      *(float4*)(bt + 128) = o_k;
      *(float4*)(bt + 192) = o_a;
      *(float4*)(bt + 256) = o_b;
      *(float4*)(bt + 320) = o_v;
    }
    __syncthreads();
    if (c + 1 < nchunk) issue(c + 1);
    int ntok = min(16, T - c * 16);
    for (int t2 = 0; t2 < ntok; ++t2) {
      const float* bt = buf + t2 * 384;
      float4 r4 = *(const float4*)(bt + j0), w4 = *(const float4*)(bt + 64 + j0), k4 = *(const float4*)(bt + 128 + j0),
             a4 = *(const float4*)(bt + 192 + j0), b4 = *(const float4*)(bt + 256 + j0);
      float vi = bt[320 + i];
      float sa = S0 * a4.x + S1 * a4.y + S2 * a4.z + S3 * a4.w;
      float t0 = S0 * w4.x + vi * k4.x, t1 = S1 * w4.y + vi * k4.y, t2_ = S2 * w4.z + vi * k4.z,
            t3 = S3 * w4.w + vi * k4.w;
      sa = red16(sa);
      S0 = t0 + sa * b4.x; S1 = t1 + sa * b4.y; S2 = t2_ + sa * b4.z; S3 = t3 + sa * b4.w;
      float y = S0 * r4.x + S1 * r4.y + S2 * r4.z + S3 * r4.w;
      y = red16(y);
      if (l16 == 0) ybuf[t2 * 16 + il] = y;
    }
    __syncthreads();
    {
      int t = c * 16 + tt;
      if (t < T) yraw[(size_t)(rowbase + t) * 512 + h * 64 + rg * 16 + cgp] = ybuf[tt * 16 + cgp];
    }
  }
  *(float4*)(s_out + i * 64 + j0) = float4{S0, S1, S2, S3};
  __syncthreads();
}

__device__ void attn_prompt_task(const Params& p, char* smem, int task) {
  const int tid = threadIdx.x, w = tid >> 6, lane = tid & 63, fr = lane & 15, fq = lane >> 4;
  int head = task & 7;
  int qt = (task >> 3) % 65;
  int b = task / (8 * 65);
  int kvh = head >> 2;
  u16* KV = (u16*)smem;
  u16* Ps = (u16*)(smem + 9216) + w * 16 * 200;
  const u16* projb = (const u16*)(p.ws + WS_C) + (size_t)b * LP * NIN;
  u16* mix = (u16*)(p.ws + WS_B);
  int q0 = qt * 64, kstart = q0 - 128;
  int qrow = min(q0 + w * 16 + fr, LP - 1);
  bf16x8 qa[2];
#pragma unroll
  for (int ks = 0; ks < 2; ++ks)
    qa[ks] = *(const bf16x8*)(projb + (size_t)qrow * NIN + 1792 + head * 64 + ks * 32 + fq * 8);
  f32x4 S[12];
#pragma unroll
  for (int i = 0; i < 12; ++i) S[i] = f32x4{0.f, 0.f, 0.f, 0.f};
#pragma unroll
  for (int kt = 0; kt < 3; ++kt) {
    {
      int key = tid >> 2, ch = tid & 3;
      int kp = min(max(kstart + kt * 64 + key, 0), LP - 1);
      const uint4* src = (const uint4*)(projb + (size_t)kp * NIN + 2304 + kvh * 64 + ch * 16);
      uint4 v0 = src[0], v1 = src[1];
      *(uint4*)(KV + key * 72 + ch * 16) = v0;
      *(uint4*)(KV + key * 72 + ch * 16 + 8) = v1;
    }
    __syncthreads();
#pragma unroll
    for (int n = 0; n < 4; ++n)
#pragma unroll
      for (int ks = 0; ks < 2; ++ks) {
        bf16x8 kb = *(const bf16x8*)(KV + (n * 16 + fr) * 72 + ks * 32 + fq * 8);
        S[kt * 4 + n] = mfma16(qa[ks], kb, S[kt * 4 + n]);
      }
    __syncthreads();
  }
  float sink = p.sinks[head];
#pragma unroll
  for (int j = 0; j < 4; ++j) {
    int qpos = q0 + w * 16 + fq * 4 + j;
    float mx = -1e30f;
#pragma unroll
    for (int T = 0; T < 12; ++T) {
      int kpos = kstart + T * 16 + fr;
      bool valid = (kpos >= 0) && (kpos <= qpos) && (qpos - kpos < 128);
      float s = valid ? S[T][j] * 0.125f : -1e30f;
      S[T][j] = s;
      mx = fmaxf(mx, s);
    }
    mx = redmax16(mx);
    mx = fmaxf(mx, sink);
    float sum = 0.f;
#pragma unroll
    for (int T = 0; T < 12; ++T) {
      float e = (S[T][j] > -1e29f) ? __expf(S[T][j] - mx) : 0.f;
      S[T][j] = e;
      sum += e;
    }
    sum = red16(sum) + __expf(sink - mx);
    float inv = 1.f / sum;
#pragma unroll
    for (int T = 0; T < 12; ++T) Ps[(fq * 4 + j) * 200 + T * 16 + fr] = f2bf(S[T][j] * inv);
  }
  f32x4 O[4];
#pragma unroll
  for (int i = 0; i < 4; ++i) O[i] = f32x4{0.f, 0.f, 0.f, 0.f};
#pragma unroll
  for (int kt = 0; kt < 3; ++kt) {
    {
      int key = tid >> 2, ch = tid & 3;
      int kp = min(max(kstart + kt * 64 + key, 0), LP - 1);
      const uint4* src = (const uint4*)(projb + (size_t)kp * NIN + 2432 + kvh * 64 + ch * 16);
      uint4 v0 = src[0], v1 = src[1];
      unsigned e[8] = {v0.x, v0.y, v0.z, v0.w, v1.x, v1.y, v1.z, v1.w};
#pragma unroll
      for (int i = 0; i < 8; ++i) {
        KV[(ch * 16 + 2 * i) * 72 + key] = (u16)(e[i] & 0xffffu);
        KV[(ch * 16 + 2 * i + 1) * 72 + key] = (u16)(e[i] >> 16);
      }
    }
    __syncthreads();
#pragma unroll
    for (int ks = 0; ks < 2; ++ks) {
      bf16x8 pa = *(const bf16x8*)(Ps + fr * 200 + kt * 64 + ks * 32 + fq * 8);
#pragma unroll
      for (int n = 0; n < 4; ++n) {
        bf16x8 vb = *(const bf16x8*)(KV + (n * 16 + fr) * 72 + ks * 32 + fq * 8);
        O[n] = mfma16(pa, vb, O[n]);
      }
    }
    __syncthreads();
  }
#pragma unroll
  for (int n = 0; n < 4; ++n)
#pragma unroll
    for (int j = 0; j < 4; ++j) {
      int q = q0 + w * 16 + fq * 4 + j;
      if (q < LP) mix[((size_t)(b * LP + q)) * 1024 + 512 + head * 64 + n * 16 + fr] = f2bf(O[n][j]);
    }
}

__device__ void attn_sample_task(const Params& p, char* smem, int task) {
  const int tid = threadIdx.x;
  int b = task >> 1, kvh = task & 1;
  const u16* proj = (const u16*)(p.ws + WS_C);
  u16* mix = (u16*)(p.ws + WS_B);
  float* Qs = (float*)smem;
  float* Sc = Qs + 1024;
  {
    int qr = tid >> 4, d4 = (tid & 15) * 4, g = qr >> 2, s = qr & 3;
    const u16* src = proj + (size_t)(TP + b * 4 + s) * NIN + 1792 + (kvh * 4 + g) * 64 + d4;
    uint2 v = *(const uint2*)src;
    *(float4*)(Qs + qr * 64 + d4) = float4{bflo(v.x) * 0.125f, bfhi(v.x) * 0.125f, bflo(v.y) * 0.125f, bfhi(v.y) * 0.125f};
  }
  __syncthreads();
  for (int idx = tid; idx < 132 * 16; idx += 256) {
    int kj = idx >> 4, qr = idx & 15, s = qr & 3;
    bool valid = (kj < 128) ? (kj > s) : (kj - 128 <= s);
    float acc = 0.f;
    const float* q = Qs + qr * 64;
    if (kj < 128) {
      const float4* kr = (const float4*)(p.cache_k + (((size_t)b * 128 + kj) * 2 + kvh) * 64);
#pragma unroll
      for (int d = 0; d < 16; ++d) {
        float4 kv = kr[d];
        acc += kv.x * q[d * 4] + kv.y * q[d * 4 + 1] + kv.z * q[d * 4 + 2] + kv.w * q[d * 4 + 3];
      }
    } else {
      const uint2* kr = (const uint2*)(proj + (size_t)(TP + b * 4 + kj - 128) * NIN + 2304 + kvh * 64);
#pragma unroll
      for (int d = 0; d < 16; ++d) {
        uint2 kv = kr[d];
        acc += bflo(kv.x) * q[d * 4] + bfhi(kv.x) * q[d * 4 + 1] + bflo(kv.y) * q[d * 4 + 2] + bfhi(kv.y) * q[d * 4 + 3];
      }
    }
    Sc[qr * 136 + kj] = valid ? acc : -1e30f;
  }
  __syncthreads();
  {
    int qr = tid >> 4, l = tid & 15, g = qr >> 2;
    float sink = p.sinks[kvh * 4 + g];
    float mx = -1e30f;
    for (int kj = l; kj < 132; kj += 16) mx = fmaxf(mx, Sc[qr * 136 + kj]);
    mx = redmax16(mx);
    mx = fmaxf(mx, sink);
    float sum = 0.f;
    for (int kj = l; kj < 132; kj += 16) {
      float s = Sc[qr * 136 + kj];
      float e = (s > -1e29f) ? __expf(s - mx) : 0.f;
      Sc[qr * 136 + kj] = e;
      sum += e;
    }
    sum = red16(sum) + __expf(sink - mx);
    float inv = 1.f / sum;
    for (int kj = l; kj < 132; kj += 16) Sc[qr * 136 + kj] *= inv;
  }
  __syncthreads();
  {
    int qr = tid >> 4, d4 = (tid & 15) * 4, g = qr >> 2, s = qr & 3;
    float4 o = {0.f, 0.f, 0.f, 0.f};
    for (int kj = 0; kj < 128; ++kj) {
      float pw = Sc[qr * 136 + kj];
      float4 v = *(const float4*)(p.cache_v + (((size_t)b * 128 + kj) * 2 + kvh) * 64 + d4);
      o.x += pw * v.x; o.y += pw * v.y; o.z += pw * v.z; o.w += pw * v.w;
    }
    for (int kj = 128; kj < 132; ++kj) {
      float pw = Sc[qr * 136 + kj];
      uint2 v = *(const uint2*)(proj + (size_t)(TP + b * 4 + kj - 128) * NIN + 2432 + kvh * 64 + d4);
      o.x += pw * bflo(v.x); o.y += pw * bfhi(v.x); o.z += pw * bflo(v.y); o.w += pw * bfhi(v.y);
    }
    *(uint2*)(mix + (size_t)(TP + b * 4 + s) * 1024 + 512 + (kvh * 4 + g) * 64 + d4) =
        uint2{pack2bf(o.x, o.y), pack2bf(o.z, o.w)};
  }
  __syncthreads();
}

__device__ void phase4(const Params& p, char* smem) {
  constexpr int N_PS = 128, N_SS = 4096, N_AP = NB * 65 * 8, N_AS = 256;
  int first, stride;
  if (gridDim.x >= 2 * N_PS) {
    if ((int)blockIdx.x < N_PS) {
      int t = blockIdx.x;
      int seq = t >> 2, rg = t & 3, b = seq >> 3, h = seq & 7;
      scan_task(p, smem, b * LP, LP, -1, h, rg, nullptr, p.out + O_WKVP + (size_t)seq * 4096);
      return;
    }
    first = N_PS + (blockIdx.x - N_PS);
    stride = gridDim.x - N_PS;
  } else {
    first = blockIdx.x;
    stride = gridDim.x;
  }
  for (int task = first; task < N_PS + N_SS + N_AP + N_AS; task += stride) {
    int t = task;
    if (t < N_PS) {
      int seq = t >> 2, rg = t & 3, b = seq >> 3, h = seq & 7;
      scan_task(p, smem, b * LP, LP, -1, h, rg, nullptr, p.out + O_WKVP + (size_t)seq * 4096);
      continue;
    }
    t -= N_PS;
    if (t < N_SS) {
      int seq = t >> 2, rg = t & 3, b = seq >> 3, h = seq & 7;
      scan_task(p, smem, TP + b * 4, 4, PREV0 + b, h, rg, p.state_wkv + (size_t)seq * 4096,
                p.out + O_WKVS + (size_t)seq * 4096);
      continue;
    }
    t -= N_SS;
    if (t < N_AP) { attn_prompt_task(p, smem, t); continue; }
    t -= N_AP;
    attn_sample_task(p, smem, t);
  }
}

__device__ void post_task(const Params& p, int task) {
  const int wave = threadIdx.x >> 6, lane = threadIdx.x & 63;
  int row = task * 4 + wave;
  if (row >= TTOK) return;
  const u16* proj = (const u16*)(p.ws + WS_C);
  const float* yraw = (const float*)(p.ws + WS_E);
  const u16* ab = (const u16*)(p.ws + WS_A);
  const u16* gb = (const u16*)(p.ws + WS_G);
  u16* mix = (u16*)(p.ws + WS_B);
  int prow;
  if (row < TP) { int t = row % LP; prow = t > 0 ? row - 1 : -1; }
  else { int r = row - TP; prow = (r & 3) ? row - 1 : PREV0 + (r >> 2); }
  int c0 = lane * 8;
  float y[8];
  {
    float4 a = *(const float4*)(yraw + (size_t)row * 512 + c0), bq = *(const float4*)(yraw + (size_t)row * 512 + c0 + 4);
    y[0] = a.x; y[1] = a.y; y[2] = a.z; y[3] = a.w; y[4] = bq.x; y[5] = bq.y; y[6] = bq.z; y[7] = bq.w;
  }
  float s = 0.f;
#pragma unroll
  for (int e = 0; e < 8; ++e) s += y[e];
  float mean = red8(s) * (1.f / 64.f);
  float vs = 0.f;
#pragma unroll
  for (int e = 0; e < 8; ++e) { float d = y[e] - mean; vs += d * d; }
  float rstd = rsqrtf(red8(vs) * (1.f / 64.f) + 64e-5f);
  float xr[8], xk[8], xv[8];
  auto ld8 = [&](int coff, float* o) {
    uint4 a = *(const uint4*)(proj + (size_t)row * NIN + coff + c0);
    uint4 q = prow >= 0 ? *(const uint4*)(proj + (size_t)prow * NIN + coff + c0) : uint4{0, 0, 0, 0};
    unsigned ua[4] = {a.x, a.y, a.z, a.w}, uq[4] = {q.x, q.y, q.z, q.w};
#pragma unroll
    for (int e = 0; e < 4; ++e) {
      float x0 = bflo(ua[e]), x1 = bfhi(ua[e]), p0 = bflo(uq[e]), p1 = bfhi(uq[e]);
      float m0 = p.mu[coff + c0 + 2 * e], m1 = p.mu[coff + c0 + 2 * e + 1];
      o[2 * e] = x0 + (p0 - x0) * m0;
      o[2 * e + 1] = x1 + (p1 - x1) * m1;
    }
  };
  ld8(0, xr);
  ld8(512, xk);
  ld8(1024, xv);
  float aa[8], gg[8];
  {
    uint4 a = *(const uint4*)(ab + (size_t)row * 512 + c0), g = *(const uint4*)(gb + (size_t)row * 512 + c0);
    unsigned ua[4] = {a.x, a.y, a.z, a.w}, ug[4] = {g.x, g.y, g.z, g.w};
#pragma unroll
    for (int e = 0; e < 4; ++e) {
      aa[2 * e] = bflo(ua[e]); aa[2 * e + 1] = bfhi(ua[e]);
      gg[2 * e] = bflo(ug[e]); gg[2 * e + 1] = bfhi(ug[e]);
    }
  }
  float bs = 0.f;
#pragma unroll
  for (int e = 0; e < 8; ++e) {
    float km = xk[e] * (1.f + (aa[e] - 1.f) * p.k_a[c0 + e]);
    bs += xr[e] * km * p.r_k[c0 + e];
  }
  bs = red8(bs);
  unsigned o[4];
#pragma unroll
  for (int e = 0; e < 4; ++e) {
    float v0 = ((y[2 * e] - mean) * rstd * p.lnx_w[c0 + 2 * e] + p.lnx_b[c0 + 2 * e] + bs * xv[2 * e]) * gg[2 * e];
    float v1 = ((y[2 * e + 1] - mean) * rstd * p.lnx_w[c0 + 2 * e + 1] + p.lnx_b[c0 + 2 * e + 1] + bs * xv[2 * e + 1]) *
               gg[2 * e + 1];
    o[e] = pack2bf(v0, v1);
  }
  *(uint4*)(mix + (size_t)row * 1024 + c0) = uint4{o[0], o[1], o[2], o[3]};
}

__device__ void phase5(const Params& p) {
  for (int task = blockIdx.x; task < TTOK / 4; task += gridDim.x) post_task(p, task);
}

__device__ void phase6(const Params& p, char* smem) {
  const u16* mix = (const u16*)(p.ws + WS_B);
  const u16* wt = (const u16*)(p.ws + WS_WOUT);
  constexpr int MT = NOUT / 128, NT = 8;
  constexpr int N_CV = 2 * 16384 * 1024 / 2048;
  for (int task = blockIdx.x; task < MT * NT + N_CV; task += gridDim.x) {
    if (task < MT * NT) {
      int mt = task / NT, nt = task % NT;
      int o0 = mt * 128;
      int arow = o0 + (o0 < 16384 ? 16 * (o0 / 4096 + 1) : 64);
      const float* xin = (o0 < 16384 ? p.x_prompt + (size_t)o0 * D : p.x_sample + (size_t)(o0 - 16384) * D) + nt * 128;
      float* xo = p.out + (size_t)o0 * D + nt * 128;
      gemm_tile(mix + (size_t)arow * 1024, 1024, wt + (size_t)nt * 128 * 1024, 1024, 1024, smem,
                [&](int r, int c, float v) { xo[(size_t)r * D + c] = xin[(size_t)r * D + c] + v; });
    } else {
      int t = task - MT * NT;
      size_t e = ((size_t)t * 256 + threadIdx.x) * 8;
      const float* src = (e < 16777216ull) ? p.eu + e : p.ev + (e - 16777216ull);
      u16* dst = (u16*)(p.ws + WS_EU) + e;
      float4 a = *(const float4*)src, bq = *(const float4*)(src + 4);
      uint4 o;
      o.x = (unsigned)f2h(a.x) | ((unsigned)f2h(a.y) << 16);
      o.y = (unsigned)f2h(a.z) | ((unsigned)f2h(a.w) << 16);
      o.z = (unsigned)f2h(bq.x) | ((unsigned)f2h(bq.y) << 16);
      o.w = (unsigned)f2h(bq.z) | ((unsigned)f2h(bq.w) << 16);
      *(uint4*)dst = o;
    }
  }
}

__device__ void phase7(const Params& p) {
  const int wave = threadIdx.x >> 6, lane = threadIdx.x & 63;
  u16* h2 = (u16*)(p.ws + WS_B);
  u16* h2h = (u16*)(p.ws + WS_E);
  for (int task = blockIdx.x; task < NOUT / 4; task += gridDim.x) {
    int o = task * 4 + wave;
    const float* src = p.out + (size_t)o * D;
    float4 v[4];
    float ss = 0.f;
#pragma unroll
    for (int i = 0; i < 4; ++i) {
      v[i] = ((const float4*)src)[i * 64 + lane];
      ss += v[i].x * v[i].x + v[i].y * v[i].y + v[i].z * v[i].z + v[i].w * v[i].w;
    }
    ss = wave_sum(ss);
    float sc = rsqrtf(ss * (1.f / 1024.f) + 1e-5f);
#pragma unroll
    for (int i = 0; i < 4; ++i) {
      float4 g = ((const float4*)p.norm2_g)[i * 64 + lane];
      float y0 = v[i].x * sc * g.x, y1 = v[i].y * sc * g.y, y2 = v[i].z * sc * g.z, y3 = v[i].w * sc * g.w;
      *(uint2*)(h2 + (size_t)o * D + (i * 64 + lane) * 4) = uint2{pack2bf(y0, y1), pack2bf(y2, y3)};
      *(uint2*)(h2h + (size_t)o * D + (i * 64 + lane) * 4) =
          uint2{(unsigned)f2h(y0) | ((unsigned)f2h(y1) << 16), (unsigned)f2h(y2) | ((unsigned)f2h(y3) << 16)};
    }
  }
}

__device__ void phase8(const Params& p, char* smem) {
  const u16* h2 = (const u16*)(p.ws + WS_B);
  const u16* wt = (const u16*)(p.ws + WS_WQ);
  u16* q = (u16*)(p.ws + WS_Q);
  constexpr int MT = NOUT / 128, NT = 16;
  for (int tile = blockIdx.x; tile < MT * NT; tile += gridDim.x) {
    int mt = tile / NT, nt = tile % NT;
    u16* crow = q + (size_t)mt * 128 * 2048 + nt * 128;
    gemm_tile(h2 + (size_t)mt * 128 * D, D, wt + (size_t)nt * 128 * D, D, D, smem,
              [&](int r, int c, float v) { crow[(size_t)r * 2048 + c] = f2bf(v); });
  }
}

__device__ __forceinline__ unsigned ford(float f) {
  unsigned u = __float_as_uint(f);
  return (u & 0x80000000u) ? ~u : (u | 0x80000000u);
}
__device__ __forceinline__ float fdeord(unsigned k) {
  unsigned u = (k & 0x80000000u) ? (k & 0x7fffffffu) : ~k;
  return __uint_as_float(u);
}
__device__ __forceinline__ unsigned umax_(unsigned a, unsigned b) { return a > b ? a : b; }
__device__ __forceinline__ unsigned umin_(unsigned a, unsigned b) { return a < b ? a : b; }

#define CE_DESC(a, b) { unsigned _x = umax_(a, b), _y = umin_(a, b); a = _x; b = _y; }
#define CE_ASC(a, b) { unsigned _x = umin_(a, b), _y = umax_(a, b); a = _x; b = _y; }

template <int N>
__device__ __forceinline__ void bitonic_sort_desc(unsigned (&k)[N]) {
#pragma unroll
  for (int sz = 2; sz <= N; sz <<= 1) {
#pragma unroll
    for (int st = sz >> 1; st > 0; st >>= 1) {
#pragma unroll
      for (int i = 0; i < N; ++i) {
        int l = i ^ st;
        if (l > i) {
          if ((i & sz) == 0) CE_DESC(k[i], k[l]) else CE_ASC(k[i], k[l])
        }
      }
    }
  }
}
template <int N>
__device__ __forceinline__ void bitonic_merge_desc(unsigned (&k)[N]) {
#pragma unroll
  for (int st = N >> 1; st > 0; st >>= 1) {
#pragma unroll
    for (int i = 0; i < N; ++i) {
      int l = i ^ st;
      if (l > i) CE_DESC(k[i], k[l])
    }
  }
}
__device__ __forceinline__ void cross_merge16(unsigned (&k)[16]) {
#pragma unroll
  for (int x = 16; x <= 32; x <<= 1) {
    unsigned o[16];
#pragma unroll
    for (int i = 0; i < 16; ++i) o[i] = (unsigned)__shfl_xor((int)k[i], x, 64);
#pragma unroll
    for (int i = 0; i < 16; ++i) k[i] = umax_(k[i], o[15 - i]);
    bitonic_merge_desc<16>(k);
  }
}

__device__ void topk_unit(const Params& p, char* smem, int tg, int h) {
  const int tid = threadIdx.x, w = tid >> 6, lane = tid & 63, fr = lane & 15, fq = lane >> 4;
  const u16* q = (const u16*)(p.ws + WS_Q);
  const u16* subk = (const u16*)(p.ws + WS_SUBK);
  int* idxo = (int*)(p.ws + WS_IDX);
  float* gateo = (float*)(p.ws + WS_GATE);
  int* il = (int*)smem + w * 512;
  const int o0 = tg * 16;
  unsigned s1[16], s2[16];
#pragma unroll
  for (int c = 0; c < 2; ++c) {
    f32x4 acc[8];
#pragma unroll
    for (int i = 0; i < 8; ++i) acc[i] = f32x4{0.f, 0.f, 0.f, 0.f};
#pragma unroll
    for (int ks = 0; ks < 4; ++ks) {
      bf16x8 qb = *(const bf16x8*)(q + (size_t)(o0 + fr) * 2048 + (h * 2 + c) * 128 + ks * 32 + fq * 8);
#pragma unroll
      for (int mt = 0; mt < 8; ++mt) {
        bf16x8 ka = *(const bf16x8*)(subk + ((size_t)(c * 128 + mt * 16 + fr)) * 128 + ks * 32 + fq * 8);
        acc[mt] = mfma16(ka, qb, acc[mt]);
      }
    }
    unsigned lo[16], hi[16];
#pragma unroll
    for (int mt = 0; mt < 4; ++mt)
#pragma unroll
      for (int j = 0; j < 4; ++j) {
        lo[mt * 4 + j] = (ford(acc[mt][j]) & 0xffffff80u) | (unsigned)(127 - (mt * 16 + fq * 4 + j));
        hi[mt * 4 + j] = (ford(acc[mt + 4][j]) & 0xffffff80u) | (unsigned)(127 - ((mt + 4) * 16 + fq * 4 + j));
      }
    bitonic_sort_desc<16>(lo);
    bitonic_sort_desc<16>(hi);
#pragma unroll
    for (int i = 0; i < 16; ++i) lo[i] = umax_(lo[i], hi[15 - i]);
    bitonic_merge_desc<16>(lo);
    cross_merge16(lo);
    if (fq == 0) {
#pragma unroll
      for (int i = 0; i < 16; ++i) il[fr * 32 + c * 16 + i] = 127 - (int)(lo[i] & 0x7fu);
    }
#pragma unroll
    for (int i = 0; i < 16; ++i) {
      if (c == 0) s1[i] = lo[i]; else s2[i] = lo[i];
    }
  }
  float v1[16], v2[16];
#pragma unroll
  for (int i = 0; i < 16; ++i) {
    v1[i] = fdeord(s1[i] & 0xffffff80u);
    v2[i] = fdeord(s2[i] & 0xffffff80u);
  }
  unsigned ck[16];
#define CAND(i, j) ((ford(v1[i] + v2[j]) & 0xffffff00u) | (unsigned)((i) * 16 + (j)))
#define SEL4(slot, A, B, C, Dv) ck[slot] = (fq == 0) ? (A) : (fq == 1) ? (B) : (fq == 2) ? (C) : (Dv);
  SEL4(0, CAND(0, 0), CAND(1, 0), CAND(3, 3), CAND(14, 0))
  SEL4(1, CAND(0, 1), CAND(1, 1), CAND(4, 0), CAND(15, 0))
  SEL4(2, CAND(0, 2), CAND(1, 2), CAND(4, 1), 0u)
  SEL4(3, CAND(0, 3), CAND(1, 3), CAND(4, 2), 0u)
  SEL4(4, CAND(0, 4), CAND(1, 4), CAND(5, 0), 0u)
  SEL4(5, CAND(0, 5), CAND(1, 5), CAND(5, 1), 0u)
  SEL4(6, CAND(0, 6), CAND(1, 6), CAND(6, 0), 0u)
  SEL4(7, CAND(0, 7), CAND(1, 7), CAND(6, 1), 0u)
  SEL4(8, CAND(0, 8), CAND(2, 0), CAND(7, 0), 0u)
  SEL4(9, CAND(0, 9), CAND(2, 1), CAND(7, 1), 0u)
  SEL4(10, CAND(0, 10), CAND(2, 2), CAND(8, 0), 0u)
  SEL4(11, CAND(0, 11), CAND(2, 3), CAND(9, 0), 0u)
  SEL4(12, CAND(0, 12), CAND(2, 4), CAND(10, 0), 0u)
  SEL4(13, CAND(0, 13), CAND(3, 0), CAND(11, 0), 0u)
  SEL4(14, CAND(0, 14), CAND(3, 1), CAND(12, 0), 0u)
  SEL4(15, CAND(0, 15), CAND(3, 2), CAND(13, 0), 0u)
#undef SEL4
#undef CAND
  bitonic_sort_desc<16>(ck);
  cross_merge16(ck);
  float top[16], esum = 0.f;
#pragma unroll
  for (int i = 0; i < 16; ++i) top[i] = fdeord(ck[i] & 0xffffff00u);
  const float tmax = top[0];
#pragma unroll
  for (int i = 0; i < 16; ++i) top[i] = __expf(top[i] - tmax);
#pragma unroll
  for (int i = 0; i < 16; ++i) esum += top[i];
  float inv = 1.f / esum;
  int oi[4];
  float og[4];
#pragma unroll
  for (int jj = 0; jj < 4; ++jj) {
    unsigned kk = (fq == 0) ? ck[jj] : (fq == 1) ? ck[4 + jj] : (fq == 2) ? ck[8 + jj] : ck[12 + jj];
    float tv = (fq == 0) ? top[jj] : (fq == 1) ? top[4 + jj] : (fq == 2) ? top[8 + jj] : top[12 + jj];
    int code = (int)(kk & 0xffu);
    int i1 = il[fr * 32 + (code >> 4)], i2 = il[fr * 32 + 16 + (code & 15)];
    oi[jj] = i1 * 128 + i2;
    og[jj] = tv * inv;
  }
  size_t ob = (size_t)(o0 + fr) * 128 + h * 16 + fq * 4;
  *(int4*)(idxo + ob) = int4{oi[0], oi[1], oi[2], oi[3]};
  *(float4*)(gateo + ob) = float4{og[0], og[1], og[2], og[3]};
}

__device__ void phase9(const Params& p, char* smem) {
  const int w = threadIdx.x >> 6;
  for (int task = blockIdx.x; task < (NOUT / 16) * 2; task += gridDim.x) {
    int tg = task >> 1, h = (task & 1) * 4 + w;
    topk_unit(p, smem, tg, h);
  }
}

__device__ __forceinline__ float dot8h(uint4 a, uint4 b, float acc) {
  acc = __builtin_amdgcn_fdot2(__builtin_bit_cast(half2v, a.x), __builtin_bit_cast(half2v, b.x), acc, false);
  acc = __builtin_amdgcn_fdot2(__builtin_bit_cast(half2v, a.y), __builtin_bit_cast(half2v, b.y), acc, false);
  acc = __builtin_amdgcn_fdot2(__builtin_bit_cast(half2v, a.z), __builtin_bit_cast(half2v, b.z), acc, false);
  acc = __builtin_amdgcn_fdot2(__builtin_bit_cast(half2v, a.w), __builtin_bit_cast(half2v, b.w), acc, false);
  return acc;
}
__device__ __forceinline__ void axpy8h(float a, uint4 v, float* acc) {
  half2v h0 = __builtin_bit_cast(half2v, v.x), h1 = __builtin_bit_cast(half2v, v.y),
         h2 = __builtin_bit_cast(half2v, v.z), h3 = __builtin_bit_cast(half2v, v.w);
  acc[0] = fmaf(a, (float)h0[0], acc[0]); acc[1] = fmaf(a, (float)h0[1], acc[1]);
  acc[2] = fmaf(a, (float)h1[0], acc[2]); acc[3] = fmaf(a, (float)h1[1], acc[3]);
  acc[4] = fmaf(a, (float)h2[0], acc[4]); acc[5] = fmaf(a, (float)h2[1], acc[5]);
  acc[6] = fmaf(a, (float)h3[0], acc[6]); acc[7] = fmaf(a, (float)h3[1], acc[7]);
}

__device__ void gather_task(const Params& p, int task) {
  const int wave = threadIdx.x >> 6, lane = threadIdx.x & 63;
  int o = task * 4 + wave;
  const u16* h2h = (const u16*)(p.ws + WS_E);
  const u16* euh = (const u16*)(p.ws + WS_EU);
  const u16* evh = (const u16*)(p.ws + WS_EV);
  const int* idx = (const int*)(p.ws + WS_IDX) + (size_t)o * 128;
  const float* gate = (const float*)(p.ws + WS_GATE) + (size_t)o * 128;
  const uint4* hrow = (const uint4*)(h2h + (size_t)o * 1024);
  uint4 ha = hrow[lane], hb = hrow[64 + lane];
  float acc[16];
#pragma unroll
  for (int i = 0; i < 16; ++i) acc[i] = 0.f;
  for (int kb = 0; kb < 8; ++kb) {
    int myidx = idx[kb * 16 + (lane & 15)];
    float mygate = gate[kb * 16 + (lane & 15)];
    float mypre = 0.f;
#pragma unroll
    for (int e4 = 0; e4 < 4; ++e4) {
      float d[4];
#pragma unroll
      for (int e = 0; e < 4; ++e) {
        int ei = __builtin_amdgcn_readlane(myidx, e4 * 4 + e);
        const uint4* ur = (const uint4*)(euh + (size_t)ei * 1024);
        uint4 ua = ur[lane], ub = ur[64 + lane];
        d[e] = dot8h(hb, ub, dot8h(ha, ua, 0.f));
      }
#pragma unroll
      for (int e = 0; e < 4; ++e) {
        float tot = wave_sum(d[e]);
        mypre = ((lane & 15) == e4 * 4 + e) ? tot : mypre;
      }
    }
    float myact = 0.5f * mypre * (1.f + erff(mypre * 0.70710678118654752f)) * mygate;
#pragma unroll
    for (int e4 = 0; e4 < 4; ++e4) {
      uint4 va[4], vb[4];
      float a[4];
#pragma unroll
      for (int e = 0; e < 4; ++e) {
        int ei = __builtin_amdgcn_readlane(myidx, e4 * 4 + e);
        a[e] = rdlane(myact, e4 * 4 + e);
        const uint4* vr = (const uint4*)(evh + (size_t)ei * 1024);
        va[e] = vr[lane];
        vb[e] = vr[64 + lane];
      }
#pragma unroll
      for (int e = 0; e < 4; ++e) {
        axpy8h(a[e], va[e], acc);
        axpy8h(a[e], vb[e], acc + 8);
      }
    }
  }
  float* xrow = p.out + (size_t)o * D;
  float x[16];
  {
    float4 a0 = *(const float4*)(xrow + lane * 8), a1 = *(const float4*)(xrow + lane * 8 + 4);
    float4 b0 = *(const float4*)(xrow + 512 + lane * 8), b1 = *(const float4*)(xrow + 512 + lane * 8 + 4);
    x[0] = a0.x; x[1] = a0.y; x[2] = a0.z; x[3] = a0.w; x[4] = a1.x; x[5] = a1.y; x[6] = a1.z; x[7] = a1.w;
    x[8] = b0.x; x[9] = b0.y; x[10] = b0.z; x[11] = b0.w; x[12] = b1.x; x[13] = b1.y; x[14] = b1.z; x[15] = b1.w;
  }
  float ss = 0.f;
#pragma unroll
  for (int i = 0; i < 16; ++i) { x[i] += acc[i]; ss += x[i] * x[i]; }
  ss = wave_sum(ss);
  float sc = rsqrtf(ss * (1.f / 1024.f) + 1e-5f);
  {
    const float* g = p.final_g;
    float4 g0 = *(const float4*)(g + lane * 8), g1 = *(const float4*)(g + lane * 8 + 4);
    float4 g2 = *(const float4*)(g + 512 + lane * 8), g3 = *(const float4*)(g + 512 + lane * 8 + 4);
    *(float4*)(xrow + lane * 8) = float4{x[0] * sc * g0.x, x[1] * sc * g0.y, x[2] * sc * g0.z, x[3] * sc * g0.w};
    *(float4*)(xrow + lane * 8 + 4) = float4{x[4] * sc * g1.x, x[5] * sc * g1.y, x[6] * sc * g1.z, x[7] * sc * g1.w};
    *(float4*)(xrow + 512 + lane * 8) = float4{x[8] * sc * g2.x, x[9] * sc * g2.y, x[10] * sc * g2.z, x[11] * sc * g2.w};
    *(float4*)(xrow + 512 + lane * 8 + 4) =
        float4{x[12] * sc * g3.x, x[13] * sc * g3.y, x[14] * sc * g3.z, x[15] * sc * g3.w};
  }
}

__device__ void phase10(const Params& p) {
  for (int task = blockIdx.x; task < NOUT / 4; task += gridDim.x) gather_task(p, task);
}

template <int PH>
__device__ __forceinline__ void run_phase(const Params& p, char* smem) {
  if constexpr (PH == 0) phase0(p, smem);
  if constexpr (PH == 1) phase1(p, smem);
  if constexpr (PH == 2) phase2(p);
  if constexpr (PH == 3) phase3(p, smem);
  if constexpr (PH == 4) phase4(p, smem);
  if constexpr (PH == 5) phase5(p);
  if constexpr (PH == 6) phase6(p, smem);
  if constexpr (PH == 7) phase7(p);
  if constexpr (PH == 8) phase8(p, smem);
  if constexpr (PH == 9) phase9(p, smem);
  if constexpr (PH == 10) phase10(p);
}

template <int LO, int HI>
__device__ __forceinline__ void run_range(const Params& p, char* smem) {
  if constexpr (LO < HI) {
    run_phase<LO>(p, smem);
    if constexpr (LO + 1 < HI) {
      cg::this_grid().sync();
      run_range<LO + 1, HI>(p, smem);
    }
  }
}

template <int LO, int HI>
__global__ void __launch_bounds__(256, 2) fwd_kernel(Params p) {
  __shared__ __attribute__((aligned(16))) char smem[SMEM_BYTES];
  run_range<LO, HI>(p, smem);
}

template <int PH>
static void launch_one(const Params& p, int grid, hipStream_t stream) {
  fwd_kernel<PH, PH + 1><<<grid, 256, 0, stream>>>(p);
}

extern "C" void kernel_launch(void* const* d_in, const int* in_sizes, int n_in, void* d_out, int out_size, void* d_ws,
                              size_t ws_size, hipStream_t stream) {
  Params p{};
  const float** pp = (const float**)&p;
  for (int i = 0; i < 28; ++i) pp[i] = (const float*)d_in[i];
  p.out = (float*)d_out;
  p.ws = (char*)d_ws;
#if MULTI_LAUNCH
  const int grid = 1024;
  launch_one<0>(p, grid, stream);
  launch_one<1>(p, grid, stream);
  launch_one<2>(p, grid, stream);
  launch_one<3>(p, grid, stream);
  launch_one<4>(p, grid, stream);
  launch_one<5>(p, grid, stream);
  launch_one<6>(p, grid, stream);
  launch_one<7>(p, grid, stream);
  launch_one<8>(p, grid, stream);
  launch_one<9>(p, grid, stream);
  launch_one<10>(p, grid, stream);
#else
  static int grid_blocks = 0;
  if (!grid_blocks) {
    int dev = 0, cus = 0, per_cu = 0;
    (void)hipGetDevice(&dev);
    (void)hipDeviceGetAttribute(&cus, hipDeviceAttributeMultiprocessorCount, dev);
    (void)hipOccupancyMaxActiveBlocksPerMultiprocessor(&per_cu, fwd_kernel<0, NPH>, 256, 0);
    if (per_cu < 1) per_cu = 1;
    if (per_cu > 4) per_cu = 4;
    grid_blocks = cus * per_cu;
  }
  void* args[] = {&p};
  hipError_t e = hipLaunchCooperativeKernel((void*)fwd_kernel<0, NPH>, dim3(grid_blocks), dim3(256), args, 0, stream);
  if (e != hipSuccess) fprintf(stderr, "cooperative launch failed: %s (grid %d)\n", hipGetErrorString(e), grid_blocks);
#endif
}
```

```cpp
#include <hip/hip_runtime.h>
#include <hip/hip_cooperative_groups.h>
#include <cstdio>
#include <cstdint>
namespace cg = cooperative_groups;

typedef unsigned short u16;
using bf16x8 = __attribute__((ext_vector_type(8))) short;
using f32x4 = __attribute__((ext_vector_type(4))) float;
using half2v = __attribute__((ext_vector_type(2))) _Float16;
using float2v = __attribute__((ext_vector_type(2))) float;

#ifndef MULTI_LAUNCH
#define MULTI_LAUNCH 0
#endif

constexpr int D = 1024, NIN = 2560;
constexpr int LP = 4112, NB = 4, TP = NB * LP;
constexpr int SB = 128, TS = 512;
constexpr int TTOK = TP + TS;
constexpr int PREV0 = TTOK;
constexpr int MROWS = 17152;
constexpr int TPAD = 17024;
constexpr int NOUT = 16896;
constexpr int PAST = 8192;
constexpr int NPH = 11;

constexpr size_t O_YP = 0;
constexpr size_t O_KWP = 17301504, O_VWP = 17367040, O_WKVP = 17432576, O_SHP = 17563648;
constexpr size_t O_KWS = 17567744, O_VWS = 19664896, O_WKVS = 21762048, O_SHS = 25956352;

constexpr size_t WS_WIN = 0;
constexpr size_t WS_WOUT = WS_WIN + 2560ull * 1024 * 2;
constexpr size_t WS_WQ = WS_WOUT + 1024ull * 1024 * 2;
constexpr size_t WS_SUBK = WS_WQ + 2048ull * 1024 * 2;
constexpr size_t WS_W2W = WS_SUBK + 2ull * 128 * 128 * 2;
constexpr size_t WS_W2A = WS_W2W + 512ull * 64 * 2;
constexpr size_t WS_W2G = WS_W2A + 512ull * 64 * 2;
constexpr size_t WS_B = WS_W2G + 512ull * 128 * 2;
constexpr size_t WS_C = WS_B + (size_t)MROWS * 1024 * 2;
constexpr size_t WS_D = WS_C + (size_t)MROWS * NIN * 2;
constexpr size_t WS_E = WS_D + (size_t)TPAD * 512 * 8;
constexpr size_t WS_END = WS_E + (size_t)TPAD * 512 * 4;
constexpr size_t WS_DEC = WS_D, WS_A = WS_D + (size_t)TPAD * 512 * 4, WS_G = WS_A + (size_t)TPAD * 512 * 2;
constexpr size_t WS_EU = WS_D, WS_EV = WS_D + 16384ull * 1024, WS_SCU = WS_EV + 16384ull * 1024, WS_SCV = WS_SCU + 65536;
constexpr size_t WS_Q = WS_C, WS_IDX = WS_C + (size_t)NOUT * 2048 * 2, WS_GATE = WS_IDX + (size_t)NOUT * 128 * 4;
static_assert(WS_SCV + 65536 <= WS_E, "expert tables overflow region D");
static_assert(WS_GATE + (size_t)NOUT * 128 * 4 <= WS_D, "idx/gate overflow region C");
static_assert(WS_END <= 256ull * 1024 * 1024, "workspace too large");

constexpr int SMEM_BYTES = 36864;

struct Params {
  const float *x_prompt, *x_sample, *cache_k, *cache_v, *state_wkv, *state_shift, *meta, *norm1_g, *w_in, *mu, *w0,
      *w2w, *a0, *w2a, *w2g, *k_k, *k_a, *r_k, *lnx_w, *lnx_b, *sinks, *w_out, *norm2_g, *w_query, *sub_keys, *eu,
      *ev, *final_g;
  float* out;
  char* ws;
};

__constant__ double INVF[8] = {1.0, 0.19392274474868576, 0.03760603093086393, 0.007292664737217109,
                               0.001414213562373095, 0.0002742481756762073, 5.318295896944988e-05,
                               1.031338537721246e-05};

__device__ __forceinline__ u16 f2bf(float f) {
  unsigned u = __float_as_uint(f);
  u += 0x7fffu + ((u >> 16) & 1u);
  return (u16)(u >> 16);
}
__device__ __forceinline__ float bf2f(u16 h) { return __uint_as_float(((unsigned)h) << 16); }
__device__ __forceinline__ float bflo(unsigned u) { return __uint_as_float(u << 16); }
__device__ __forceinline__ float bfhi(unsigned u) { return __uint_as_float(u & 0xffff0000u); }
__device__ __forceinline__ unsigned pack2bf(float a, float b) { return (unsigned)f2bf(a) | ((unsigned)f2bf(b) << 16); }
__device__ __forceinline__ u16 f2h(float f) {
  _Float16 h = (_Float16)f;
  return __builtin_bit_cast(u16, h);
}

template <int CTRL>
__device__ __forceinline__ float dppf(float x) {
  return __int_as_float(__builtin_amdgcn_update_dpp(0, __float_as_int(x), CTRL, 0xF, 0xF, false));
}
__device__ __forceinline__ float red4(float x) {
  x += dppf<0xB1>(x);
  x += dppf<0x4E>(x);
  return x;
}
__device__ __forceinline__ float red8(float x) {
  x = red4(x);
  x += dppf<0x141>(x);
  return x;
}
__device__ __forceinline__ float red16(float x) {
  x = red8(x);
  x += dppf<0x140>(x);
  return x;
}
__device__ __forceinline__ float redmax16(float x) {
  x = fmaxf(x, dppf<0xB1>(x));
  x = fmaxf(x, dppf<0x4E>(x));
  x = fmaxf(x, dppf<0x141>(x));
  x = fmaxf(x, dppf<0x140>(x));
  return x;
}
__device__ __forceinline__ float rdlane(float x, int l) {
  return __int_as_float(__builtin_amdgcn_readlane(__float_as_int(x), l));
}
__device__ __forceinline__ float wave_sum(float x) {
  x = red16(x);
  return rdlane(x, 0) + rdlane(x, 16) + rdlane(x, 32) + rdlane(x, 48);
}
__device__ __forceinline__ f32x4 mfma16(bf16x8 a, bf16x8 b, f32x4 c) {
  return __builtin_amdgcn_mfma_f32_16x16x32_bf16(a, b, c, 0, 0, 0);
}
__device__ __forceinline__ float sigmoidf_(float x) { return 1.f / (1.f + __expf(-x)); }

template <class Epi>
__device__ __forceinline__ void gemm_tile(const u16* __restrict__ A, int lda, const u16* __restrict__ Bt, int ldb, int K,
                                          char* smem, Epi epi) {
  const int tid = threadIdx.x, wid = tid >> 6, lane = tid & 63, wr = wid >> 1, wc = wid & 1, fr = lane & 15,
            fq = lane >> 4;
  u16* SA = (u16*)smem;
  u16* SB = SA + 128 * 32;
  f32x4 acc[4][4];
#pragma unroll
  for (int m = 0; m < 4; ++m)
#pragma unroll
    for (int n = 0; n < 4; ++n) acc[m][n] = f32x4{0.f, 0.f, 0.f, 0.f};
  const int nk = K / 32;
  for (int kt = 0; kt < nk; ++kt) {
#pragma unroll
    for (int i = 0; i < 2; ++i) {
      int b = tid * 16 + i * 4096, r = b / 64, c = (b % 64) / 2;
      __builtin_amdgcn_global_load_lds((const unsigned*)(A + (size_t)r * lda + kt * 32 + c),
                                       (__attribute__((address_space(3))) unsigned*)((char*)SA + b), 16, 0, 0);
      __builtin_amdgcn_global_load_lds((const unsigned*)(Bt + (size_t)r * ldb + kt * 32 + c),
                                       (__attribute__((address_space(3))) unsigned*)((char*)SB + b), 16, 0, 0);
    }
    asm volatile("s_waitcnt vmcnt(0)" ::: "memory");
    __syncthreads();
    bf16x8 At[4], Bl[4];
#pragma unroll
    for (int m = 0; m < 4; ++m) At[m] = *(const bf16x8*)((const char*)SA + (wr * 64 + m * 16 + fr) * 64 + fq * 16);
#pragma unroll
    for (int n = 0; n < 4; ++n) Bl[n] = *(const bf16x8*)((const char*)SB + (wc * 64 + n * 16 + fr) * 64 + fq * 16);
#pragma unroll
    for (int m = 0; m < 4; ++m)
#pragma unroll
      for (int n = 0; n < 4; ++n) acc[m][n] = mfma16(At[m], Bl[n], acc[m][n]);
    __syncthreads();
  }
#pragma unroll
  for (int m = 0; m < 4; ++m)
#pragma unroll
    for (int n = 0; n < 4; ++n)
#pragma unroll
      for (int j = 0; j < 4; ++j) epi(wr * 64 + m * 16 + fq * 4 + j, wc * 64 + n * 16 + fr, acc[m][n][j]);
}

__device__ void transpose_task(const float* __restrict__ src, int K, int N, u16* __restrict__ dst, int tile, char* smem) {
  const int tid = threadIdx.x;
  int tn = N / 64;
  int k0 = (tile / tn) * 64, n0 = (tile % tn) * 64;
  float* t = (float*)smem;
#pragma unroll 4
  for (int it = 0; it < 16; ++it) {
    int k = it * 4 + (tid >> 6), n = tid & 63;
    t[n * 65 + k] = src[(size_t)(k0 + k) * N + n0 + n];
  }
  __syncthreads();
#pragma unroll 4
  for (int it = 0; it < 16; ++it) {
    int n = it * 4 + (tid >> 6), k = tid & 63;
    dst[(size_t)(n0 + n) * K + k0 + k] = f2bf(t[n * 65 + k]);
  }
  __syncthreads();
}

__device__ void norm1_task(const Params& p, int task) {
  const int wave = threadIdx.x >> 6, lane = threadIdx.x & 63;
  int row = task * 4 + wave;
  u16* h = (u16*)(p.ws + WS_B) + (size_t)row * D;
  const float* src = nullptr;
  bool donorm = true;
  float* shout = nullptr;
  if (row < TP) {
    int b = row / LP, t = row % LP;
    src = (t < 16) ? p.meta + (size_t)t * D : p.x_prompt + ((size_t)b * 4096 + (t - 16)) * D;
    if (t == LP - 1) shout = p.out + O_SHP + (size_t)b * D;
  } else if (row < TTOK) {
    int r = row - TP;
    src = p.x_sample + (size_t)r * D;
    if ((r & 3) == 3) shout = p.out + O_SHS + (size_t)(r >> 2) * D;
  } else if (row < TTOK + SB) {
    src = p.state_shift + (size_t)(row - TTOK) * D;
    donorm = false;
  }
  if (!src) {
#pragma unroll
    for (int i = 0; i < 4; ++i) *(uint2*)(h + (i * 64 + lane) * 4) = uint2{0u, 0u};
    return;
  }
  float4 v[4];
  float ss = 0.f;
#pragma unroll
  for (int i = 0; i < 4; ++i) {
    v[i] = ((const float4*)src)[i * 64 + lane];
    ss += v[i].x * v[i].x + v[i].y * v[i].y + v[i].z * v[i].z + v[i].w * v[i].w;
  }
  float sc = 1.f;
  if (donorm) {
    ss = wave_sum(ss);
    sc = rsqrtf(ss * (1.f / 1024.f) + 1e-5f);
  }
#pragma unroll
  for (int i = 0; i < 4; ++i) {
    float4 y = v[i];
    if (donorm) {
      float4 g = ((const float4*)p.norm1_g)[i * 64 + lane];
      y.x *= sc * g.x; y.y *= sc * g.y; y.z *= sc * g.z; y.w *= sc * g.w;
    }
    *(uint2*)(h + (i * 64 + lane) * 4) = uint2{pack2bf(y.x, y.y), pack2bf(y.z, y.w)};
    if (shout) ((float4*)shout)[i * 64 + lane] = y;
  }
}

__device__ void phase0(const Params& p, char* smem) {
  constexpr int N_NORM = MROWS / 4;
  constexpr int T_WIN = 16 * 40, T_WOUT = 16 * 16, T_WQ = 16 * 32, T_W2W = 8, T_W2A = 8, T_W2G = 16, T_SUBK = 32;
  constexpr int TOT = N_NORM + T_WIN + T_WOUT + T_WQ + T_W2W + T_W2A + T_W2G + T_SUBK;
  for (int task = blockIdx.x; task < TOT; task += gridDim.x) {
    int t = task;
    if (t < N_NORM) { norm1_task(p, t); continue; }
    t -= N_NORM;
    if (t < T_WIN) { transpose_task(p.w_in, 1024, 2560, (u16*)(p.ws + WS_WIN), t, smem); continue; }
    t -= T_WIN;
    if (t < T_WOUT) { transpose_task(p.w_out, 1024, 1024, (u16*)(p.ws + WS_WOUT), t, smem); continue; }
    t -= T_WOUT;
    if (t < T_WQ) { transpose_task(p.w_query, 1024, 2048, (u16*)(p.ws + WS_WQ), t, smem); continue; }
    t -= T_WQ;
    if (t < T_W2W) { transpose_task(p.w2w, 64, 512, (u16*)(p.ws + WS_W2W), t, smem); continue; }
    t -= T_W2W;
    if (t < T_W2A) { transpose_task(p.w2a, 64, 512, (u16*)(p.ws + WS_W2A), t, smem); continue; }
    t -= T_W2A;
    if (t < T_W2G) { transpose_task(p.w2g, 128, 512, (u16*)(p.ws + WS_W2G), t, smem); continue; }
    t -= T_W2G;
    {
      int e = (t * 256 + threadIdx.x) * 4;
      float4 v = *(const float4*)(p.sub_keys + e);
      *(uint2*)((u16*)(p.ws + WS_SUBK) + e) = uint2{pack2bf(v.x, v.y), pack2bf(v.z, v.w)};
    }
  }
}

__device__ void phase1(const Params& p, char* smem) {
  const u16* hbuf = (const u16*)(p.ws + WS_B);
  const u16* wt = (const u16*)(p.ws + WS_WIN);
  u16* proj = (u16*)(p.ws + WS_C);
  constexpr int NT = 20, MT = MROWS / 128;
  for (int tile = blockIdx.x; tile < MT * NT; tile += gridDim.x) {
    int mt = tile / NT, nt = tile % NT;
    u16* crow = proj + (size_t)mt * 128 * NIN + nt * 128;
    gemm_tile(hbuf + (size_t)mt * 128 * D, D, wt + (size_t)nt * 128 * D, D, D, smem,
              [&](int r, int c, float v) { crow[(size_t)r * NIN + c] = f2bf(v); });
  }
}

__device__ void prepass_task(const Params& p, int task) {
  const int wave = threadIdx.x >> 6, lane = threadIdx.x & 63;
  int row = task * 4 + wave;
  if (row >= TTOK) return;
  u16* proj = (u16*)(p.ws + WS_C);
  u16* act = (u16*)(p.ws + WS_E);
  bool isP = row < TP;
  int b, t, prow;
  float pos;
  if (isP) { b = row / LP; t = row % LP; prow = t > 0 ? row - 1 : -1; pos = (float)t; }
  else { int r = row - TP; b = r >> 2; t = r & 3; prow = t > 0 ? row - 1 : PREV0 + b; pos = (float)(PAST + t); }
  u16* pr = proj + (size_t)row * NIN;
  const u16* pp = prow >= 0 ? proj + (size_t)prow * NIN : nullptr;
  {
    int c = 1536 + lane * 4;
    uint2 a = *(const uint2*)(pr + c);
    uint2 bq = pp ? *(const uint2*)(pp + c) : uint2{0u, 0u};
    float4 mu = *(const float4*)(p.mu + c);
    float x[4] = {bflo(a.x), bfhi(a.x), bflo(a.y), bfhi(a.y)};
    float xp[4] = {bflo(bq.x), bfhi(bq.x), bflo(bq.y), bfhi(bq.y)};
    float mm[4] = {mu.x, mu.y, mu.z, mu.w};
    float o[4];
#pragma unroll
    for (int i = 0; i < 4; ++i) {
      float m = x[i] + (xp[i] - x[i]) * mm[i];
      float r;
      if (lane < 16) r = tanhf(m);
      else if (lane < 32) r = m;
      else r = sigmoidf_(m);
      o[i] = r;
    }
    *(uint2*)(act + (size_t)row * 256 + lane * 4) = uint2{pack2bf(o[0], o[1]), pack2bf(o[2], o[3])};
  }
  float* kwin = nullptr;
  float* vwin = nullptr;
  if (isP) {
    if (t >= LP - 128) {
      kwin = p.out + O_KWP + ((size_t)b * 128 + (t - (LP - 128))) * 128;
      vwin = p.out + O_VWP + ((size_t)b * 128 + (t - (LP - 128))) * 128;
    }
  } else {
    kwin = p.out + O_KWS + ((size_t)b * 128 + 124 + t) * 128;
    vwin = p.out + O_VWS + ((size_t)b * 128 + 124 + t) * 128;
  }
  for (int it = lane; it < 80; it += 64) {
    int hh = it >> 3, d = it & 7;
    int col = 1792 + hh * 64 + d;
    float x1 = bf2f(pr[col]), x2 = bf2f(pr[col + 8]);
    double rev = (double)pos * INVF[d] * 0.15915494309189535;
    float fr = (float)(rev - floor(rev));
    float sn = __builtin_amdgcn_sinf(fr), cs = __builtin_amdgcn_cosf(fr);
    float r1 = x1 * cs - x2 * sn, r2 = x2 * cs + x1 * sn;
    pr[col] = f2bf(r1);
    pr[col + 8] = f2bf(r2);
    if (hh >= 8 && kwin) {
      kwin[(hh - 8) * 64 + d] = r1;
      kwin[(hh - 8) * 64 + d + 8] = r2;
    }
  }
  if (kwin) {
#pragma unroll
    for (int i = 0; i < 2; ++i) {
      int idx = lane * 2 + i;
      if ((idx & 63) >= 16) kwin[idx] = bf2f(pr[2304 + idx]);
      vwin[idx] = bf2f(pr[2432 + idx]);
    }
  }
}

__device__ void phase2(const Params& p) {
  constexpr int N_PRE = TTOK / 4;
  constexpr int N_CP = 256;
  for (int task = blockIdx.x; task < N_PRE + N_CP; task += gridDim.x) {
    if (task < N_PRE) { prepass_task(p, task); continue; }
    int t = task - N_PRE;
    int which = t >> 7, b = t & 127;
    const float4* src = (const float4*)((which ? p.cache_v : p.cache_k) + (size_t)b * 16384 + 512);
    float4* dst = (float4*)(p.out + (which ? O_VWS : O_KWS) + (size_t)b * 16384);
    for (int i = threadIdx.x; i < 3968; i += 256) dst[i] = src[i];
  }
}

__device__ void phase3(const Params& p, char* smem) {
  const u16* act = (const u16*)(p.ws + WS_E);
  float* dec = (float*)(p.ws + WS_DEC);
  u16* ab = (u16*)(p.ws + WS_A);
  u16* gb = (u16*)(p.ws + WS_G);
  constexpr int MT = TPAD / 128;
  for (int tile = blockIdx.x; tile < MT * 12; tile += gridDim.x) {
    int which = tile % 3, rest = tile / 3;
    int nt = rest & 3, mt = rest >> 2;
    size_t r0 = (size_t)mt * 128;
    int c0 = nt * 128;
    if (which == 0) {
      gemm_tile(act + r0 * 256, 256, (const u16*)(p.ws + WS_W2W) + (size_t)c0 * 64, 64, 64, smem,
                [&](int r, int c, float v) {
                  float lw = p.w0[c0 + c] + v;
                  float nx = -lw;
                  float sp = fmaxf(nx, 0.f) + log1pf(__expf(-fabsf(nx)));
                  float w = -sp - 0.5f;
                  dec[(r0 + r) * 512 + c0 + c] = __expf(-__expf(w));
                });
    } else if (which == 1) {
      gemm_tile(act + r0 * 256 + 64, 256, (const u16*)(p.ws + WS_W2A) + (size_t)c0 * 64, 64, 64, smem,
                [&](int r, int c, float v) { ab[(r0 + r) * 512 + c0 + c] = f2bf(sigmoidf_(p.a0[c0 + c] + v)); });
    } else {
      gemm_tile(act + r0 * 256 + 128, 256, (const u16*)(p.ws + WS_W2G) + (size_t)c0 * 128, 128, 128, smem,
                [&](int r, int c, float v) { gb[(r0 + r) * 512 + c0 + c] = f2bf(v); });
    }
  }
}

__device__ void scan_task(const Params& p, char* smem, int rowbase, int T, int prevrow, int h, int rg,
                          const float* __restrict__ s_in, float* __restrict__ s_out) {
  const int tid = threadIdx.x, wave = tid >> 6, lane = tid & 63, l16 = lane & 15;
  const int il = wave * 4 + (lane >> 4), i = rg * 16 + il, j0 = l16 * 4;
  const u16* proj = (const u16*)(p.ws + WS_C);
  const float* dec = (const float*)(p.ws + WS_DEC);
  const u16* ab = (const u16*)(p.ws + WS_A);
  float* yraw = (float*)(p.ws + WS_E);
  float* buf = (float*)smem;
  float* ybuf = (float*)(smem + 24576);
  float S0 = 0.f, S1 = 0.f, S2 = 0.f, S3 = 0.f;
  if (s_in) {
    float4 s = *(const float4*)(s_in + i * 64 + j0);
    S0 = s.x; S1 = s.y; S2 = s.z; S3 = s.w;
  }
  const int tt = tid >> 4, cgp = tid & 15, col = h * 64 + cgp * 4;
  const float4 mu_r = *(const float4*)(p.mu + col), mu_k = *(const float4*)(p.mu + 512 + col),
               mu_v = *(const float4*)(p.mu + 1024 + col);
  const float4 kkw = *(const float4*)(p.k_k + col), kaw = *(const float4*)(p.k_a + col);
  const int nchunk = (T + 15) >> 4;
  uint2 rr = {0, 0}, rk = {0, 0}, rv = {0, 0}, qr = {0, 0}, qk = {0, 0}, qv = {0, 0}, av = {0, 0};
  float4 dc = {0, 0, 0, 0};
  auto issue = [&](int c) {
    int t = c * 16 + tt;
    if (t < T) {
      int row = rowbase + t;
      int prow = t > 0 ? row - 1 : prevrow;
      const u16* pr = proj + (size_t)row * NIN + col;
      rr = *(const uint2*)(pr);
      rk = *(const uint2*)(pr + 512);
      rv = *(const uint2*)(pr + 1024);
      if (prow >= 0) {
        const u16* pq = proj + (size_t)prow * NIN + col;
        qr = *(const uint2*)(pq);
        qk = *(const uint2*)(pq + 512);
        qv = *(const uint2*)(pq + 1024);
      } else {
        qr = uint2{0, 0}; qk = uint2{0, 0}; qv = uint2{0, 0};
      }
      dc = *(const float4*)(dec + (size_t)row * 512 + col);
      av = *(const uint2*)(ab + (size_t)row * 512 + col);
    }
  };
  issue(0);
  for (int c = 0; c < nchunk; ++c) {
    {
      float xr[4] = {bflo(rr.x), bfhi(rr.x), bflo(rr.y), bfhi(rr.y)};
      float xk[4] = {bflo(rk.x), bfhi(rk.x), bflo(rk.y), bfhi(rk.y)};
      float xv[4] = {bflo(rv.x), bfhi(rv.x), bflo(rv.y), bfhi(rv.y)};
      float pr_[4] = {bflo(qr.x), bfhi(qr.x), bflo(qr.y), bfhi(qr.y)};
      float pk_[4] = {bflo(qk.x), bfhi(qk.x), bflo(qk.y), bfhi(qk.y)};
      float pv_[4] = {bflo(qv.x), bfhi(qv.x), bflo(qv.y), bfhi(qv.y)};
      float aa[4] = {bflo(av.x), bfhi(av.x), bflo(av.y), bfhi(av.y)};
      float mur[4] = {mu_r.x, mu_r.y, mu_r.z, mu_r.w}, muk[4] = {mu_k.x, mu_k.y, mu_k.z, mu_k.w},
            muv[4] = {mu_v.x, mu_v.y, mu_v.z, mu_v.w};
      float kw[4] = {kkw.x, kkw.y, kkw.z, kkw.w}, ka[4] = {kaw.x, kaw.y, kaw.z, kaw.w};
      float kkv[4], ss = 0.f;
#pragma unroll
      for (int e = 0; e < 4; ++e) {
        xr[e] = xr[e] + (pr_[e] - xr[e]) * mur[e];
        xk[e] = xk[e] + (pk_[e] - xk[e]) * muk[e];
        xv[e] = xv[e] + (pv_[e] - xv[e]) * muv[e];
        kkv[e] = xk[e] * kw[e];
        ss += kkv[e] * kkv[e];
      }
      ss = red16(ss);
      float inv = 1.f / fmaxf(sqrtf(ss), 1e-12f);
      float4 o_r, o_w, o_k, o_a, o_b, o_v;
      float nk[4], kb[4], km[4];
#pragma unroll
      for (int e = 0; e < 4; ++e) {
        float kk = kkv[e] * inv;
        nk[e] = -kk;
        kb[e] = kk * aa[e];
        km[e] = xk[e] * (1.f + (aa[e] - 1.f) * ka[e]);
      }
      o_r = float4{xr[0], xr[1], xr[2], xr[3]};
      o_w = dc;
      o_k = float4{km[0], km[1], km[2], km[3]};
      o_a = float4{nk[0], nk[1], nk[2], nk[3]};
      o_b = float4{kb[0], kb[1], kb[2], kb[3]};
      o_v = float4{xv[0], xv[1], xv[2], xv[3]};
      float* bt = buf + tt * 384 + cgp * 4;
      *(float4*)(bt) = o_r;
      *(float4*)(bt + 64) = o_w;
      *(float4*)(bt + 128) = o_k;
      *(float4*)(bt + 192) = o_a;
      *(float4*)(bt + 256) = o_b;
      *(float4*)(bt + 320) = o_v;
    }
    __syncthreads();
    if (c + 1 < nchunk) issue(c + 1);
    int ntok = min(16, T - c * 16);
    for (int t2 = 0; t2 < ntok; ++t2) {
      const float* bt = buf + t2 * 384;
      float4 r4 = *(const float4*)(bt + j0), w4 = *(const float4*)(bt + 64 + j0), k4 = *(const float4*)(bt + 128 + j0),
             a4 = *(const float4*)(bt + 192 + j0), b4 = *(const float4*)(bt + 256 + j0);
      float vi = bt[320 + i];
      float sa = S0 * a4.x + S1 * a4.y + S2 * a4.z + S3 * a4.w;
      float t0 = S0 * w4.x + vi * k4.x, t1 = S1 * w4.y + vi * k4.y, t2_ = S2 * w4.z + vi * k4.z,
            t3 = S3 * w4.w + vi * k4.w;
      sa = red16(sa);
      S0 = t0 + sa * b4.x; S1 = t1 + sa * b4.y; S2 = t2_ + sa * b4.z; S3 = t3 + sa * b4.w;
      float y = S0 * r4.x + S1 * r4.y + S2 * r4.z + S3 * r4.w;
      y = red16(y);
      if (l16 == 0) ybuf[t2 * 16 + il] = y;
    }
    __syncthreads();
    {
      int t = c * 16 + tt;
      if (t < T) yraw[(size_t)(rowbase + t) * 512 + h * 64 + rg * 16 + cgp] = ybuf[tt * 16 + cgp];
    }
  }
  *(float4*)(s_out + i * 64 + j0) = float4{S0, S1, S2, S3};
  __syncthreads();
}

__device__ void attn_prompt_task(const Params& p, char* smem, int task) {
  const int tid = threadIdx.x, w = tid >> 6, lane = tid & 63, fr = lane & 15, fq = lane >> 4;
  int head = task & 7;
  int qt = (task >> 3) % 65;
  int b = task / (8 * 65);
  int kvh = head >> 2;
  u16* KV = (u16*)smem;
  u16* Ps = (u16*)(smem + 9216) + w * 16 * 200;
  const u16* projb = (const u16*)(p.ws + WS_C) + (size_t)b * LP * NIN;
  u16* mix = (u16*)(p.ws + WS_B);
  int q0 = qt * 64, kstart = q0 - 128;
  int qrow = min(q0 + w * 16 + fr, LP - 1);
  bf16x8 qa[2];
#pragma unroll
  for (int ks = 0; ks < 2; ++ks)
    qa[ks] = *(const bf16x8*)(projb + (size_t)qrow * NIN + 1792 + head * 64 + ks * 32 + fq * 8);
  f32x4 S[12];
#pragma unroll
  for (int i = 0; i < 12; ++i) S[i] = f32x4{0.f, 0.f, 0.f, 0.f};
#pragma unroll
  for (int kt = 0; kt < 3; ++kt) {
    {
      int key = tid >> 2, ch = tid & 3;
      int kp = min(max(kstart + kt * 64 + key, 0), LP - 1);
      const uint4* src = (const uint4*)(projb + (size_t)kp * NIN + 2304 + kvh * 64 + ch * 16);
      uint4 v0 = src[0], v1 = src[1];
      *(uint4*)(KV + key * 72 + ch * 16) = v0;
      *(uint4*)(KV + key * 72 + ch * 16 + 8) = v1;
    }
    __syncthreads();
#pragma unroll
    for (int n = 0; n < 4; ++n)
#pragma unroll
      for (int ks = 0; ks < 2; ++ks) {
        bf16x8 kb = *(const bf16x8*)(KV + (n * 16 + fr) * 72 + ks * 32 + fq * 8);
        S[kt * 4 + n] = mfma16(qa[ks], kb, S[kt * 4 + n]);
      }
    __syncthreads();
  }
  float sink = p.sinks[head];
#pragma unroll
  for (int j = 0; j < 4; ++j) {
    int qpos = q0 + w * 16 + fq * 4 + j;
    float mx = -1e30f;
#pragma unroll
    for (int T = 0; T < 12; ++T) {
      int kpos = kstart + T * 16 + fr;
      bool valid = (kpos >= 0) && (kpos <= qpos) && (qpos - kpos < 128);
      float s = valid ? S[T][j] * 0.125f : -1e30f;
      S[T][j] = s;
      mx = fmaxf(mx, s);
    }
    mx = redmax16(mx);
    mx = fmaxf(mx, sink);
    float sum = 0.f;
#pragma unroll
    for (int T = 0; T < 12; ++T) {
      float e = (S[T][j] > -1e29f) ? __expf(S[T][j] - mx) : 0.f;
      S[T][j] = e;
      sum += e;
    }
    sum = red16(sum) + __expf(sink - mx);
    float inv = 1.f / sum;
#pragma unroll
    for (int T = 0; T < 12; ++T) Ps[(fq * 4 + j) * 200 + T * 16 + fr] = f2bf(S[T][j] * inv);
  }
  f32x4 O[4];
#pragma unroll
  for (int i = 0; i < 4; ++i) O[i] = f32x4{0.f, 0.f, 0.f, 0.f};
#pragma unroll
  for (int kt = 0; kt < 3; ++kt) {
    {
      int key = tid >> 2, ch = tid & 3;
      int kp = min(max(kstart + kt * 64 + key, 0), LP - 1);
      const uint4* src = (const uint4*)(projb + (size_t)kp * NIN + 2432 + kvh * 64 + ch * 16);
      uint4 v0 = src[0], v1 = src[1];
      unsigned e[8] = {v0.x, v0.y, v0.z, v0.w, v1.x, v1.y, v1.z, v1.w};
#pragma unroll
      for (int i = 0; i < 8; ++i) {
        KV[(ch * 16 + 2 * i) * 72 + key] = (u16)(e[i] & 0xffffu);
        KV[(ch * 16 + 2 * i + 1) * 72 + key] = (u16)(e[i] >> 16);
      }
    }
    __syncthreads();
#pragma unroll
    for (int ks = 0; ks < 2; ++ks) {
      bf16x8 pa = *(const bf16x8*)(Ps + fr * 200 + kt * 64 + ks * 32 + fq * 8);
#pragma unroll
      for (int n = 0; n < 4; ++n) {
        bf16x8 vb = *(const bf16x8*)(KV + (n * 16 + fr) * 72 + ks * 32 + fq * 8);
        O[n] = mfma16(pa, vb, O[n]);
      }
    }
    __syncthreads();
  }
#pragma unroll
  for (int n = 0; n < 4; ++n)
#pragma unroll
    for (int j = 0; j < 4; ++j) {
      int q = q0 + w * 16 + fq * 4 + j;
      if (q < LP) mix[((size_t)(b * LP + q)) * 1024 + 512 + head * 64 + n * 16 + fr] = f2bf(O[n][j]);
    }
}

__device__ void attn_sample_task(const Params& p, char* smem, int task) {
  const int tid = threadIdx.x;
  int b = task >> 1, kvh = task & 1;
  const u16* proj = (const u16*)(p.ws + WS_C);
  u16* mix = (u16*)(p.ws + WS_B);
  float* Qs = (float*)smem;
  float* Sc = Qs + 1024;
  {
    int qr = tid >> 4, d4 = (tid & 15) * 4, g = qr >> 2, s = qr & 3;
    const u16* src = proj + (size_t)(TP + b * 4 + s) * NIN + 1792 + (kvh * 4 + g) * 64 + d4;
    uint2 v = *(const uint2*)src;
    *(float4*)(Qs + qr * 64 + d4) = float4{bflo(v.x) * 0.125f, bfhi(v.x) * 0.125f, bflo(v.y) * 0.125f, bfhi(v.y) * 0.125f};
  }
  __syncthreads();
  for (int idx = tid; idx < 132 * 16; idx += 256) {
    int kj = idx >> 4, qr = idx & 15, s = qr & 3;
    bool valid = (kj < 128) ? (kj > s) : (kj - 128 <= s);
    float acc = 0.f;
    const float* q = Qs + qr * 64;
    if (kj < 128) {
      const float4* kr = (const float4*)(p.cache_k + (((size_t)b * 128 + kj) * 2 + kvh) * 64);
#pragma unroll
      for (int d = 0; d < 16; ++d) {
        float4 kv = kr[d];
        acc += kv.x * q[d * 4] + kv.y * q[d * 4 + 1] + kv.z * q[d * 4 + 2] + kv.w * q[d * 4 + 3];
      }
    } else {
      const uint2* kr = (const uint2*)(proj + (size_t)(TP + b * 4 + kj - 128) * NIN + 2304 + kvh * 64);
#pragma unroll
      for (int d = 0; d < 16; ++d) {
        uint2 kv = kr[d];
        acc += bflo(kv.x) * q[d * 4] + bfhi(kv.x) * q[d * 4 + 1] + bflo(kv.y) * q[d * 4 + 2] + bfhi(kv.y) * q[d * 4 + 3];
      }
    }
    Sc[qr * 136 + kj] = valid ? acc : -1e30f;
  }
  __syncthreads();
  {
    int qr = tid >> 4, l = tid & 15, g = qr >> 2;
    float sink = p.sinks[kvh * 4 + g];
    float mx = -1e30f;
    for (int kj = l; kj < 132; kj += 16) mx = fmaxf(mx, Sc[qr * 136 + kj]);
    mx = redmax16(mx);
    mx = fmaxf(mx, sink);
    float sum = 0.f;
    for (int kj = l; kj < 132; kj += 16) {
      float s = Sc[qr * 136 + kj];
      float e = (s > -1e29f) ? __expf(s - mx) : 0.f;
      Sc[qr * 136 + kj] = e;
      sum += e;
    }
    sum = red16(sum) + __expf(sink - mx);
    float inv = 1.f / sum;
    for (int kj = l; kj < 132; kj += 16) Sc[qr * 136 + kj] *= inv;
  }
  __syncthreads();
  {
    int qr = tid >> 4, d4 = (tid & 15) * 4, g = qr >> 2, s = qr & 3;
    float4 o = {0.f, 0.f, 0.f, 0.f};
    for (int kj = 0; kj < 128; ++kj) {
      float pw = Sc[qr * 136 + kj];
      float4 v = *(const float4*)(p.cache_v + (((size_t)b * 128 + kj) * 2 + kvh) * 64 + d4);
      o.x += pw * v.x; o.y += pw * v.y; o.z += pw * v.z; o.w += pw * v.w;
    }
    for (int kj = 128; kj < 132; ++kj) {
      float pw = Sc[qr * 136 + kj];
      uint2 v = *(const uint2*)(proj + (size_t)(TP + b * 4 + kj - 128) * NIN + 2432 + kvh * 64 + d4);
      o.x += pw * bflo(v.x); o.y += pw * bfhi(v.x); o.z += pw * bflo(v.y); o.w += pw * bfhi(v.y);
    }
    *(uint2*)(mix + (size_t)(TP + b * 4 + s) * 1024 + 512 + (kvh * 4 + g) * 64 + d4) =
        uint2{pack2bf(o.x, o.y), pack2bf(o.z, o.w)};
  }
  __syncthreads();
}

__device__ void phase4(const Params& p, char* smem) {
  constexpr int N_PS = 128, N_SS = 4096, N_AP = NB * 65 * 8, N_AS = 256;
  int first, stride;
  if (gridDim.x >= 2 * N_PS) {
    if ((int)blockIdx.x < N_PS) {
      int t = blockIdx.x;
      int seq = t >> 2, rg = t & 3, b = seq >> 3, h = seq & 7;
      scan_task(p, smem, b * LP, LP, -1, h, rg, nullptr, p.out + O_WKVP + (size_t)seq * 4096);
      return;
    }
    first = N_PS + (blockIdx.x - N_PS);
    stride = gridDim.x - N_PS;
  } else {
    first = blockIdx.x;
    stride = gridDim.x;
  }
  for (int task = first; task < N_PS + N_SS + N_AP + N_AS; task += stride) {
    int t = task;
    if (t < N_PS) {
      int seq = t >> 2, rg = t & 3, b = seq >> 3, h = seq & 7;
      scan_task(p, smem, b * LP, LP, -1, h, rg, nullptr, p.out + O_WKVP + (size_t)seq * 4096);
      continue;
    }
    t -= N_PS;
    if (t < N_SS) {
      int seq = t >> 2, rg = t & 3, b = seq >> 3, h = seq & 7;
      scan_task(p, smem, TP + b * 4, 4, PREV0 + b, h, rg, p.state_wkv + (size_t)seq * 4096,
                p.out + O_WKVS + (size_t)seq * 4096);
      continue;
    }
    t -= N_SS;
    if (t < N_AP) { attn_prompt_task(p, smem, t); continue; }
    t -= N_AP;
    attn_sample_task(p, smem, t);
  }
}

__device__ void post_task(const Params& p, int task) {
  const int wave = threadIdx.x >> 6, lane = threadIdx.x & 63;
  int row = task * 4 + wave;
  if (row >= TTOK) return;
  const u16* proj = (const u16*)(p.ws + WS_C);
  const float* yraw = (const float*)(p.ws + WS_E);
  const u16* ab = (const u16*)(p.ws + WS_A);
  const u16* gb = (const u16*)(p.ws + WS_G);
  u16* mix = (u16*)(p.ws + WS_B);
  int prow;
  if (row < TP) { int t = row % LP; prow = t > 0 ? row - 1 : -1; }
  else { int r = row - TP; prow = (r & 3) ? row - 1 : PREV0 + (r >> 2); }
  int c0 = lane * 8;
  float y[8];
  {
    float4 a = *(const float4*)(yraw + (size_t)row * 512 + c0), bq = *(const float4*)(yraw + (size_t)row * 512 + c0 + 4);
    y[0] = a.x; y[1] = a.y; y[2] = a.z; y[3] = a.w; y[4] = bq.x; y[5] = bq.y; y[6] = bq.z; y[7] = bq.w;
  }
  float s = 0.f;
#pragma unroll
  for (int e = 0; e < 8; ++e) s += y[e];
  float mean = red8(s) * (1.f / 64.f);
  float vs = 0.f;
#pragma unroll
  for (int e = 0; e < 8; ++e) { float d = y[e] - mean; vs += d * d; }
  float rstd = rsqrtf(red8(vs) * (1.f / 64.f) + 64e-5f);
  float xr[8], xk[8], xv[8];
  auto ld8 = [&](int coff, float* o) {
    uint4 a = *(const uint4*)(proj + (size_t)row * NIN + coff + c0);
    uint4 q = prow >= 0 ? *(const uint4*)(proj + (size_t)prow * NIN + coff + c0) : uint4{0, 0, 0, 0};
    unsigned ua[4] = {a.x, a.y, a.z, a.w}, uq[4] = {q.x, q.y, q.z, q.w};
#pragma unroll
    for (int e = 0; e < 4; ++e) {
      float x0 = bflo(ua[e]), x1 = bfhi(ua[e]), p0 = bflo(uq[e]), p1 = bfhi(uq[e]);
      float m0 = p.mu[coff + c0 + 2 * e], m1 = p.mu[coff + c0 + 2 * e + 1];
      o[2 * e] = x0 + (p0 - x0) * m0;
      o[2 * e + 1] = x1 + (p1 - x1) * m1;
    }
  };
  ld8(0, xr);
  ld8(512, xk);
  ld8(1024, xv);
  float aa[8], gg[8];
  {
    uint4 a = *(const uint4*)(ab + (size_t)row * 512 + c0), g = *(const uint4*)(gb + (size_t)row * 512 + c0);
    unsigned ua[4] = {a.x, a.y, a.z, a.w}, ug[4] = {g.x, g.y, g.z, g.w};
#pragma unroll
    for (int e = 0; e < 4; ++e) {
      aa[2 * e] = bflo(ua[e]); aa[2 * e + 1] = bfhi(ua[e]);
      gg[2 * e] = bflo(ug[e]); gg[2 * e + 1] = bfhi(ug[e]);
    }
  }
  float bs = 0.f;
#pragma unroll
  for (int e = 0; e < 8; ++e) {
    float km = xk[e] * (1.f + (aa[e] - 1.f) * p.k_a[c0 + e]);
    bs += xr[e] * km * p.r_k[c0 + e];
  }
  bs = red8(bs);
  unsigned o[4];
#pragma unroll
  for (int e = 0; e < 4; ++e) {
    float v0 = ((y[2 * e] - mean) * rstd * p.lnx_w[c0 + 2 * e] + p.lnx_b[c0 + 2 * e] + bs * xv[2 * e]) * gg[2 * e];
    float v1 = ((y[2 * e + 1] - mean) * rstd * p.lnx_w[c0 + 2 * e + 1] + p.lnx_b[c0 + 2 * e + 1] + bs * xv[2 * e + 1]) *
               gg[2 * e + 1];
    o[e] = pack2bf(v0, v1);
  }
  *(uint4*)(mix + (size_t)row * 1024 + c0) = uint4{o[0], o[1], o[2], o[3]};
}

__device__ void phase5(const Params& p) {
  for (int task = blockIdx.x; task < TTOK / 4; task += gridDim.x) post_task(p, task);
}

__device__ void phase6(const Params& p, char* smem) {
  const u16* mix = (const u16*)(p.ws + WS_B);
  const u16* wt = (const u16*)(p.ws + WS_WOUT);
  constexpr int MT = NOUT / 128, NT = 8;
  constexpr int N_CV = 32768 / 4;
  const int wave = threadIdx.x >> 6, lane = threadIdx.x & 63;
  for (int task = blockIdx.x; task < MT * NT + N_CV; task += gridDim.x) {
    if (task < MT * NT) {
      int mt = task / NT, nt = task % NT;
      int o0 = mt * 128;
      int arow = o0 + (o0 < 16384 ? 16 * (o0 / 4096 + 1) : 64);
      const float* xin = (o0 < 16384 ? p.x_prompt + (size_t)o0 * D : p.x_sample + (size_t)(o0 - 16384) * D) + nt * 128;
      float* xo = p.out + (size_t)o0 * D + nt * 128;
      gemm_tile(mix + (size_t)arow * 1024, 1024, wt + (size_t)nt * 128 * 1024, 1024, 1024, smem,
                [&](int r, int c, float v) { xo[(size_t)r * D + c] = xin[(size_t)r * D + c] + v; });
    } else {
      int r = (task - MT * NT) * 4 + wave;
      const float* src = (r < 16384 ? p.eu + (size_t)r * 1024 : p.ev + (size_t)(r - 16384) * 1024) + lane * 16;
      float4 x[4];
      float am = 0.f;
#pragma unroll
      for (int i = 0; i < 4; ++i) {
        x[i] = ((const float4*)src)[i];
        am = fmaxf(am, fmaxf(fmaxf(fabsf(x[i].x), fabsf(x[i].y)), fmaxf(fabsf(x[i].z), fabsf(x[i].w))));
      }
      am = redmax16(am);
      am = fmaxf(fmaxf(rdlane(am, 0), rdlane(am, 16)), fmaxf(rdlane(am, 32), rdlane(am, 48)));
      float scale = am > 0.f ? 384.f / am : 1.f;
      float inv = am > 0.f ? am * (1.f / 384.f) : 1.f;
      unsigned wd[4];
#pragma unroll
      for (int i = 0; i < 4; ++i) {
        int w = 0;
        w = __builtin_amdgcn_cvt_pk_fp8_f32(x[i].x * scale, x[i].y * scale, w, false);
        w = __builtin_amdgcn_cvt_pk_fp8_f32(x[i].z * scale, x[i].w * scale, w, true);
        wd[i] = (unsigned)w;
      }
      *(uint4*)((unsigned char*)(p.ws + WS_EU) + (size_t)r * 1024 + lane * 16) = uint4{wd[0], wd[1], wd[2], wd[3]};
      if (lane == 0) ((float*)(p.ws + WS_SCU))[r] = inv;
    }
  }
}

__device__ void phase7(const Params& p) {
  const int wave = threadIdx.x >> 6, lane = threadIdx.x & 63;
  u16* h2 = (u16*)(p.ws + WS_B);
  u16* h2h = (u16*)(p.ws + WS_E);
  for (int task = blockIdx.x; task < NOUT / 4; task += gridDim.x) {
    int o = task * 4 + wave;
    const float* src = p.out + (size_t)o * D;
    float4 v[4];
    float ss = 0.f;
#pragma unroll
    for (int i = 0; i < 4; ++i) {
      v[i] = ((const float4*)src)[i * 64 + lane];
      ss += v[i].x * v[i].x + v[i].y * v[i].y + v[i].z * v[i].z + v[i].w * v[i].w;
    }
    ss = wave_sum(ss);
    float sc = rsqrtf(ss * (1.f / 1024.f) + 1e-5f);
#pragma unroll
    for (int i = 0; i < 4; ++i) {
      float4 g = ((const float4*)p.norm2_g)[i * 64 + lane];
      float y0 = v[i].x * sc * g.x, y1 = v[i].y * sc * g.y, y2 = v[i].z * sc * g.z, y3 = v[i].w * sc * g.w;
      *(uint2*)(h2 + (size_t)o * D + (i * 64 + lane) * 4) = uint2{pack2bf(y0, y1), pack2bf(y2, y3)};
      *(uint2*)(h2h + (size_t)o * D + (i * 64 + lane) * 4) =
          uint2{(unsigned)f2h(y0) | ((unsigned)f2h(y1) << 16), (unsigned)f2h(y2) | ((unsigned)f2h(y3) << 16)};
    }
  }
}

__device__ void phase8(const Params& p, char* smem) {
  const u16* h2 = (const u16*)(p.ws + WS_B);
  const u16* wt = (const u16*)(p.ws + WS_WQ);
  u16* q = (u16*)(p.ws + WS_Q);
  constexpr int MT = NOUT / 128, NT = 16;
  for (int tile = blockIdx.x; tile < MT * NT; tile += gridDim.x) {
    int mt = tile / NT, nt = tile % NT;
    u16* crow = q + (size_t)mt * 128 * 2048 + nt * 128;
    gemm_tile(h2 + (size_t)mt * 128 * D, D, wt + (size_t)nt * 128 * D, D, D, smem,
              [&](int r, int c, float v) { crow[(size_t)r * 2048 + c] = f2bf(v); });
  }
}

__device__ __forceinline__ unsigned ford(float f) {
  unsigned u = __float_as_uint(f);
  return (u & 0x80000000u) ? ~u : (u | 0x80000000u);
}
__device__ __forceinline__ float fdeord(unsigned k) {
  unsigned u = (k & 0x80000000u) ? (k & 0x7fffffffu) : ~k;
  return __uint_as_float(u);
}
__device__ __forceinline__ unsigned umax_(unsigned a, unsigned b) { return a > b ? a : b; }
__device__ __forceinline__ unsigned umin_(unsigned a, unsigned b) { return a < b ? a : b; }

#define CE_DESC(a, b) { unsigned _x = umax_(a, b), _y = umin_(a, b); a = _x; b = _y; }
#define CE_ASC(a, b) { unsigned _x = umin_(a, b), _y = umax_(a, b); a = _x; b = _y; }

template <int N>
__device__ __forceinline__ void bitonic_sort_desc(unsigned (&k)[N]) {
#pragma unroll
  for (int sz = 2; sz <= N; sz <<= 1) {
#pragma unroll
    for (int st = sz >> 1; st > 0; st >>= 1) {
#pragma unroll
      for (int i = 0; i < N; ++i) {
        int l = i ^ st;
        if (l > i) {
          if ((i & sz) == 0) CE_DESC(k[i], k[l]) else CE_ASC(k[i], k[l])
        }
      }
    }
  }
}
template <int N>
__device__ __forceinline__ void bitonic_merge_desc(unsigned (&k)[N]) {
#pragma unroll
  for (int st = N >> 1; st > 0; st >>= 1) {
#pragma unroll
    for (int i = 0; i < N; ++i) {
      int l = i ^ st;
      if (l > i) CE_DESC(k[i], k[l])
    }
  }
}
__device__ __forceinline__ void cross_merge16(unsigned (&k)[16]) {
#pragma unroll
  for (int x = 16; x <= 32; x <<= 1) {
    unsigned o[16];
#pragma unroll
    for (int i = 0; i < 16; ++i) o[i] = (unsigned)__shfl_xor((int)k[i], x, 64);
#pragma unroll
    for (int i = 0; i < 16; ++i) k[i] = umax_(k[i], o[15 - i]);
    bitonic_merge_desc<16>(k);
  }
}

__device__ void topk_unit(const Params& p, char* smem, int tg, int h) {
  const int tid = threadIdx.x, w = tid >> 6, lane = tid & 63, fr = lane & 15, fq = lane >> 4;
  const u16* q = (const u16*)(p.ws + WS_Q);
  const u16* subk = (const u16*)(p.ws + WS_SUBK);
  int* idxo = (int*)(p.ws + WS_IDX);
  float* gateo = (float*)(p.ws + WS_GATE);
  int* il = (int*)smem + w * 512;
  const int o0 = tg * 16;
  unsigned s1[16], s2[16];
#pragma unroll
  for (int c = 0; c < 2; ++c) {
    f32x4 acc[8];
#pragma unroll
    for (int i = 0; i < 8; ++i) acc[i] = f32x4{0.f, 0.f, 0.f, 0.f};
#pragma unroll
    for (int ks = 0; ks < 4; ++ks) {
      bf16x8 qb = *(const bf16x8*)(q + (size_t)(o0 + fr) * 2048 + (h * 2 + c) * 128 + ks * 32 + fq * 8);
#pragma unroll
      for (int mt = 0; mt < 8; ++mt) {
        bf16x8 ka = *(const bf16x8*)(subk + ((size_t)(c * 128 + mt * 16 + fr)) * 128 + ks * 32 + fq * 8);
        acc[mt] = mfma16(ka, qb, acc[mt]);
      }
    }
    unsigned lo[16], hi[16];
#pragma unroll
    for (int mt = 0; mt < 4; ++mt)
#pragma unroll
      for (int j = 0; j < 4; ++j) {
        lo[mt * 4 + j] = (ford(acc[mt][j]) & 0xffffff80u) | (unsigned)(127 - (mt * 16 + fq * 4 + j));
        hi[mt * 4 + j] = (ford(acc[mt + 4][j]) & 0xffffff80u) | (unsigned)(127 - ((mt + 4) * 16 + fq * 4 + j));
      }
    bitonic_sort_desc<16>(lo);
    bitonic_sort_desc<16>(hi);
#pragma unroll
    for (int i = 0; i < 16; ++i) lo[i] = umax_(lo[i], hi[15 - i]);
    bitonic_merge_desc<16>(lo);
    cross_merge16(lo);
    if (fq == 0) {
#pragma unroll
      for (int i = 0; i < 16; ++i) il[fr * 32 + c * 16 + i] = 127 - (int)(lo[i] & 0x7fu);
    }
#pragma unroll
    for (int i = 0; i < 16; ++i) {
      if (c == 0) s1[i] = lo[i]; else s2[i] = lo[i];
    }
  }
  float v1[16], v2[16];
#pragma unroll
  for (int i = 0; i < 16; ++i) {
    v1[i] = fdeord(s1[i] & 0xffffff80u);
    v2[i] = fdeord(s2[i] & 0xffffff80u);
  }
  unsigned ck[16];
#define CAND(i, j) ((ford(v1[i] + v2[j]) & 0xffffff00u) | (unsigned)((i) * 16 + (j)))
#define SEL4(slot, A, B, C, Dv) ck[slot] = (fq == 0) ? (A) : (fq == 1) ? (B) : (fq == 2) ? (C) : (Dv);
  SEL4(0, CAND(0, 0), CAND(1, 0), CAND(3, 3), CAND(14, 0))
  SEL4(1, CAND(0, 1), CAND(1, 1), CAND(4, 0), CAND(15, 0))
  SEL4(2, CAND(0, 2), CAND(1, 2), CAND(4, 1), 0u)
  SEL4(3, CAND(0, 3), CAND(1, 3), CAND(4, 2), 0u)
  SEL4(4, CAND(0, 4), CAND(1, 4), CAND(5, 0), 0u)
  SEL4(5, CAND(0, 5), CAND(1, 5), CAND(5, 1), 0u)
  SEL4(6, CAND(0, 6), CAND(1, 6), CAND(6, 0), 0u)
  SEL4(7, CAND(0, 7), CAND(1, 7), CAND(6, 1), 0u)
  SEL4(8, CAND(0, 8), CAND(2, 0), CAND(7, 0), 0u)
  SEL4(9, CAND(0, 9), CAND(2, 1), CAND(7, 1), 0u)
  SEL4(10, CAND(0, 10), CAND(2, 2), CAND(8, 0), 0u)
  SEL4(11, CAND(0, 11), CAND(2, 3), CAND(9, 0), 0u)
  SEL4(12, CAND(0, 12), CAND(2, 4), CAND(10, 0), 0u)
  SEL4(13, CAND(0, 13), CAND(3, 0), CAND(11, 0), 0u)
  SEL4(14, CAND(0, 14), CAND(3, 1), CAND(12, 0), 0u)
  SEL4(15, CAND(0, 15), CAND(3, 2), CAND(13, 0), 0u)
#undef SEL4
#undef CAND
  bitonic_sort_desc<16>(ck);
  cross_merge16(ck);
  float top[16], esum = 0.f;
#pragma unroll
  for (int i = 0; i < 16; ++i) top[i] = fdeord(ck[i] & 0xffffff00u);
  const float tmax = top[0];
#pragma unroll
  for (int i = 0; i < 16; ++i) top[i] = __expf(top[i] - tmax);
#pragma unroll
  for (int i = 0; i < 16; ++i) esum += top[i];
  float inv = 1.f / esum;
  int oi[4];
  float og[4];
#pragma unroll
  for (int jj = 0; jj < 4; ++jj) {
    unsigned kk = (fq == 0) ? ck[jj] : (fq == 1) ? ck[4 + jj] : (fq == 2) ? ck[8 + jj] : ck[12 + jj];
    float tv = (fq == 0) ? top[jj] : (fq == 1) ? top[4 + jj] : (fq == 2) ? top[8 + jj] : top[12 + jj];
    int code = (int)(kk & 0xffu);
    int i1 = il[fr * 32 + (code >> 4)], i2 = il[fr * 32 + 16 + (code & 15)];
    oi[jj] = i1 * 128 + i2;
    og[jj] = tv * inv;
  }
  size_t ob = (size_t)(o0 + fr) * 128 + h * 16 + fq * 4;
  *(int4*)(idxo + ob) = int4{oi[0], oi[1], oi[2], oi[3]};
  *(float4*)(gateo + ob) = float4{og[0], og[1], og[2], og[3]};
}

__device__ void phase9(const Params& p, char* smem) {
  const int w = threadIdx.x >> 6;
  for (int task = blockIdx.x; task < (NOUT / 16) * 2; task += gridDim.x) {
    int tg = task >> 1, h = (task & 1) * 4 + w;
    topk_unit(p, smem, tg, h);
  }
}

__device__ __forceinline__ float dot16f8(const float* h, uint4 u, float acc) {
  unsigned w[4] = {u.x, u.y, u.z, u.w};
#pragma unroll
  for (int i = 0; i < 4; ++i) {
    float2v lo = __builtin_amdgcn_cvt_pk_f32_fp8((int)w[i], false);
    float2v hi = __builtin_amdgcn_cvt_pk_f32_fp8((int)w[i], true);
    acc = fmaf(h[4 * i], lo.x, acc);
    acc = fmaf(h[4 * i + 1], lo.y, acc);
    acc = fmaf(h[4 * i + 2], hi.x, acc);
    acc = fmaf(h[4 * i + 3], hi.y, acc);
  }
  return acc;
}
__device__ __forceinline__ void axpy16f8(float a, uint4 v, float* acc) {
  unsigned w[4] = {v.x, v.y, v.z, v.w};
#pragma unroll
  for (int i = 0; i < 4; ++i) {
    float2v lo = __builtin_amdgcn_cvt_pk_f32_fp8((int)w[i], false);
    float2v hi = __builtin_amdgcn_cvt_pk_f32_fp8((int)w[i], true);
    acc[4 * i] = fmaf(a, lo.x, acc[4 * i]);
    acc[4 * i + 1] = fmaf(a, lo.y, acc[4 * i + 1]);
    acc[4 * i + 2] = fmaf(a, hi.x, acc[4 * i + 2]);
    acc[4 * i + 3] = fmaf(a, hi.y, acc[4 * i + 3]);
  }
}
__device__ __forceinline__ float reduce4(float d0, float d1, float d2, float d3) {
  auto s1 = __builtin_amdgcn_permlane32_swap(__float_as_uint(d0), __float_as_uint(d1), false, false);
  float s01 = __uint_as_float(s1[0]) + __uint_as_float(s1[1]);
  auto s2 = __builtin_amdgcn_permlane32_swap(__float_as_uint(d2), __float_as_uint(d3), false, false);
  float s23 = __uint_as_float(s2[0]) + __uint_as_float(s2[1]);
  auto s3 = __builtin_amdgcn_permlane16_swap(__float_as_uint(s01), __float_as_uint(s23), false, false);
  float t = __uint_as_float(s3[0]) + __uint_as_float(s3[1]);
  return red16(t);
}

__device__ void gather_task(const Params& p, int task) {
  const int wave = threadIdx.x >> 6, lane = threadIdx.x & 63;
  int o = task * 4 + wave;
  const u16* h2h = (const u16*)(p.ws + WS_E);
  const unsigned char* eu8 = (const unsigned char*)(p.ws + WS_EU) + lane * 16;
  const unsigned char* ev8 = (const unsigned char*)(p.ws + WS_EV) + lane * 16;
  const float* scu = (const float*)(p.ws + WS_SCU);
  const float* scv = (const float*)(p.ws + WS_SCV);
  const int* idx = (const int*)(p.ws + WS_IDX) + (size_t)o * 128;
  const float* gate = (const float*)(p.ws + WS_GATE) + (size_t)o * 128;
  float hf[16];
  {
    const uint4* hrow = (const uint4*)(h2h + (size_t)o * 1024 + lane * 16);
    uint4 h0 = hrow[0], h1 = hrow[1];
    unsigned hw[8] = {h0.x, h0.y, h0.z, h0.w, h1.x, h1.y, h1.z, h1.w};
#pragma unroll
    for (int i = 0; i < 8; ++i) {
      half2v hh = __builtin_bit_cast(half2v, hw[i]);
      hf[2 * i] = (float)hh[0];
      hf[2 * i + 1] = (float)hh[1];
    }
  }
  float acc[16];
#pragma unroll
  for (int i = 0; i < 16; ++i) acc[i] = 0.f;
  const int rw = lane >> 4;
  const int kl = (lane & 3) * 4 + ((rw == 1) ? 2 : (rw == 2) ? 1 : rw);
  for (int kb = 0; kb < 8; ++kb) {
    int myidx = idx[kb * 16 + (lane & 15)];
    int myidx2 = idx[kb * 16 + kl];
    float mygate = gate[kb * 16 + kl];
    float su = scu[myidx2], sv = scv[myidx2];
    float mypre = 0.f;
#pragma unroll
    for (int e4 = 0; e4 < 4; ++e4) {
      uint4 ua[4];
#pragma unroll
      for (int e = 0; e < 4; ++e) {
        int ei = __builtin_amdgcn_readlane(myidx, e4 * 4 + e);
        ua[e] = *(const uint4*)(eu8 + (size_t)ei * 1024);
      }
      float d[4];
#pragma unroll
      for (int e = 0; e < 4; ++e) d[e] = dot16f8(hf, ua[e], 0.f);
      float tot = reduce4(d[0], d[1], d[2], d[3]);
      mypre = ((lane & 3) == e4) ? tot : mypre;
    }
    mypre *= su;
    float myact = 0.5f * mypre * (1.f + erff(mypre * 0.70710678118654752f)) * mygate * sv;
#pragma unroll
    for (int e4 = 0; e4 < 4; ++e4) {
      uint4 va[4];
      float a[4];
#pragma unroll
      for (int e = 0; e < 4; ++e) {
        int ei = __builtin_amdgcn_readlane(myidx, e4 * 4 + e);
        const int pr = (e == 1) ? 2 : (e == 2) ? 1 : e;
        a[e] = rdlane(myact, pr * 16 + e4);
        va[e] = *(const uint4*)(ev8 + (size_t)ei * 1024);
      }
#pragma unroll
      for (int e = 0; e < 4; ++e) axpy16f8(a[e], va[e], acc);
    }
  }
  float* xrow = p.out + (size_t)o * D + lane * 16;
  float x[16];
#pragma unroll
  for (int i = 0; i < 4; ++i) {
    float4 a = ((const float4*)xrow)[i];
    x[4 * i] = a.x; x[4 * i + 1] = a.y; x[4 * i + 2] = a.z; x[4 * i + 3] = a.w;
  }
  float ss = 0.f;
#pragma unroll
  for (int i = 0; i < 16; ++i) { x[i] += acc[i]; ss += x[i] * x[i]; }
  ss = wave_sum(ss);
  float sc = rsqrtf(ss * (1.f / 1024.f) + 1e-5f);
  const float* g = p.final_g + lane * 16;
#pragma unroll
  for (int i = 0; i < 4; ++i) {
    float4 gg = ((const float4*)g)[i];
    ((float4*)xrow)[i] = float4{x[4 * i] * sc * gg.x, x[4 * i + 1] * sc * gg.y, x[4 * i + 2] * sc * gg.z, x[4 * i + 3] * sc * gg.w};
  }
}

__device__ void phase10(const Params& p) {
  for (int task = blockIdx.x; task < NOUT / 4; task += gridDim.x) gather_task(p, task);
}

template <int PH>
__device__ __forceinline__ void run_phase(const Params& p, char* smem) {
  if constexpr (PH == 0) phase0(p, smem);
  if constexpr (PH == 1) phase1(p, smem);
  if constexpr (PH == 2) phase2(p);
  if constexpr (PH == 3) phase3(p, smem);
  if constexpr (PH == 4) phase4(p, smem);
  if constexpr (PH == 5) phase5(p);
  if constexpr (PH == 6) phase6(p, smem);
  if constexpr (PH == 7) phase7(p);
  if constexpr (PH == 8) phase8(p, smem);
  if constexpr (PH == 9) phase9(p, smem);
  if constexpr (PH == 10) phase10(p);
}

template <int LO, int HI>
__device__ __forceinline__ void run_range(const Params& p, char* smem) {
  if constexpr (LO < HI) {
    run_phase<LO>(p, smem);
    if constexpr (LO + 1 < HI) {
      cg::this_grid().sync();
      run_range<LO + 1, HI>(p, smem);
    }
  }
}

template <int LO, int HI>
__global__ void __launch_bounds__(256, 2) fwd_kernel(Params p) {
  __shared__ __attribute__((aligned(16))) char smem[SMEM_BYTES];
  run_range<LO, HI>(p, smem);
}

template <int PH>
static void launch_one(const Params& p, int grid, hipStream_t stream) {
  fwd_kernel<PH, PH + 1><<<grid, 256, 0, stream>>>(p);
}

extern "C" void kernel_launch(void* const* d_in, const int* in_sizes, int n_in, void* d_out, int out_size, void* d_ws,
                              size_t ws_size, hipStream_t stream) {
  Params p{};
  const float** pp = (const float**)&p;
  for (int i = 0; i < 28; ++i) pp[i] = (const float*)d_in[i];
  p.out = (float*)d_out;
  p.ws = (char*)d_ws;
#if MULTI_LAUNCH
  const int grid = 1024;
  launch_one<0>(p, grid, stream);
  launch_one<1>(p, grid, stream);
  launch_one<2>(p, grid, stream);
  launch_one<3>(p, grid, stream);
  launch_one<4>(p, grid, stream);
  launch_one<5>(p, grid, stream);
  launch_one<6>(p, grid, stream);
  launch_one<7>(p, grid, stream);
  launch_one<8>(p, grid, stream);
  launch_one<9>(p, grid, stream);
  launch_one<10>(p, grid, stream);
#else
  static int grid_blocks = 0;
  if (!grid_blocks) {
    int dev = 0, cus = 0, per_cu = 0;
    (void)hipGetDevice(&dev);
    (void)hipDeviceGetAttribute(&cus, hipDeviceAttributeMultiprocessorCount, dev);
    (void)hipOccupancyMaxActiveBlocksPerMultiprocessor(&per_cu, fwd_kernel<0, NPH>, 256, 0);
    if (per_cu < 1) per_cu = 1;
    if (per_cu > 4) per_cu = 4;
    grid_blocks = cus * per_cu;
  }
  void* args[] = {&p};
  hipError_t e = hipLaunchCooperativeKernel((void*)fwd_kernel<0, NPH>, dim3(grid_blocks), dim3(256), args, 0, stream);
  if (e != hipSuccess) fprintf(stderr, "cooperative launch failed: %s (grid %d)\n", hipGetErrorString(e), grid_blocks);
#endif
}
```

```cpp
#include <hip/hip_runtime.h>
#include <hip/hip_cooperative_groups.h>
#include <cstdio>
#include <cstdint>
namespace cg = cooperative_groups;

typedef unsigned short u16;
using bf16x8 = __attribute__((ext_vector_type(8))) short;
using f32x4 = __attribute__((ext_vector_type(4))) float;
using half2v = __attribute__((ext_vector_type(2))) _Float16;
using float2v = __attribute__((ext_vector_type(2))) float;

#ifndef MULTI_LAUNCH
#define MULTI_LAUNCH 0
#endif

constexpr int D = 1024, NIN = 2560;
constexpr int LP = 4112, NB = 4, TP = NB * LP;
constexpr int SB = 128, TS = 512;
constexpr int TTOK = TP + TS;
constexpr int PREV0 = TTOK;
constexpr int MROWS = 17152;
constexpr int TPAD = 17024;
constexpr int NOUT = 16896;
constexpr int PAST = 8192;
constexpr int NPH = 11;

constexpr size_t O_YP = 0;
constexpr size_t O_KWP = 17301504, O_VWP = 17367040, O_WKVP = 17432576, O_SHP = 17563648;
constexpr size_t O_KWS = 17567744, O_VWS = 19664896, O_WKVS = 21762048, O_SHS = 25956352;

constexpr size_t WS_WIN = 0;
constexpr size_t WS_WOUT = WS_WIN + 2560ull * 1024 * 2;
constexpr size_t WS_WQ = WS_WOUT + 1024ull * 1024 * 2;
constexpr size_t WS_SUBK = WS_WQ + 2048ull * 1024 * 2;
constexpr size_t WS_W2W = WS_SUBK + 2ull * 128 * 128 * 2;
constexpr size_t WS_W2A = WS_W2W + 512ull * 64 * 2;
constexpr size_t WS_W2G = WS_W2A + 512ull * 64 * 2;
constexpr size_t WS_B = WS_W2G + 512ull * 128 * 2;
constexpr size_t WS_C = WS_B + (size_t)MROWS * 1024 * 2;
constexpr size_t WS_D = WS_C + (size_t)MROWS * NIN * 2;
constexpr size_t WS_E = WS_D + (size_t)TPAD * 512 * 8;
constexpr size_t WS_END = WS_E + (size_t)TPAD * 512 * 4;
constexpr size_t WS_DEC = WS_D, WS_A = WS_D + (size_t)TPAD * 512 * 4, WS_G = WS_A + (size_t)TPAD * 512 * 2;
constexpr size_t WS_EU = WS_E, WS_EV = WS_E + 16384ull * 512, WS_SCU = WS_EV + 16384ull * 512, WS_SCV = WS_SCU + 65536;
constexpr size_t WS_X1B = WS_D, WS_SSQ = WS_D + 40ull * 1024 * 1024;
constexpr size_t WS_Q = WS_C, WS_IDX = WS_C + (size_t)NOUT * 2048 * 2, WS_GATE = WS_IDX + (size_t)NOUT * 128 * 4;
static_assert(WS_SCV + 65536 <= WS_END, "expert tables overflow region E");
static_assert(WS_X1B + (size_t)NOUT * 2048 <= WS_SSQ && WS_SSQ + (size_t)NOUT * 64 <= WS_E, "x1b/ssq overflow region D");
static_assert(WS_GATE + (size_t)NOUT * 128 * 4 <= WS_D, "idx/gate overflow region C");
constexpr size_t WS_BAR = WS_END;
static_assert(WS_BAR + 32768 <= 256ull * 1024 * 1024, "workspace too large");

constexpr int SMEM_BYTES = 65536;

struct Params {
  const float *x_prompt, *x_sample, *cache_k, *cache_v, *state_wkv, *state_shift, *meta, *norm1_g, *w_in, *mu, *w0,
      *w2w, *a0, *w2a, *w2g, *k_k, *k_a, *r_k, *lnx_w, *lnx_b, *sinks, *w_out, *norm2_g, *w_query, *sub_keys, *eu,
      *ev, *final_g;
  float* out;
  char* ws;
  int full1, full8, full10, pad_;
};

__constant__ double INVF[8] = {1.0, 0.19392274474868576, 0.03760603093086393, 0.007292664737217109,
                               0.001414213562373095, 0.0002742481756762073, 5.318295896944988e-05,
                               1.031338537721246e-05};

__device__ __forceinline__ u16 f2bf(float f) {
  unsigned u = __float_as_uint(f);
  u += 0x7fffu + ((u >> 16) & 1u);
  return (u16)(u >> 16);
}
__device__ __forceinline__ float bf2f(u16 h) { return __uint_as_float(((unsigned)h) << 16); }
__device__ __forceinline__ float bflo(unsigned u) { return __uint_as_float(u << 16); }
__device__ __forceinline__ float bfhi(unsigned u) { return __uint_as_float(u & 0xffff0000u); }
__device__ __forceinline__ unsigned pack2bf(float a, float b) { return (unsigned)f2bf(a) | ((unsigned)f2bf(b) << 16); }
__device__ __forceinline__ u16 f2h(float f) {
  _Float16 h = (_Float16)f;
  return __builtin_bit_cast(u16, h);
}

template <int CTRL>
__device__ __forceinline__ float dppf(float x) {
  return __int_as_float(__builtin_amdgcn_update_dpp(0, __float_as_int(x), CTRL, 0xF, 0xF, false));
}
__device__ __forceinline__ float red4(float x) {
  x += dppf<0xB1>(x);
  x += dppf<0x4E>(x);
  return x;
}
__device__ __forceinline__ float red8(float x) {
  x = red4(x);
  x += dppf<0x141>(x);
  return x;
}
__device__ __forceinline__ float red16(float x) {
  x = red8(x);
  x += dppf<0x140>(x);
  return x;
}
__device__ __forceinline__ float redmax16(float x) {
  x = fmaxf(x, dppf<0xB1>(x));
  x = fmaxf(x, dppf<0x4E>(x));
  x = fmaxf(x, dppf<0x141>(x));
  x = fmaxf(x, dppf<0x140>(x));
  return x;
}
__device__ __forceinline__ float rdlane(float x, int l) {
  return __int_as_float(__builtin_amdgcn_readlane(__float_as_int(x), l));
}
__device__ __forceinline__ float wave_sum(float x) {
  x = red16(x);
  return rdlane(x, 0) + rdlane(x, 16) + rdlane(x, 32) + rdlane(x, 48);
}
__device__ __forceinline__ f32x4 mfma16(bf16x8 a, bf16x8 b, f32x4 c) {
  return __builtin_amdgcn_mfma_f32_16x16x32_bf16(a, b, c, 0, 0, 0);
}
__device__ __forceinline__ float sigmoidf_(float x) { return __builtin_amdgcn_rcpf(1.f + __expf(-x)); }

template <class Epi>
__device__ __forceinline__ void gemm_tile(const u16* __restrict__ A, int lda, const u16* __restrict__ Bt, int ldb, int K,
                                          char* smem, Epi epi) {
  const int tid = threadIdx.x, wid = tid >> 6, lane = tid & 63, wr = wid >> 1, wc = wid & 1, fr = lane & 15,
            fq = lane >> 4;
  f32x4 acc[4][4];
#pragma unroll
  for (int m = 0; m < 4; ++m)
#pragma unroll
    for (int n = 0; n < 4; ++n) acc[m][n] = f32x4{0.f, 0.f, 0.f, 0.f};
  const int nk = K / 64;
  auto stage = [&](int buf, int kt) {
    char* SA = smem + buf * 32768;
    char* SB = SA + 16384;
#pragma unroll
    for (int i = 0; i < 4; ++i) {
      int b = tid * 16 + i * 4096, r = b >> 7, pc = (b >> 4) & 7;
      int c = kt * 64 + ((pc ^ ((r >> 1) & 7)) << 3);
      __builtin_amdgcn_global_load_lds((const unsigned*)(A + (size_t)r * lda + c),
                                       (__attribute__((address_space(3))) unsigned*)(SA + b), 16, 0, 0);
      __builtin_amdgcn_global_load_lds((const unsigned*)(Bt + (size_t)r * ldb + c),
                                       (__attribute__((address_space(3))) unsigned*)(SB + b), 16, 0, 0);
    }
  };
  stage(0, 0);
  asm volatile("s_waitcnt vmcnt(0)" ::: "memory");
  __syncthreads();
  for (int kt = 0; kt < nk; ++kt) {
    const int cur = kt & 1;
    if (kt + 1 < nk) stage(cur ^ 1, kt + 1);
    const char* SA = smem + cur * 32768;
    const char* SB = SA + 16384;
#pragma unroll
    for (int ks = 0; ks < 2; ++ks) {
      bf16x8 At[4], Bl[4];
#pragma unroll
      for (int m = 0; m < 4; ++m) {
        int r = wr * 64 + m * 16 + fr;
        At[m] = *(const bf16x8*)(SA + r * 128 + (((ks * 4 + fq) ^ ((r >> 1) & 7)) << 4));
      }
#pragma unroll
      for (int n = 0; n < 4; ++n) {
        int r = wc * 64 + n * 16 + fr;
        Bl[n] = *(const bf16x8*)(SB + r * 128 + (((ks * 4 + fq) ^ ((r >> 1) & 7)) << 4));
      }
      __builtin_amdgcn_s_setprio(1);
#pragma unroll
      for (int m = 0; m < 4; ++m)
#pragma unroll
        for (int n = 0; n < 4; ++n) acc[m][n] = mfma16(Bl[n], At[m], acc[m][n]);
      __builtin_amdgcn_s_setprio(0);
    }
    asm volatile("s_waitcnt vmcnt(0)" ::: "memory");
    __syncthreads();
  }
#pragma unroll
  for (int m = 0; m < 4; ++m)
#pragma unroll
    for (int n = 0; n < 4; ++n) epi(m, wr * 64 + m * 16 + fr, wc * 64 + n * 16 + fq * 4, acc[m][n]);
}

template <class Epi>
__device__ __forceinline__ void gemm_qtile(const u16* __restrict__ A, int lda, const u16* __restrict__ Bt, int ldb, int K,
                                           char* smem, Epi epi) {
  const int tid = threadIdx.x, wid = tid >> 6, lane = tid & 63, fr = lane & 15, fq = lane >> 4;
  f32x4 acc[2][2];
#pragma unroll
  for (int m = 0; m < 2; ++m)
#pragma unroll
    for (int n = 0; n < 2; ++n) acc[m][n] = f32x4{0.f, 0.f, 0.f, 0.f};
  const int nk = K / 64;
  auto stage = [&](int buf, int kt) {
    char* SA = smem + buf * 32768;
    char* SB = SA + 16384;
    {
      int b = tid * 16, r = b >> 7, pc = (b >> 4) & 7;
      int c = kt * 64 + ((pc ^ ((r >> 1) & 7)) << 3);
      __builtin_amdgcn_global_load_lds((const unsigned*)(A + (size_t)r * lda + c),
                                       (__attribute__((address_space(3))) unsigned*)(SA + b), 16, 0, 0);
    }
#pragma unroll
    for (int i = 0; i < 4; ++i) {
      int b = tid * 16 + i * 4096, r = b >> 7, pc = (b >> 4) & 7;
      int c = kt * 64 + ((pc ^ ((r >> 1) & 7)) << 3);
      __builtin_amdgcn_global_load_lds((const unsigned*)(Bt + (size_t)r * ldb + c),
                                       (__attribute__((address_space(3))) unsigned*)(SB + b), 16, 0, 0);
    }
  };
  stage(0, 0);
  asm volatile("s_waitcnt vmcnt(0)" ::: "memory");
  __syncthreads();
  for (int kt = 0; kt < nk; ++kt) {
    const int cur = kt & 1;
    if (kt + 1 < nk) stage(cur ^ 1, kt + 1);
    const char* SA = smem + cur * 32768;
    const char* SB = SA + 16384;
#pragma unroll
    for (int ks = 0; ks < 2; ++ks) {
      bf16x8 At[2], Bl[2];
#pragma unroll
      for (int m = 0; m < 2; ++m) {
        int r = m * 16 + fr;
        At[m] = *(const bf16x8*)(SA + r * 128 + (((ks * 4 + fq) ^ ((r >> 1) & 7)) << 4));
      }
#pragma unroll
      for (int n = 0; n < 2; ++n) {
        int r = wid * 32 + n * 16 + fr;
        Bl[n] = *(const bf16x8*)(SB + r * 128 + (((ks * 4 + fq) ^ ((r >> 1) & 7)) << 4));
      }
#pragma unroll
      for (int m = 0; m < 2; ++m)
#pragma unroll
        for (int n = 0; n < 2; ++n) acc[m][n] = mfma16(Bl[n], At[m], acc[m][n]);
    }
    asm volatile("s_waitcnt vmcnt(0)" ::: "memory");
    __syncthreads();
  }
#pragma unroll
  for (int m = 0; m < 2; ++m)
#pragma unroll
    for (int n = 0; n < 2; ++n) epi(m, m * 16 + fr, wid * 32 + n * 16 + fq * 4, acc[m][n]);
}

__device__ __forceinline__ int xcd_vid() { return (blockIdx.x & 7) * (gridDim.x >> 3) + (blockIdx.x >> 3); }
__device__ __forceinline__ void grouped_tile(int t, int MT, int NT, int& mt, int& nt) {
  const int GM = 8;
  int per = GM * NT, gid = t / per, rem = t - gid * per;
  int first = gid * GM, gsz = min(MT - first, GM);
  mt = first + rem % gsz;
  nt = rem / gsz;
}

__device__ void transpose_task(const float* __restrict__ src, int K, int N, u16* __restrict__ dst, int tile, char* smem,
                               const float* __restrict__ kscale = nullptr) {
  const int tid = threadIdx.x;
  int tn = N / 64;
  int k0 = (tile / tn) * 64, n0 = (tile % tn) * 64;
  float* t = (float*)smem;
#pragma unroll 4
  for (int it = 0; it < 16; ++it) {
    int k = it * 4 + (tid >> 6), n = tid & 63;
    t[n * 65 + k] = src[(size_t)(k0 + k) * N + n0 + n] * (kscale ? kscale[k0 + k] : 1.f);
  }
  __syncthreads();
#pragma unroll 4
  for (int it = 0; it < 16; ++it) {
    int n = it * 4 + (tid >> 6), k = tid & 63;
    dst[(size_t)(n0 + n) * K + k0 + k] = f2bf(t[n * 65 + k]);
  }
  __syncthreads();
}

__device__ void norm1_task(const Params& p, int task) {
  const int wave = threadIdx.x >> 6, lane = threadIdx.x & 63;
  int row = task * 4 + wave;
  u16* h = (u16*)(p.ws + WS_B) + (size_t)row * D;
  const float* src = nullptr;
  bool donorm = true;
  float* shout = nullptr;
  if (row < TP) {
    int b = row / LP, t = row % LP;
    src = (t < 16) ? p.meta + (size_t)t * D : p.x_prompt + ((size_t)b * 4096 + (t - 16)) * D;
    if (t == LP - 1) shout = p.out + O_SHP + (size_t)b * D;
  } else if (row < TTOK) {
    int r = row - TP;
    src = p.x_sample + (size_t)r * D;
    if ((r & 3) == 3) shout = p.out + O_SHS + (size_t)(r >> 2) * D;
  } else if (row < TTOK + SB) {
    src = p.state_shift + (size_t)(row - TTOK) * D;
    donorm = false;
  }
  if (!src) {
#pragma unroll
    for (int i = 0; i < 4; ++i) *(uint2*)(h + (i * 64 + lane) * 4) = uint2{0u, 0u};
    return;
  }
  float4 v[4];
  float ss = 0.f;
#pragma unroll
  for (int i = 0; i < 4; ++i) {
    v[i] = ((const float4*)src)[i * 64 + lane];
    ss += v[i].x * v[i].x + v[i].y * v[i].y + v[i].z * v[i].z + v[i].w * v[i].w;
  }
  float sc = 1.f;
  if (donorm) {
    ss = wave_sum(ss);
    sc = rsqrtf(ss * (1.f / 1024.f) + 1e-5f);
  }
#pragma unroll
  for (int i = 0; i < 4; ++i) {
    float4 y = v[i];
    if (donorm) {
      float4 g = ((const float4*)p.norm1_g)[i * 64 + lane];
      y.x *= sc * g.x; y.y *= sc * g.y; y.z *= sc * g.z; y.w *= sc * g.w;
    }
    *(uint2*)(h + (i * 64 + lane) * 4) = uint2{pack2bf(y.x, y.y), pack2bf(y.z, y.w)};
    if (shout) ((float4*)shout)[i * 64 + lane] = y;
  }
}

__device__ void phase0(const Params& p, char* smem) {
  constexpr int N_NORM = MROWS / 4;
  constexpr int T_WIN = 16 * 40, T_WOUT = 16 * 16, T_WQ = 16 * 32, T_W2W = 8, T_W2A = 8, T_W2G = 16, T_SUBK = 32;
  constexpr int TOT = N_NORM + T_WIN + T_W2W + T_W2A + T_W2G + T_SUBK;
  for (int task = blockIdx.x; task < TOT; task += gridDim.x) {
    int t = task;
    if (t < N_NORM) { norm1_task(p, t); continue; }
    t -= N_NORM;
    if (t < T_WIN) { transpose_task(p.w_in, 1024, 2560, (u16*)(p.ws + WS_WIN), t, smem); continue; }
    t -= T_WIN;
    if (t < T_W2W) { transpose_task(p.w2w, 64, 512, (u16*)(p.ws + WS_W2W), t, smem); continue; }
    t -= T_W2W;
    if (t < T_W2A) { transpose_task(p.w2a, 64, 512, (u16*)(p.ws + WS_W2A), t, smem); continue; }
    t -= T_W2A;
    if (t < T_W2G) { transpose_task(p.w2g, 128, 512, (u16*)(p.ws + WS_W2G), t, smem); continue; }
    t -= T_W2G;
    {
      int e = (t * 256 + threadIdx.x) * 4;
      float4 v = *(const float4*)(p.sub_keys + e);
      *(uint2*)((u16*)(p.ws + WS_SUBK) + e) = uint2{pack2bf(v.x, v.y), pack2bf(v.z, v.w)};
    }
  }
}

__device__ void phase1(const Params& p, char* smem) {
  const u16* hbuf = (const u16*)(p.ws + WS_B);
  const u16* wt = (const u16*)(p.ws + WS_WIN);
  u16* proj = (u16*)(p.ws + WS_C);
  constexpr int NT = 20, MT = MROWS / 128, TOT = MT * NT;
  const int G = gridDim.x, full = p.full1, ntask = full + 4 * (TOT - full);
  for (int task = xcd_vid(); task < ntask; task += G) {
    int mt, nt;
    if (task < full) {
      grouped_tile(task, MT, NT, mt, nt);
      u16* crow = proj + (size_t)mt * 128 * NIN + nt * 128;
      gemm_tile(hbuf + (size_t)mt * 128 * D, D, wt + (size_t)nt * 128 * D, D, D, smem,
                [&](int m, int r, int c, f32x4 v) { *(uint2*)(crow + (size_t)r * NIN + c) = uint2{pack2bf(v[0], v[1]), pack2bf(v[2], v[3])}; });
    } else {
      int rem = task - full, qd = rem & 3;
      grouped_tile(full + (rem >> 2), MT, NT, mt, nt);
      size_t r0 = (size_t)mt * 128 + qd * 32;
      u16* crow = proj + r0 * NIN + nt * 128;
      gemm_qtile(hbuf + r0 * D, D, wt + (size_t)nt * 128 * D, D, D, smem,
                 [&](int m, int r, int c, f32x4 v) { *(uint2*)(crow + (size_t)r * NIN + c) = uint2{pack2bf(v[0], v[1]), pack2bf(v[2], v[3])}; });
    }
  }
}

__device__ void prepass_task(const Params& p, int task) {
  const int wave = threadIdx.x >> 6, lane = threadIdx.x & 63;
  int row = task * 4 + wave;
  if (row >= TTOK) return;
  u16* proj = (u16*)(p.ws + WS_C);
  u16* act = (u16*)(p.ws + WS_E);
  bool isP = row < TP;
  int b, t, prow;
  float pos;
  if (isP) { b = row / LP; t = row % LP; prow = t > 0 ? row - 1 : -1; pos = (float)t; }
  else { int r = row - TP; b = r >> 2; t = r & 3; prow = t > 0 ? row - 1 : PREV0 + b; pos = (float)(PAST + t); }
  u16* pr = proj + (size_t)row * NIN;
  const u16* pp = prow >= 0 ? proj + (size_t)prow * NIN : nullptr;
  {
    int c = 1536 + lane * 4;
    uint2 a = *(const uint2*)(pr + c);
    uint2 bq = pp ? *(const uint2*)(pp + c) : uint2{0u, 0u};
    float4 mu = *(const float4*)(p.mu + c);
    float x[4] = {bflo(a.x), bfhi(a.x), bflo(a.y), bfhi(a.y)};
    float xp[4] = {bflo(bq.x), bfhi(bq.x), bflo(bq.y), bfhi(bq.y)};
    float mm[4] = {mu.x, mu.y, mu.z, mu.w};
    float o[4];
#pragma unroll
    for (int i = 0; i < 4; ++i) {
      float m = x[i] + (xp[i] - x[i]) * mm[i];
      float r;
      if (lane < 16) r = tanhf(m);
      else if (lane < 32) r = m;
      else r = sigmoidf_(m);
      o[i] = r;
    }
    *(uint2*)(act + (size_t)row * 256 + lane * 4) = uint2{pack2bf(o[0], o[1]), pack2bf(o[2], o[3])};
  }
  float* kwin = nullptr;
  float* vwin = nullptr;
  if (isP) {
    if (t >= LP - 128) {
      kwin = p.out + O_KWP + ((size_t)b * 128 + (t - (LP - 128))) * 128;
      vwin = p.out + O_VWP + ((size_t)b * 128 + (t - (LP - 128))) * 128;
    }
  } else {
    kwin = p.out + O_KWS + ((size_t)b * 128 + 124 + t) * 128;
    vwin = p.out + O_VWS + ((size_t)b * 128 + 124 + t) * 128;
  }
  for (int it = lane; it < 80; it += 64) {
    int hh = it >> 3, d = it & 7;
    int col = 1792 + hh * 64 + d;
    float x1 = bf2f(pr[col]), x2 = bf2f(pr[col + 8]);
    double rev = (double)pos * INVF[d] * 0.15915494309189535;
    float fr = (float)(rev - floor(rev));
    float sn = __builtin_amdgcn_sinf(fr), cs = __builtin_amdgcn_cosf(fr);
    float r1 = x1 * cs - x2 * sn, r2 = x2 * cs + x1 * sn;
    pr[col] = f2bf(r1);
    pr[col + 8] = f2bf(r2);
    if (hh >= 8 && kwin) {
      kwin[(hh - 8) * 64 + d] = r1;
      kwin[(hh - 8) * 64 + d + 8] = r2;
    }
  }
  if (kwin) {
#pragma unroll
    for (int i = 0; i < 2; ++i) {
      int idx = lane * 2 + i;
      if ((idx & 63) >= 16) kwin[idx] = bf2f(pr[2304 + idx]);
      vwin[idx] = bf2f(pr[2432 + idx]);
    }
  }
}

__device__ void phase2(const Params& p) {
  constexpr int N_PRE = TTOK / 4;
  constexpr int N_CP = 256;
  for (int task = blockIdx.x; task < N_PRE + N_CP; task += gridDim.x) {
    if (task < N_PRE) { prepass_task(p, task); continue; }
    int t = task - N_PRE;
    int which = t >> 7, b = t & 127;
    const float4* src = (const float4*)((which ? p.cache_v : p.cache_k) + (size_t)b * 16384 + 512);
    float4* dst = (float4*)(p.out + (which ? O_VWS : O_KWS) + (size_t)b * 16384);
    for (int i = threadIdx.x; i < 3968; i += 256) dst[i] = src[i];
  }
}

__device__ void phase3(const Params& p, char* smem) {
  const u16* act = (const u16*)(p.ws + WS_E);
  float* dec = (float*)(p.ws + WS_DEC);
  u16* ab = (u16*)(p.ws + WS_A);
  u16* gb = (u16*)(p.ws + WS_G);
  constexpr int MT = TPAD / 128;
  for (int tile = blockIdx.x; tile < MT * 12; tile += gridDim.x) {
    int which = tile % 3, rest = tile / 3;
    int nt = rest & 3, mt = rest >> 2;
    size_t r0 = (size_t)mt * 128;
    int c0 = nt * 128;
    if (which == 0) {
      gemm_tile(act + r0 * 256, 256, (const u16*)(p.ws + WS_W2W) + (size_t)c0 * 64, 64, 64, smem,
                [&](int m, int r, int c, f32x4 v) {
                  float4 w0v = *(const float4*)(p.w0 + c0 + c);
                  float w0a[4] = {w0v.x, w0v.y, w0v.z, w0v.w};
                  float o[4];
#pragma unroll
                  for (int e = 0; e < 4; ++e) {
                    float nx = -(w0a[e] + v[e]);
                    float sp = fmaxf(nx, 0.f) + __logf(1.f + __expf(-fabsf(nx)));
                    o[e] = __expf(-__expf(-sp - 0.5f));
                  }
                  *(float4*)(dec + (r0 + r) * 512 + c0 + c) = float4{o[0], o[1], o[2], o[3]};
                });
    } else if (which == 1) {
      gemm_tile(act + r0 * 256 + 64, 256, (const u16*)(p.ws + WS_W2A) + (size_t)c0 * 64, 64, 64, smem,
                [&](int m, int r, int c, f32x4 v) {
                  float4 a0v = *(const float4*)(p.a0 + c0 + c);
                  *(uint2*)(ab + (r0 + r) * 512 + c0 + c) = uint2{pack2bf(sigmoidf_(a0v.x + v[0]), sigmoidf_(a0v.y + v[1])), pack2bf(sigmoidf_(a0v.z + v[2]), sigmoidf_(a0v.w + v[3]))};
                });
    } else {
      gemm_tile(act + r0 * 256 + 128, 256, (const u16*)(p.ws + WS_W2G) + (size_t)c0 * 128, 128, 128, smem,
                [&](int m, int r, int c, f32x4 v) { *(uint2*)(gb + (r0 + r) * 512 + c0 + c) = uint2{pack2bf(v[0], v[1]), pack2bf(v[2], v[3])}; });
    }
  }
}

__device__ void convert_task(const Params& p, int task) {
  const int wave = threadIdx.x >> 6, lane = threadIdx.x & 63;
  int r = task * 4 + wave;
  const float* src = (r < 16384 ? p.eu + (size_t)r * 1024 : p.ev + (size_t)(r - 16384) * 1024) + lane * 16;
  float4 x[4];
  float am = 0.f;
#pragma unroll
  for (int i = 0; i < 4; ++i) {
    x[i] = ((const float4*)src)[i];
    am = fmaxf(am, fmaxf(fmaxf(fabsf(x[i].x), fabsf(x[i].y)), fmaxf(fabsf(x[i].z), fabsf(x[i].w))));
  }
  am = redmax16(am);
  am = fmaxf(fmaxf(rdlane(am, 0), rdlane(am, 16)), fmaxf(rdlane(am, 32), rdlane(am, 48)));
  float scale = am > 0.f ? 7.f / am : 1.f;
  float inv = am > 0.f ? am * (1.f / 7.f) : 1.f;
  float y[16];
#pragma unroll
  for (int i = 0; i < 4; ++i) {
    y[4 * i] = fminf(fmaxf(x[i].x * scale, -6.f), 6.f); y[4 * i + 1] = fminf(fmaxf(x[i].y * scale, -6.f), 6.f);
    y[4 * i + 2] = fminf(fmaxf(x[i].z * scale, -6.f), 6.f); y[4 * i + 3] = fminf(fmaxf(x[i].w * scale, -6.f), 6.f);
  }
  unsigned w0 = 0u, w1 = 0u;
  w0 = __builtin_amdgcn_cvt_scalef32_pk_fp4_f32(w0, y[0], y[1], 1.0f, 0);
  w0 = __builtin_amdgcn_cvt_scalef32_pk_fp4_f32(w0, y[2], y[3], 1.0f, 1);
  w0 = __builtin_amdgcn_cvt_scalef32_pk_fp4_f32(w0, y[4], y[5], 1.0f, 2);
  w0 = __builtin_amdgcn_cvt_scalef32_pk_fp4_f32(w0, y[6], y[7], 1.0f, 3);
  w1 = __builtin_amdgcn_cvt_scalef32_pk_fp4_f32(w1, y[8], y[9], 1.0f, 0);
  w1 = __builtin_amdgcn_cvt_scalef32_pk_fp4_f32(w1, y[10], y[11], 1.0f, 1);
  w1 = __builtin_amdgcn_cvt_scalef32_pk_fp4_f32(w1, y[12], y[13], 1.0f, 2);
  w1 = __builtin_amdgcn_cvt_scalef32_pk_fp4_f32(w1, y[14], y[15], 1.0f, 3);
  *(uint2*)((unsigned char*)(p.ws + WS_EU) + (size_t)r * 512 + lane * 8) = uint2{w0, w1};
  if (lane == 0) ((float*)(p.ws + WS_SCU))[r] = inv;
}

struct ScanRaw {
  uint2 rr, rk, rv, qr, qk, qv, av;
  float4 dc;
};
constexpr int SC_TOK = 332;

__device__ void scan_task(const Params& p, char* smem, int rowbase, int T, int prevrow, int h, int rg,
                          const float* __restrict__ s_in, float* __restrict__ s_out) {
  const int tid = threadIdx.x, wave = tid >> 6, lane = tid & 63, l16 = lane & 15;
  const bool scanner = wave < 2;
  const u16* proj = (const u16*)(p.ws + WS_C);
  const float* dec = (const float*)(p.ws + WS_DEC);
  const u16* ab = (const u16*)(p.ws + WS_A);
  float* yraw = p.out;
  float* bufs = (float*)smem;
  float* yparts = (float*)(smem + 42496);
  float* vkrs = (float*)(smem + 42496 + 16384);
  const int nchunk = (T + 15) >> 4;
  const int il = (wave & 1) * 4 + (lane >> 4), i = rg * 8 + il, j0 = l16 * 4;
  float2v S01 = {0.f, 0.f}, S23 = {0.f, 0.f};
  if (s_in && scanner) {
    float4 s = *(const float4*)(s_in + i * 64 + j0);
    S01 = float2v{s.x, s.y}; S23 = float2v{s.z, s.w};
  }
  const int ptid = tid & 127, cgp = ptid & 15, ttb = ptid >> 4, col = h * 64 + cgp * 4;
  const float4 mu_r = *(const float4*)(p.mu + col), mu_k = *(const float4*)(p.mu + 512 + col),
               mu_v = *(const float4*)(p.mu + 1024 + col);
  const float4 kkw = *(const float4*)(p.k_k + col), kaw = *(const float4*)(p.k_a + col);
  const u16* projc = proj + (size_t)rowbase * NIN + col;
  const float* decc = dec + (size_t)rowbase * 512 + col;
  const u16* abc = ab + (size_t)rowbase * 512 + col;
  const u16* prevp = prevrow >= 0 ? proj + (size_t)prevrow * NIN + col : nullptr;
  auto issue = [&](int c, int tt, ScanRaw& R) {
    int t = c * 16 + tt;
    if (t < T) {
      const size_t ro = (size_t)c * 16 + tt;
      const u16* pr = projc + ro * NIN;
      R.rr = *(const uint2*)(pr);
      R.rk = *(const uint2*)(pr + 512);
      R.rv = *(const uint2*)(pr + 1024);
      const u16* pq = t > 0 ? pr - NIN : prevp;
      if (pq) {
        R.qr = *(const uint2*)(pq);
        R.qk = *(const uint2*)(pq + 512);
        R.qv = *(const uint2*)(pq + 1024);
      } else {
        R.qr = uint2{0, 0}; R.qk = uint2{0, 0}; R.qv = uint2{0, 0};
      }
      R.dc = *(const float4*)(decc + ro * 512);
      R.av = *(const uint2*)(abc + ro * 512);
    }
  };
  auto prep_item = [&](const ScanRaw& R, int tt, float* buf, float* vkr) {
    float xr[4] = {bflo(R.rr.x), bfhi(R.rr.x), bflo(R.rr.y), bfhi(R.rr.y)};
    float xk[4] = {bflo(R.rk.x), bfhi(R.rk.x), bflo(R.rk.y), bfhi(R.rk.y)};
    float xv[4] = {bflo(R.rv.x), bfhi(R.rv.x), bflo(R.rv.y), bfhi(R.rv.y)};
    float pr_[4] = {bflo(R.qr.x), bfhi(R.qr.x), bflo(R.qr.y), bfhi(R.qr.y)};
    float pk_[4] = {bflo(R.qk.x), bfhi(R.qk.x), bflo(R.qk.y), bfhi(R.qk.y)};
    float pv_[4] = {bflo(R.qv.x), bfhi(R.qv.x), bflo(R.qv.y), bfhi(R.qv.y)};
    float aa[4] = {bflo(R.av.x), bfhi(R.av.x), bflo(R.av.y), bfhi(R.av.y)};
    float dcv[4] = {R.dc.x, R.dc.y, R.dc.z, R.dc.w};
    float mur[4] = {mu_r.x, mu_r.y, mu_r.z, mu_r.w}, muk[4] = {mu_k.x, mu_k.y, mu_k.z, mu_k.w},
          muv[4] = {mu_v.x, mu_v.y, mu_v.z, mu_v.w};
    float kw[4] = {kkw.x, kkw.y, kkw.z, kkw.w}, ka[4] = {kaw.x, kaw.y, kaw.z, kaw.w};
    float kkv[4], ss = 0.f;
#pragma unroll
    for (int e = 0; e < 4; ++e) {
      xr[e] = xr[e] + (pr_[e] - xr[e]) * mur[e];
      xk[e] = xk[e] + (pk_[e] - xk[e]) * muk[e];
      xv[e] = xv[e] + (pv_[e] - xv[e]) * muv[e];
      kkv[e] = xk[e] * kw[e];
      ss += kkv[e] * kkv[e];
    }
    ss = red16(ss);
    float inv = __builtin_amdgcn_rsqf(fmaxf(ss, 1e-24f));
    float nk[4], kb[4], km[4];
    float brs = 0.f, krs = 0.f;
#pragma unroll
    for (int e = 0; e < 4; ++e) {
      float kk = kkv[e] * inv;
      nk[e] = -kk;
      kb[e] = kk * aa[e];
      km[e] = xk[e] * (1.f + (aa[e] - 1.f) * ka[e]);
      brs += kb[e] * xr[e];
      krs += km[e] * xr[e];
    }
    brs = red16(brs);
    krs = red16(krs);
    float* bt = buf + tt * SC_TOK + cgp * 4;
    *(float4*)(bt) = float4{xr[0] * dcv[0] + brs * nk[0], xr[1] * dcv[1] + brs * nk[1], xr[2] * dcv[2] + brs * nk[2],
                            xr[3] * dcv[3] + brs * nk[3]};
    *(float4*)(bt + 64) = R.dc;
    *(float4*)(bt + 128) = float4{km[0], km[1], km[2], km[3]};
    *(float4*)(bt + 192) = float4{nk[0], nk[1], nk[2], nk[3]};
    *(float4*)(bt + 256) = float4{kb[0], kb[1], kb[2], kb[3]};
    if ((cgp >> 1) == rg) {
      *(float4*)(buf + tt * SC_TOK + 320 + (cgp & 1) * 4) = float4{xv[0], xv[1], xv[2], xv[3]};
      *(float4*)(vkr + tt * 8 + (cgp & 1) * 4) = float4{xv[0] * krs, xv[1] * krs, xv[2] * krs, xv[3] * krs};
    }
  };
  auto yreduce = [&](int c) {
    const int tt = ptid >> 3, row = ptid & 7;
    const float4* yp = (const float4*)(yparts + (c & 1) * 2048 + ptid * 16);
    float4 a = yp[0], b = yp[1], c4 = yp[2], d = yp[3];
    float y = ((a.x + a.y) + (a.z + a.w)) + ((b.x + b.y) + (b.z + b.w)) + ((c4.x + c4.y) + (c4.z + c4.w)) +
              ((d.x + d.y) + (d.z + d.w)) + vkrs[(c % 3) * 128 + ptid];
    int t = c * 16 + tt;
    if (t < T) yraw[(size_t)(rowbase + t) * 512 + h * 64 + rg * 8 + row] = y;
  };
  ScanRaw R0, R1;
  R0.rr = R0.rk = R0.rv = R0.qr = R0.qk = R0.qv = R0.av = uint2{0, 0}; R0.dc = float4{0, 0, 0, 0};
  R1 = R0;
  if (!scanner) {
    issue(0, ttb, R0);
    issue(0, ttb + 8, R1);
    prep_item(R0, ttb, bufs, vkrs);
    prep_item(R1, ttb + 8, bufs, vkrs);
    if (nchunk > 1) { issue(1, ttb, R0); issue(1, ttb + 8, R1); }
  }
  __syncthreads();
  for (int c = 0; c < nchunk; ++c) {
    if (scanner) {
      const float* buf = bufs + (c & 1) * (16 * SC_TOK);
      float* ypart = yparts + (c & 1) * 2048;
      const int ntok = min(16, T - c * 16);
      const float* bt0 = buf + j0;
      float4 r4 = *(const float4*)(bt0), w4 = *(const float4*)(bt0 + 64), k4 = *(const float4*)(bt0 + 128),
             a4 = *(const float4*)(bt0 + 192), b4 = *(const float4*)(bt0 + 256);
      float vi = buf[320 + il];
      for (int t2 = 0; t2 < ntok; ++t2) {
        int tn = min(t2 + 1, ntok - 1);
        const float* bn = buf + tn * SC_TOK + j0;
        float4 rn = *(const float4*)(bn), wn = *(const float4*)(bn + 64), kn = *(const float4*)(bn + 128),
               an = *(const float4*)(bn + 192), bnn = *(const float4*)(bn + 256);
        float vn = buf[tn * SC_TOK + 320 + il];
        float2v sa2 = S01 * float2v{a4.x, a4.y} + S23 * float2v{a4.z, a4.w};
        float2v q2 = S01 * float2v{r4.x, r4.y} + S23 * float2v{r4.z, r4.w};
        float2v vv = float2v{vi, vi};
        float2v t01 = S01 * float2v{w4.x, w4.y} + vv * float2v{k4.x, k4.y};
        float2v t23 = S23 * float2v{w4.z, w4.w} + vv * float2v{k4.z, k4.w};
        float sa = red16(sa2.x + sa2.y);
        float2v sv = float2v{sa, sa};
        S01 = t01 + sv * float2v{b4.x, b4.y};
        S23 = t23 + sv * float2v{b4.z, b4.w};
        ypart[t2 * 128 + (tid & 127)] = q2.x + q2.y;
        r4 = rn; w4 = wn; k4 = kn; a4 = an; b4 = bnn; vi = vn;
      }
    } else {
      if (c > 0) yreduce(c - 1);
      if (c + 1 < nchunk) {
        float* nb = bufs + ((c + 1) & 1) * (16 * SC_TOK);
        float* nv = vkrs + ((c + 1) % 3) * 128;
        prep_item(R0, ttb, nb, nv);
        prep_item(R1, ttb + 8, nb, nv);
        if (c + 2 < nchunk) { issue(c + 2, ttb, R0); issue(c + 2, ttb + 8, R1); }
      }
    }
    __syncthreads();
  }
  if (scanner) *(float4*)(s_out + i * 64 + j0) = float4{S01.x, S01.y, S23.x, S23.y};
  else yreduce(nchunk - 1);
  __syncthreads();
}

__device__ void attn_prompt_task(const Params& p, char* smem, int task) {
  const int tid = threadIdx.x, w = tid >> 6, lane = tid & 63, fr = lane & 15, fq = lane >> 4;
  int head = task & 7;
  int qt = (task >> 3) % 65;
  int b = task / (8 * 65);
  int kvh = head >> 2;
  u16* KV = (u16*)smem;
  u16* Ps = (u16*)(smem + 9216) + w * 16 * 200;
  const u16* projb = (const u16*)(p.ws + WS_C) + (size_t)b * LP * NIN;
  u16* mix = (u16*)(p.ws + WS_B);
  int q0 = qt * 64, kstart = q0 - 128;
  int qrow = min(q0 + w * 16 + fr, LP - 1);
  bf16x8 qa[2];
#pragma unroll
  for (int ks = 0; ks < 2; ++ks)
    qa[ks] = *(const bf16x8*)(projb + (size_t)qrow * NIN + 1792 + head * 64 + ks * 32 + fq * 8);
  f32x4 S[12];
#pragma unroll
  for (int i = 0; i < 12; ++i) S[i] = f32x4{0.f, 0.f, 0.f, 0.f};
#pragma unroll
  for (int kt = 0; kt < 3; ++kt) {
    {
      int key = tid >> 2, ch = tid & 3;
      int kp = min(max(kstart + kt * 64 + key, 0), LP - 1);
      const uint4* src = (const uint4*)(projb + (size_t)kp * NIN + 2304 + kvh * 64 + ch * 16);
      uint4 v0 = src[0], v1 = src[1];
      *(uint4*)(KV + key * 72 + ch * 16) = v0;
      *(uint4*)(KV + key * 72 + ch * 16 + 8) = v1;
    }
    __syncthreads();
#pragma unroll
    for (int n = 0; n < 4; ++n)
#pragma unroll
      for (int ks = 0; ks < 2; ++ks) {
        bf16x8 kb = *(const bf16x8*)(KV + (n * 16 + fr) * 72 + ks * 32 + fq * 8);
        S[kt * 4 + n] = mfma16(qa[ks], kb, S[kt * 4 + n]);
      }
    __syncthreads();
  }
  float sink = p.sinks[head];
#pragma unroll
  for (int j = 0; j < 4; ++j) {
    int qpos = q0 + w * 16 + fq * 4 + j;
    float mx = -1e30f;
#pragma unroll
    for (int T = 0; T < 12; ++T) {
      int kpos = kstart + T * 16 + fr;
      bool valid = (kpos >= 0) && (kpos <= qpos) && (qpos - kpos < 128);
      float s = valid ? S[T][j] * 0.125f : -1e30f;
      S[T][j] = s;
      mx = fmaxf(mx, s);
    }
    mx = redmax16(mx);
    mx = fmaxf(mx, sink);
    float sum = 0.f;
#pragma unroll
    for (int T = 0; T < 12; ++T) {
      float e = (S[T][j] > -1e29f) ? __expf(S[T][j] - mx) : 0.f;
      S[T][j] = e;
      sum += e;
    }
    sum = red16(sum) + __expf(sink - mx);
    float inv = 1.f / sum;
#pragma unroll
    for (int T = 0; T < 12; ++T) Ps[(fq * 4 + j) * 200 + T * 16 + fr] = f2bf(S[T][j] * inv);
  }
  f32x4 O[4];
#pragma unroll
  for (int i = 0; i < 4; ++i) O[i] = f32x4{0.f, 0.f, 0.f, 0.f};
#pragma unroll
  for (int kt = 0; kt < 3; ++kt) {
    {
      int key = tid >> 2, ch = tid & 3;
      int kp = min(max(kstart + kt * 64 + key, 0), LP - 1);
      const uint4* src = (const uint4*)(projb + (size_t)kp * NIN + 2432 + kvh * 64 + ch * 16);
      uint4 v0 = src[0], v1 = src[1];
      unsigned e[8] = {v0.x, v0.y, v0.z, v0.w, v1.x, v1.y, v1.z, v1.w};
#pragma unroll
      for (int i = 0; i < 8; ++i) {
        KV[(ch * 16 + 2 * i) * 72 + key] = (u16)(e[i] & 0xffffu);
        KV[(ch * 16 + 2 * i + 1) * 72 + key] = (u16)(e[i] >> 16);
      }
    }
    __syncthreads();
#pragma unroll
    for (int ks = 0; ks < 2; ++ks) {
      bf16x8 pa = *(const bf16x8*)(Ps + fr * 200 + kt * 64 + ks * 32 + fq * 8);
#pragma unroll
      for (int n = 0; n < 4; ++n) {
        bf16x8 vb = *(const bf16x8*)(KV + (n * 16 + fr) * 72 + ks * 32 + fq * 8);
        O[n] = mfma16(pa, vb, O[n]);
      }
    }
    __syncthreads();
  }
#pragma unroll
  for (int n = 0; n < 4; ++n)
#pragma unroll
    for (int j = 0; j < 4; ++j) {
      int q = q0 + w * 16 + fq * 4 + j;
      if (q < LP) mix[((size_t)(b * LP + q)) * 1024 + 512 + head * 64 + n * 16 + fr] = f2bf(O[n][j]);
    }
}

__device__ void attn_sample_task(const Params& p, char* smem, int task) {
  const int tid = threadIdx.x;
  int b = task >> 1, kvh = task & 1;
  const u16* proj = (const u16*)(p.ws + WS_C);
  u16* mix = (u16*)(p.ws + WS_B);
  float* Qs = (float*)smem;
  float* Sc = Qs + 1024;
  {
    int qr = tid >> 4, d4 = (tid & 15) * 4, g = qr >> 2, s = qr & 3;
    const u16* src = proj + (size_t)(TP + b * 4 + s) * NIN + 1792 + (kvh * 4 + g) * 64 + d4;
    uint2 v = *(const uint2*)src;
    *(float4*)(Qs + qr * 64 + d4) = float4{bflo(v.x) * 0.125f, bfhi(v.x) * 0.125f, bflo(v.y) * 0.125f, bfhi(v.y) * 0.125f};
  }
  __syncthreads();
  for (int idx = tid; idx < 132 * 16; idx += 256) {
    int kj = idx >> 4, qr = idx & 15, s = qr & 3;
    bool valid = (kj < 128) ? (kj > s) : (kj - 128 <= s);
    float acc = 0.f;
    const float* q = Qs + qr * 64;
    if (kj < 128) {
      const float4* kr = (const float4*)(p.cache_k + (((size_t)b * 128 + kj) * 2 + kvh) * 64);
#pragma unroll
      for (int d = 0; d < 16; ++d) {
        float4 kv = kr[d];
        acc += kv.x * q[d * 4] + kv.y * q[d * 4 + 1] + kv.z * q[d * 4 + 2] + kv.w * q[d * 4 + 3];
      }
    } else {
      const uint2* kr = (const uint2*)(proj + (size_t)(TP + b * 4 + kj - 128) * NIN + 2304 + kvh * 64);
#pragma unroll
      for (int d = 0; d < 16; ++d) {
        uint2 kv = kr[d];
        acc += bflo(kv.x) * q[d * 4] + bfhi(kv.x) * q[d * 4 + 1] + bflo(kv.y) * q[d * 4 + 2] + bfhi(kv.y) * q[d * 4 + 3];
      }
    }
    Sc[qr * 136 + kj] = valid ? acc : -1e30f;
  }
  __syncthreads();
  {
    int qr = tid >> 4, l = tid & 15, g = qr >> 2;
    float sink = p.sinks[kvh * 4 + g];
    float mx = -1e30f;
    for (int kj = l; kj < 132; kj += 16) mx = fmaxf(mx, Sc[qr * 136 + kj]);
    mx = redmax16(mx);
    mx = fmaxf(mx, sink);
    float sum = 0.f;
    for (int kj = l; kj < 132; kj += 16) {
      float s = Sc[qr * 136 + kj];
      float e = (s > -1e29f) ? __expf(s - mx) : 0.f;
      Sc[qr * 136 + kj] = e;
      sum += e;
    }
    sum = red16(sum) + __expf(sink - mx);
    float inv = 1.f / sum;
    for (int kj = l; kj < 132; kj += 16) Sc[qr * 136 + kj] *= inv;
  }
  __syncthreads();
  {
    int qr = tid >> 4, d4 = (tid & 15) * 4, g = qr >> 2, s = qr & 3;
    float4 o = {0.f, 0.f, 0.f, 0.f};
    for (int kj = 0; kj < 128; ++kj) {
      float pw = Sc[qr * 136 + kj];
      float4 v = *(const float4*)(p.cache_v + (((size_t)b * 128 + kj) * 2 + kvh) * 64 + d4);
      o.x += pw * v.x; o.y += pw * v.y; o.z += pw * v.z; o.w += pw * v.w;
    }
    for (int kj = 128; kj < 132; ++kj) {
      float pw = Sc[qr * 136 + kj];
      uint2 v = *(const uint2*)(proj + (size_t)(TP + b * 4 + kj - 128) * NIN + 2432 + kvh * 64 + d4);
      o.x += pw * bflo(v.x); o.y += pw * bfhi(v.x); o.z += pw * bflo(v.y); o.w += pw * bfhi(v.y);
    }
    *(uint2*)(mix + (size_t)(TP + b * 4 + s) * 1024 + 512 + (kvh * 4 + g) * 64 + d4) =
        uint2{pack2bf(o.x, o.y), pack2bf(o.z, o.w)};
  }
  __syncthreads();
}

__device__ void phase4(const Params& p, char* smem) {
  constexpr int N_PS = 256, N_SS = 8192, N_AP = NB * 65 * 8, N_AS = 256;
  constexpr int N_CV = 32768 / 4, T_WOUT = 16 * 16, T_WQ = 16 * 32;
  int first, stride;
  if (gridDim.x >= 2 * N_PS) {
    if ((int)blockIdx.x < N_PS) {
      int t = blockIdx.x;
      int seq = t >> 3, rg = t & 7, b = seq >> 3, h = seq & 7;
      scan_task(p, smem, b * LP, LP, -1, h, rg, nullptr, p.out + O_WKVP + (size_t)seq * 4096);
      return;
    }
    first = N_PS + (blockIdx.x - N_PS);
    stride = gridDim.x - N_PS;
  } else {
    first = blockIdx.x;
    stride = gridDim.x;
  }
  for (int task = first; task < N_PS + N_SS + N_AP + N_AS + N_CV + T_WOUT + T_WQ; task += stride) {
    int t = task;
    if (t < N_PS) {
      int seq = t >> 3, rg = t & 7, b = seq >> 3, h = seq & 7;
      scan_task(p, smem, b * LP, LP, -1, h, rg, nullptr, p.out + O_WKVP + (size_t)seq * 4096);
      continue;
    }
    t -= N_PS;
    if (t < N_SS) {
      int seq = t >> 3, rg = t & 7, b = seq >> 3, h = seq & 7;
      scan_task(p, smem, TP + b * 4, 4, PREV0 + b, h, rg, p.state_wkv + (size_t)seq * 4096,
                p.out + O_WKVS + (size_t)seq * 4096);
      continue;
    }
    t -= N_SS;
    if (t < N_AP) { attn_prompt_task(p, smem, t); continue; }
    t -= N_AP;
    if (t < N_AS) { attn_sample_task(p, smem, t); continue; }
    t -= N_AS;
    if (t < N_CV) { convert_task(p, t); continue; }
    t -= N_CV;
    if (t < T_WOUT) { transpose_task(p.w_out, 1024, 1024, (u16*)(p.ws + WS_WOUT), t, smem); continue; }
    t -= T_WOUT;
    transpose_task(p.w_query, 1024, 2048, (u16*)(p.ws + WS_WQ), t, smem, p.norm2_g);
  }
}

struct PostC { float mu[3][8], ka[8], rk[8], lw[8], lb[8]; };

__device__ __forceinline__ void post_task(const Params& p, int task, const PostC& C) {
  const int wave = threadIdx.x >> 6, lane = threadIdx.x & 63;
  int row = task * 4 + wave;
  if (row >= TTOK) return;
  const u16* proj = (const u16*)(p.ws + WS_C);
  const float* yraw = p.out;
  const u16* ab = (const u16*)(p.ws + WS_A);
  const u16* gb = (const u16*)(p.ws + WS_G);
  u16* mix = (u16*)(p.ws + WS_B);
  int prow;
  if (row < TP) { int t = row % LP; prow = t > 0 ? row - 1 : -1; }
  else { int r = row - TP; prow = (r & 3) ? row - 1 : PREV0 + (r >> 2); }
  int c0 = lane * 8;
  float y[8];
  {
    float4 a = *(const float4*)(yraw + (size_t)row * 512 + c0), bq = *(const float4*)(yraw + (size_t)row * 512 + c0 + 4);
    y[0] = a.x; y[1] = a.y; y[2] = a.z; y[3] = a.w; y[4] = bq.x; y[5] = bq.y; y[6] = bq.z; y[7] = bq.w;
  }
  float s = 0.f;
#pragma unroll
  for (int e = 0; e < 8; ++e) s += y[e];
  float mean = red8(s) * (1.f / 64.f);
  float vs = 0.f;
#pragma unroll
  for (int e = 0; e < 8; ++e) { float d = y[e] - mean; vs += d * d; }
  float rstd = rsqrtf(red8(vs) * (1.f / 64.f) + 64e-5f);
  float xr[8], xk[8], xv[8];
  auto ld8 = [&](int coff, int mi, float* o) {
    uint4 a = *(const uint4*)(proj + (size_t)row * NIN + coff + c0);
    uint4 q = prow >= 0 ? *(const uint4*)(proj + (size_t)prow * NIN + coff + c0) : uint4{0, 0, 0, 0};
    unsigned ua[4] = {a.x, a.y, a.z, a.w}, uq[4] = {q.x, q.y, q.z, q.w};
#pragma unroll
    for (int e = 0; e < 4; ++e) {
      float x0 = bflo(ua[e]), x1 = bfhi(ua[e]), p0 = bflo(uq[e]), p1 = bfhi(uq[e]);
      float m0 = C.mu[mi][2 * e], m1 = C.mu[mi][2 * e + 1];
      o[2 * e] = x0 + (p0 - x0) * m0;
      o[2 * e + 1] = x1 + (p1 - x1) * m1;
    }
  };
  ld8(0, 0, xr);
  ld8(512, 1, xk);
  ld8(1024, 2, xv);
  float aa[8], gg[8];
  {
    uint4 a = *(const uint4*)(ab + (size_t)row * 512 + c0), g = *(const uint4*)(gb + (size_t)row * 512 + c0);
    unsigned ua[4] = {a.x, a.y, a.z, a.w}, ug[4] = {g.x, g.y, g.z, g.w};
#pragma unroll
    for (int e = 0; e < 4; ++e) {
      aa[2 * e] = bflo(ua[e]); aa[2 * e + 1] = bfhi(ua[e]);
      gg[2 * e] = bflo(ug[e]); gg[2 * e + 1] = bfhi(ug[e]);
    }
  }
  float bs = 0.f;
#pragma unroll
  for (int e = 0; e < 8; ++e) {
    float km = xk[e] * (1.f + (aa[e] - 1.f) * C.ka[e]);
    bs += xr[e] * km * C.rk[e];
  }
  bs = red8(bs);
  unsigned o[4];
#pragma unroll
  for (int e = 0; e < 4; ++e) {
    float v0 = ((y[2 * e] - mean) * rstd * C.lw[2 * e] + C.lb[2 * e] + bs * xv[2 * e]) * gg[2 * e];
    float v1 = ((y[2 * e + 1] - mean) * rstd * C.lw[2 * e + 1] + C.lb[2 * e + 1] + bs * xv[2 * e + 1]) * gg[2 * e + 1];
    o[e] = pack2bf(v0, v1);
  }
  *(uint4*)(mix + (size_t)row * 1024 + c0) = uint4{o[0], o[1], o[2], o[3]};
}

__device__ void phase5(const Params& p) {
  const int lane = threadIdx.x & 63, c0 = lane * 8;
  PostC C;
  auto ld = [&](const float* src, float* dst) {
    float4 a = *(const float4*)(src + c0), b = *(const float4*)(src + c0 + 4);
    dst[0] = a.x; dst[1] = a.y; dst[2] = a.z; dst[3] = a.w; dst[4] = b.x; dst[5] = b.y; dst[6] = b.z; dst[7] = b.w;
  };
  ld(p.mu, C.mu[0]); ld(p.mu + 512, C.mu[1]); ld(p.mu + 1024, C.mu[2]);
  ld(p.k_a, C.ka); ld(p.r_k, C.rk); ld(p.lnx_w, C.lw); ld(p.lnx_b, C.lb);
  for (int task = blockIdx.x; task < TTOK / 4; task += gridDim.x) post_task(p, task, C);
}

__device__ void phase6(const Params& p, char* smem) {
  const u16* mix = (const u16*)(p.ws + WS_B);
  const u16* wt = (const u16*)(p.ws + WS_WOUT);
  constexpr int MT = NOUT / 128, NT = 8;
  constexpr int N_CV = 0;
  const int wave = threadIdx.x >> 6, lane = threadIdx.x & 63;
  for (int task = xcd_vid(); task < MT * NT + N_CV; task += gridDim.x) {
    if (task < MT * NT) {
      int mt, nt;
      grouped_tile(task, MT, NT, mt, nt);
      int o0 = mt * 128;
      int arow = o0 + (o0 < 16384 ? 16 * (o0 / 4096 + 1) : 64);
      const float* xin = (o0 < 16384 ? p.x_prompt + (size_t)o0 * D : p.x_sample + (size_t)(o0 - 16384) * D) + nt * 128;
      float* xo = p.out + (size_t)o0 * D + nt * 128;
      u16* xb = (u16*)(p.ws + WS_X1B) + (size_t)o0 * D + nt * 128;
      float rs[4] = {0.f, 0.f, 0.f, 0.f};
      gemm_tile(mix + (size_t)arow * 1024, 1024, wt + (size_t)nt * 128 * 1024, 1024, 1024, smem,
                [&](int m, int r, int c, f32x4 v) {
                  float4 xi = *(const float4*)(xin + (size_t)r * D + c);
                  float4 xv = float4{xi.x + v[0], xi.y + v[1], xi.z + v[2], xi.w + v[3]};
                  *(float4*)(xo + (size_t)r * D + c) = xv;
                  *(uint2*)(xb + (size_t)r * D + c) = uint2{pack2bf(xv.x, xv.y), pack2bf(xv.z, xv.w)};
                  rs[m] += xv.x * xv.x + xv.y * xv.y + xv.z * xv.z + xv.w * xv.w;
                });
      {
        const int lane_ = threadIdx.x & 63, wid_ = threadIdx.x >> 6, wr_ = wid_ >> 1, wc_ = wid_ & 1;
        float* ssq = (float*)(p.ws + WS_SSQ);
#pragma unroll
        for (int m = 0; m < 4; ++m) {
          float t = rs[m];
          t += __shfl_xor(t, 16, 64);
          t += __shfl_xor(t, 32, 64);
          if ((lane_ >> 4) == 0) ssq[(size_t)(o0 + wr_ * 64 + m * 16 + (lane_ & 15)) * 16 + nt * 2 + wc_] = t;
        }
      }
    }
  }
}

__device__ void phase8(const Params& p, char* smem) {
  const u16* xb = (const u16*)(p.ws + WS_X1B);
  const u16* wt = (const u16*)(p.ws + WS_WQ);
  const float* ssq = (const float*)(p.ws + WS_SSQ);
  u16* q = (u16*)(p.ws + WS_Q);
  constexpr int MT = NOUT / 128, NT = 16, TOT = MT * NT;
  const int lane = threadIdx.x & 63, wr = (threadIdx.x >> 6) >> 1, fr = lane & 15;
  const int G = gridDim.x, full = p.full8, ntask = full + 4 * (TOT - full);
  auto row_rstd = [&](size_t row) {
    const float4* sp = (const float4*)(ssq + row * 16);
    float4 a = sp[0], b = sp[1], c = sp[2], d = sp[3];
    float ss = ((a.x + a.y) + (a.z + a.w)) + ((b.x + b.y) + (b.z + b.w)) + ((c.x + c.y) + (c.z + c.w)) + ((d.x + d.y) + (d.z + d.w));
    return rsqrtf(ss * (1.f / 1024.f) + 1e-5f);
  };
  for (int task = xcd_vid(); task < ntask; task += G) {
    int mt, nt;
    if (task < full) {
      grouped_tile(task, MT, NT, mt, nt);
      u16* crow = q + (size_t)mt * 128 * 2048 + nt * 128;
      float rstd[4];
#pragma unroll
      for (int m = 0; m < 4; ++m) rstd[m] = row_rstd((size_t)mt * 128 + wr * 64 + m * 16 + fr);
      gemm_tile(xb + (size_t)mt * 128 * D, D, wt + (size_t)nt * 128 * D, D, D, smem,
                [&](int m, int r, int c, f32x4 v) {
                  float sc = rstd[m];
                  *(uint2*)(crow + (size_t)r * 2048 + c) = uint2{pack2bf(v[0] * sc, v[1] * sc), pack2bf(v[2] * sc, v[3] * sc)};
                });
    } else {
      int rem = task - full, qd = rem & 3;
      grouped_tile(full + (rem >> 2), MT, NT, mt, nt);
      size_t r0 = (size_t)mt * 128 + qd * 32;
      u16* crow = q + r0 * 2048 + nt * 128;
      float rstd[2];
#pragma unroll
      for (int m = 0; m < 2; ++m) rstd[m] = row_rstd(r0 + m * 16 + fr);
      gemm_qtile(xb + r0 * D, D, wt + (size_t)nt * 128 * D, D, D, smem,
                 [&](int m, int r, int c, f32x4 v) {
                   float sc = rstd[m];
                   *(uint2*)(crow + (size_t)r * 2048 + c) = uint2{pack2bf(v[0] * sc, v[1] * sc), pack2bf(v[2] * sc, v[3] * sc)};
                 });
    }
  }
}

__device__ __forceinline__ unsigned ford(float f) {
  unsigned u = __float_as_uint(f);
  return (u & 0x80000000u) ? ~u : (u | 0x80000000u);
}
__device__ __forceinline__ float fdeord(unsigned k) {
  unsigned u = (k & 0x80000000u) ? (k & 0x7fffffffu) : ~k;
  return __uint_as_float(u);
}
__device__ __forceinline__ unsigned umax_(unsigned a, unsigned b) { return a > b ? a : b; }
__device__ __forceinline__ unsigned umin_(unsigned a, unsigned b) { return a < b ? a : b; }

#define CE_DESC(a, b) { unsigned _x = umax_(a, b), _y = umin_(a, b); a = _x; b = _y; }
#define CE_ASC(a, b) { unsigned _x = umin_(a, b), _y = umax_(a, b); a = _x; b = _y; }

template <int N>
__device__ __forceinline__ void bitonic_sort_desc(unsigned (&k)[N]) {
#pragma unroll
  for (int sz = 2; sz <= N; sz <<= 1) {
#pragma unroll
    for (int st = sz >> 1; st > 0; st >>= 1) {
#pragma unroll
      for (int i = 0; i < N; ++i) {
        int l = i ^ st;
        if (l > i) {
          if ((i & sz) == 0) CE_DESC(k[i], k[l]) else CE_ASC(k[i], k[l])
        }
      }
    }
  }
}
template <int N>
__device__ __forceinline__ void bitonic_merge_desc(unsigned (&k)[N]) {
#pragma unroll
  for (int st = N >> 1; st > 0; st >>= 1) {
#pragma unroll
    for (int i = 0; i < N; ++i) {
      int l = i ^ st;
      if (l > i) CE_DESC(k[i], k[l])
    }
  }
}
__device__ __forceinline__ void cross_merge16(unsigned (&k)[16]) {
#pragma unroll
  for (int x = 16; x <= 32; x <<= 1) {
    unsigned o[16];
#pragma unroll
    for (int i = 0; i < 16; ++i) o[i] = (unsigned)__shfl_xor((int)k[i], x, 64);
#pragma unroll
    for (int i = 0; i < 16; ++i) k[i] = umax_(k[i], o[15 - i]);
    bitonic_merge_desc<16>(k);
  }
}

__device__ __forceinline__ unsigned sel16(const unsigned (&a)[16], int k) {
  unsigned r = a[0];
#pragma unroll
  for (int i = 1; i < 16; ++i) r = (k == i) ? a[i] : r;
  return r;
}

__device__ void topk_unit(const Params& p, const char* smem, int tg, int h) {
  const int tid = threadIdx.x, lane = tid & 63, fr = lane & 15, fq = lane >> 4;
  const u16* q = (const u16*)(p.ws + WS_Q);
  int* idxo = (int*)(p.ws + WS_IDX);
  float* gateo = (float*)(p.ws + WS_GATE);
  const int o0 = tg * 16;
  float v1[16], v2[16];
  unsigned pk1[4] = {0u, 0u, 0u, 0u}, pk2[4] = {0u, 0u, 0u, 0u};
#pragma unroll
  for (int c = 0; c < 2; ++c) {
    bf16x8 qb[4];
#pragma unroll
    for (int ks = 0; ks < 4; ++ks)
      qb[ks] = *(const bf16x8*)(q + (size_t)(o0 + fr) * 2048 + (h * 2 + c) * 128 + ks * 32 + fq * 8);
    f32x4 acc[8];
#pragma unroll
    for (int i = 0; i < 8; ++i) acc[i] = f32x4{0.f, 0.f, 0.f, 0.f};
#pragma unroll
    for (int ks = 0; ks < 4; ++ks) {
#pragma unroll
      for (int mt = 0; mt < 8; ++mt) {
        bf16x8 ka = *(const bf16x8*)(smem + (c * 128 + mt * 16 + fr) * 256 + (((ks * 4 + fq) ^ fr) << 4));
        acc[mt] = mfma16(ka, qb[ks], acc[mt]);
      }
      __builtin_amdgcn_sched_barrier(0);
    }
    unsigned lo[16], hi[16];
#pragma unroll
    for (int mt = 0; mt < 4; ++mt)
#pragma unroll
      for (int j = 0; j < 4; ++j) {
        lo[mt * 4 + j] = (ford(acc[mt][j]) & 0xffffff80u) | (unsigned)(127 - (mt * 16 + fq * 4 + j));
        hi[mt * 4 + j] = (ford(acc[mt + 4][j]) & 0xffffff80u) | (unsigned)(127 - ((mt + 4) * 16 + fq * 4 + j));
      }
    bitonic_sort_desc<16>(lo);
    bitonic_sort_desc<16>(hi);
#pragma unroll
    for (int i = 0; i < 16; ++i) lo[i] = umax_(lo[i], hi[15 - i]);
    bitonic_merge_desc<16>(lo);
    cross_merge16(lo);
#pragma unroll
    for (int i = 0; i < 16; ++i) {
      float val = fdeord(lo[i] & 0xffffff80u);
      unsigned ix = (127u - (lo[i] & 0x7fu)) << ((i & 3) * 8);
      if (c == 0) { v1[i] = val; pk1[i >> 2] |= ix; } else { v2[i] = val; pk2[i >> 2] |= ix; }
    }
  }
  unsigned ck[16];
#define CAND(i, j) ((ford(v1[i] + v2[j]) & 0xffffff00u) | (unsigned)((i) * 16 + (j)))
#define SEL4(slot, A, B, C, Dv) ck[slot] = (fq == 0) ? (A) : (fq == 1) ? (B) : (fq == 2) ? (C) : (Dv);
  SEL4(0, CAND(0, 0), CAND(1, 0), CAND(3, 3), CAND(14, 0))
  SEL4(1, CAND(0, 1), CAND(1, 1), CAND(4, 0), CAND(15, 0))
  SEL4(2, CAND(0, 2), CAND(1, 2), CAND(4, 1), 0u)
  SEL4(3, CAND(0, 3), CAND(1, 3), CAND(4, 2), 0u)
  SEL4(4, CAND(0, 4), CAND(1, 4), CAND(5, 0), 0u)
  SEL4(5, CAND(0, 5), CAND(1, 5), CAND(5, 1), 0u)
  SEL4(6, CAND(0, 6), CAND(1, 6), CAND(6, 0), 0u)
  SEL4(7, CAND(0, 7), CAND(1, 7), CAND(6, 1), 0u)
  SEL4(8, CAND(0, 8), CAND(2, 0), CAND(7, 0), 0u)
  SEL4(9, CAND(0, 9), CAND(2, 1), CAND(7, 1), 0u)
  SEL4(10, CAND(0, 10), CAND(2, 2), CAND(8, 0), 0u)
  SEL4(11, CAND(0, 11), CAND(2, 3), CAND(9, 0), 0u)
  SEL4(12, CAND(0, 12), CAND(2, 4), CAND(10, 0), 0u)
  SEL4(13, CAND(0, 13), CAND(3, 0), CAND(11, 0), 0u)
  SEL4(14, CAND(0, 14), CAND(3, 1), CAND(12, 0), 0u)
  SEL4(15, CAND(0, 15), CAND(3, 2), CAND(13, 0), 0u)
#undef SEL4
#undef CAND
  bitonic_sort_desc<16>(ck);
  cross_merge16(ck);
  float top[16], esum = 0.f;
#pragma unroll
  for (int i = 0; i < 16; ++i) top[i] = fdeord(ck[i] & 0xffffff00u);
  const float tmax = top[0];
#pragma unroll
  for (int i = 0; i < 16; ++i) top[i] = __expf(top[i] - tmax);
#pragma unroll
  for (int i = 0; i < 16; ++i) esum += top[i];
  float inv = 1.f / esum;
  int oi[4];
  float og[4];
#pragma unroll
  for (int jj = 0; jj < 4; ++jj) {
    unsigned kk = (fq == 0) ? ck[jj] : (fq == 1) ? ck[4 + jj] : (fq == 2) ? ck[8 + jj] : ck[12 + jj];
    float tv = (fq == 0) ? top[jj] : (fq == 1) ? top[4 + jj] : (fq == 2) ? top[8 + jj] : top[12 + jj];
    int code = (int)(kk & 0xffu);
    int ci = code >> 4, cj = code & 15;
    unsigned d1 = (ci < 8) ? ((ci < 4) ? pk1[0] : pk1[1]) : ((ci < 12) ? pk1[2] : pk1[3]);
    unsigned d2 = (cj < 8) ? ((cj < 4) ? pk2[0] : pk2[1]) : ((cj < 12) ? pk2[2] : pk2[3]);
    int i1 = (int)((d1 >> ((ci & 3) * 8)) & 0xffu), i2 = (int)((d2 >> ((cj & 3) * 8)) & 0xffu);
    oi[jj] = i1 * 128 + i2;
    og[jj] = tv * inv;
  }
  size_t ob = (size_t)(o0 + fr) * 128 + h * 16 + fq * 4;
  *(int4*)(idxo + ob) = int4{oi[0], oi[1], oi[2], oi[3]};
  *(float4*)(gateo + ob) = float4{og[0], og[1], og[2], og[3]};
}

__device__ void phase9(const Params& p, char* smem) {
  const int w = threadIdx.x >> 6;
  {
    const u16* subk = (const u16*)(p.ws + WS_SUBK);
    for (int i = threadIdx.x; i < 4096; i += 256) {
      int row = i >> 4, lc = i & 15;
      *(uint4*)(smem + row * 256 + ((lc ^ (row & 15)) << 4)) = *(const uint4*)(subk + row * 128 + lc * 8);
    }
    __syncthreads();
  }
  for (int task = blockIdx.x; task < (NOUT / 16) * 2; task += gridDim.x) {
    int tg = task >> 1, h = (task & 1) * 4 + w;
    topk_unit(p, smem, tg, h);
  }
  __syncthreads();
}

#define F4(w, b) __builtin_amdgcn_cvt_scalef32_pk_f32_fp4((w), 1.0f, (b))
__device__ __forceinline__ float dot16f8(const float* h, uint2 u, float acc) {
  unsigned w[2] = {u.x, u.y};
#pragma unroll
  for (int i = 0; i < 2; ++i) {
    float2v v0 = F4(w[i], 0), v1 = F4(w[i], 1), v2 = F4(w[i], 2), v3 = F4(w[i], 3);
    acc = fmaf(h[8 * i], v0.x, acc); acc = fmaf(h[8 * i + 1], v0.y, acc);
    acc = fmaf(h[8 * i + 2], v1.x, acc); acc = fmaf(h[8 * i + 3], v1.y, acc);
    acc = fmaf(h[8 * i + 4], v2.x, acc); acc = fmaf(h[8 * i + 5], v2.y, acc);
    acc = fmaf(h[8 * i + 6], v3.x, acc); acc = fmaf(h[8 * i + 7], v3.y, acc);
  }
  return acc;
}
__device__ __forceinline__ void axpy16f8(float a, uint2 v, float* acc) {
  unsigned w[2] = {v.x, v.y};
#pragma unroll
  for (int i = 0; i < 2; ++i) {
    float2v v0 = F4(w[i], 0), v1 = F4(w[i], 1), v2 = F4(w[i], 2), v3 = F4(w[i], 3);
    acc[8 * i] = fmaf(a, v0.x, acc[8 * i]); acc[8 * i + 1] = fmaf(a, v0.y, acc[8 * i + 1]);
    acc[8 * i + 2] = fmaf(a, v1.x, acc[8 * i + 2]); acc[8 * i + 3] = fmaf(a, v1.y, acc[8 * i + 3]);
    acc[8 * i + 4] = fmaf(a, v2.x, acc[8 * i + 4]); acc[8 * i + 5] = fmaf(a, v2.y, acc[8 * i + 5]);
    acc[8 * i + 6] = fmaf(a, v3.x, acc[8 * i + 6]); acc[8 * i + 7] = fmaf(a, v3.y, acc[8 * i + 7]);
  }
}
__device__ __forceinline__ float reduce4(float d0, float d1, float d2, float d3) {
  auto s1 = __builtin_amdgcn_permlane32_swap(__float_as_uint(d0), __float_as_uint(d1), false, false);
  float s01 = __uint_as_float(s1[0]) + __uint_as_float(s1[1]);
  auto s2 = __builtin_amdgcn_permlane32_swap(__float_as_uint(d2), __float_as_uint(d3), false, false);
  float s23 = __uint_as_float(s2[0]) + __uint_as_float(s2[1]);
  auto s3 = __builtin_amdgcn_permlane16_swap(__float_as_uint(s01), __float_as_uint(s23), false, false);
  float t = __uint_as_float(s3[0]) + __uint_as_float(s3[1]);
  return red16(t);
}

__device__ void gather_task(const Params& p, int task) {
  const int wave = threadIdx.x >> 6, lane = threadIdx.x & 63;
  int o = task * 4 + wave;
  const unsigned char* eu8 = (const unsigned char*)(p.ws + WS_EU) + lane * 8;
  const unsigned char* ev8 = (const unsigned char*)(p.ws + WS_EV) + lane * 8;
  const float* scu = (const float*)(p.ws + WS_SCU);
  const float* scv = (const float*)(p.ws + WS_SCV);
  const int* idx = (const int*)(p.ws + WS_IDX) + (size_t)o * 128;
  const float* gate = (const float*)(p.ws + WS_GATE) + (size_t)o * 128;
  float* xrow = p.out + (size_t)o * D + lane * 16;
  float hf[16];
  {
    float x[16];
#pragma unroll
    for (int i = 0; i < 4; ++i) {
      float4 a = ((const float4*)xrow)[i];
      x[4 * i] = a.x; x[4 * i + 1] = a.y; x[4 * i + 2] = a.z; x[4 * i + 3] = a.w;
    }
    float ss2 = 0.f;
#pragma unroll
    for (int i = 0; i < 16; ++i) ss2 += x[i] * x[i];
    ss2 = wave_sum(ss2);
    float sc2 = rsqrtf(ss2 * (1.f / 1024.f) + 1e-5f);
    const float* g2 = p.norm2_g + lane * 16;
#pragma unroll
    for (int i = 0; i < 4; ++i) {
      float4 gg = ((const float4*)g2)[i];
      hf[4 * i] = x[4 * i] * sc2 * gg.x; hf[4 * i + 1] = x[4 * i + 1] * sc2 * gg.y;
      hf[4 * i + 2] = x[4 * i + 2] * sc2 * gg.z; hf[4 * i + 3] = x[4 * i + 3] * sc2 * gg.w;
    }
  }
  float acc[16];
#pragma unroll
  for (int i = 0; i < 16; ++i) acc[i] = 0.f;
  const int rw = lane >> 4;
  const int kl = (lane & 3) * 4 + ((rw == 1) ? 2 : (rw == 2) ? 1 : rw);
  for (int kb = 0; kb < 8; ++kb) {
    int myidx = idx[kb * 16 + (lane & 15)];
    int myidx2 = idx[kb * 16 + kl];
    float mygate = gate[kb * 16 + kl];
    float su = scu[myidx2], sv = scv[myidx2];
    float mypre = 0.f;
#pragma unroll
    for (int e4 = 0; e4 < 4; ++e4) {
      uint2 ua[4];
#pragma unroll
      for (int e = 0; e < 4; ++e) {
        int ei = __builtin_amdgcn_readlane(myidx, e4 * 4 + e);
        ua[e] = *(const uint2*)(eu8 + (size_t)ei * 512);
      }
      float d[4];
#pragma unroll
      for (int e = 0; e < 4; ++e) d[e] = dot16f8(hf, ua[e], 0.f);
      float tot = reduce4(d[0], d[1], d[2], d[3]);
      mypre = ((lane & 3) == e4) ? tot : mypre;
    }
    mypre *= su;
    float myact = 0.5f * mypre * (1.f + erff(mypre * 0.70710678118654752f)) * mygate * sv;
#pragma unroll
    for (int e4 = 0; e4 < 4; ++e4) {
      uint2 va[4];
      float a[4];
#pragma unroll
      for (int e = 0; e < 4; ++e) {
        int ei = __builtin_amdgcn_readlane(myidx, e4 * 4 + e);
        const int pr = (e == 1) ? 2 : (e == 2) ? 1 : e;
        a[e] = rdlane(myact, pr * 16 + e4);
        va[e] = *(const uint2*)(ev8 + (size_t)ei * 512);
      }
#pragma unroll
      for (int e = 0; e < 4; ++e) axpy16f8(a[e], va[e], acc);
    }
  }
  float x[16];
#pragma unroll
  for (int i = 0; i < 4; ++i) {
    float4 a = ((const float4*)xrow)[i];
    x[4 * i] = a.x; x[4 * i + 1] = a.y; x[4 * i + 2] = a.z; x[4 * i + 3] = a.w;
  }
  float ss = 0.f;
#pragma unroll
  for (int i = 0; i < 16; ++i) { x[i] += acc[i]; ss += x[i] * x[i]; }
  ss = wave_sum(ss);
  float sc = rsqrtf(ss * (1.f / 1024.f) + 1e-5f);
  const float* g = p.final_g + lane * 16;
#pragma unroll
  for (int i = 0; i < 4; ++i) {
    float4 gg = ((const float4*)g)[i];
    ((float4*)xrow)[i] = float4{x[4 * i] * sc * gg.x, x[4 * i + 1] * sc * gg.y, x[4 * i + 2] * sc * gg.z, x[4 * i + 3] * sc * gg.w};
  }
}

__device__ void gather_task_block(const Params& p, char* smem, int o) {
  const int wave = threadIdx.x >> 6, lane = threadIdx.x & 63;
  const unsigned char* eu8 = (const unsigned char*)(p.ws + WS_EU) + lane * 8;
  const unsigned char* ev8 = (const unsigned char*)(p.ws + WS_EV) + lane * 8;
  const float* scu = (const float*)(p.ws + WS_SCU);
  const float* scv = (const float*)(p.ws + WS_SCV);
  const int* idx = (const int*)(p.ws + WS_IDX) + (size_t)o * 128;
  const float* gate = (const float*)(p.ws + WS_GATE) + (size_t)o * 128;
  float* orow = p.out + (size_t)o * D;
  float hf[16];
  {
    const float* xrow = orow + lane * 16;
    float x[16];
#pragma unroll
    for (int i = 0; i < 4; ++i) {
      float4 a = ((const float4*)xrow)[i];
      x[4 * i] = a.x; x[4 * i + 1] = a.y; x[4 * i + 2] = a.z; x[4 * i + 3] = a.w;
    }
    float ss2 = 0.f;
#pragma unroll
    for (int i = 0; i < 16; ++i) ss2 += x[i] * x[i];
    ss2 = wave_sum(ss2);
    float sc2 = rsqrtf(ss2 * (1.f / 1024.f) + 1e-5f);
    const float* g2 = p.norm2_g + lane * 16;
#pragma unroll
    for (int i = 0; i < 4; ++i) {
      float4 gg = ((const float4*)g2)[i];
      hf[4 * i] = x[4 * i] * sc2 * gg.x; hf[4 * i + 1] = x[4 * i + 1] * sc2 * gg.y;
      hf[4 * i + 2] = x[4 * i + 2] * sc2 * gg.z; hf[4 * i + 3] = x[4 * i + 3] * sc2 * gg.w;
    }
  }
  float acc[16];
#pragma unroll
  for (int i = 0; i < 16; ++i) acc[i] = 0.f;
  const int rw = lane >> 4;
  const int kl = (lane & 3) * 4 + ((rw == 1) ? 2 : (rw == 2) ? 1 : rw);
#pragma unroll
  for (int kq = 0; kq < 2; ++kq) {
    const int kb = wave * 2 + kq;
    int myidx = idx[kb * 16 + (lane & 15)];
    int myidx2 = idx[kb * 16 + kl];
    float mygate = gate[kb * 16 + kl];
    float su = scu[myidx2], sv = scv[myidx2];
    float mypre = 0.f;
#pragma unroll
    for (int e4 = 0; e4 < 4; ++e4) {
      uint2 ua[4];
#pragma unroll
      for (int e = 0; e < 4; ++e) {
        int ei = __builtin_amdgcn_readlane(myidx, e4 * 4 + e);
        ua[e] = *(const uint2*)(eu8 + (size_t)ei * 512);
      }
      float d[4];
#pragma unroll
      for (int e = 0; e < 4; ++e) d[e] = dot16f8(hf, ua[e], 0.f);
      float tot = reduce4(d[0], d[1], d[2], d[3]);
      mypre = ((lane & 3) == e4) ? tot : mypre;
    }
    mypre *= su;
    float myact = 0.5f * mypre * (1.f + erff(mypre * 0.70710678118654752f)) * mygate * sv;
#pragma unroll
    for (int e4 = 0; e4 < 4; ++e4) {
      uint2 va[4];
      float a[4];
#pragma unroll
      for (int e = 0; e < 4; ++e) {
        int ei = __builtin_amdgcn_readlane(myidx, e4 * 4 + e);
        const int pr = (e == 1) ? 2 : (e == 2) ? 1 : e;
        a[e] = rdlane(myact, pr * 16 + e4);
        va[e] = *(const uint2*)(ev8 + (size_t)ei * 512);
      }
#pragma unroll
      for (int e = 0; e < 4; ++e) axpy16f8(a[e], va[e], acc);
    }
  }
  float* part = (float*)smem;
  float* red = part + 4096;
#pragma unroll
  for (int i = 0; i < 4; ++i)
    *(float4*)(part + wave * 1024 + lane * 16 + 4 * i) = float4{acc[4 * i], acc[4 * i + 1], acc[4 * i + 2], acc[4 * i + 3]};
  __syncthreads();
  const int c = threadIdx.x * 4;
  float4 xv = *(const float4*)(orow + c);
#pragma unroll
  for (int k = 0; k < 4; ++k) {
    float4 pv = *(const float4*)(part + k * 1024 + c);
    xv.x += pv.x; xv.y += pv.y; xv.z += pv.z; xv.w += pv.w;
  }
  float ss = wave_sum(xv.x * xv.x + xv.y * xv.y + xv.z * xv.z + xv.w * xv.w);
  if (lane == 0) red[wave] = ss;
  __syncthreads();
  ss = (red[0] + red[1]) + (red[2] + red[3]);
  float sc = rsqrtf(ss * (1.f / 1024.f) + 1e-5f);
  float4 gg = *(const float4*)(p.final_g + c);
  *(float4*)(orow + c) = float4{xv.x * sc * gg.x, xv.y * sc * gg.y, xv.z * sc * gg.z, xv.w * sc * gg.w};
  __syncthreads();
}

__device__ void phase10(const Params& p, char* smem) {
  const int G = gridDim.x, full = p.full10;
  for (int task = blockIdx.x; task < full; task += G) gather_task(p, task);
  for (int o = full * 4 + blockIdx.x; o < NOUT; o += G) gather_task_block(p, smem, o);
}

#define XB_TMO      128
#define XB_XCNT(j)  (256  + 64 * (j))
#define XB_XSUB(j)  (1280 + 64 * (j))
#define XB_XGEN(j)  (2304 + 64 * (j))
#define XB_TOP      3328
#define XB_TOPGEN   3392
#define XCD_BAR_WORDS 3456
#define XB_SPIN_CAP (1u << 20)
__device__ __forceinline__ unsigned xb_ld(unsigned* p) { return __hip_atomic_load(p, __ATOMIC_RELAXED, __HIP_MEMORY_SCOPE_AGENT); }
__device__ __forceinline__ unsigned xb_add(unsigned* p, unsigned v) { return __hip_atomic_fetch_add(p, v, __ATOMIC_RELAXED, __HIP_MEMORY_SCOPE_AGENT); }
__device__ __forceinline__ unsigned xb_xcc_id() { return (unsigned)__builtin_amdgcn_s_getreg((3 << 11) | 20) & 0xFu; }
#define XB_SPIN(cond, bar) do { unsigned _sp = 0; while (cond) { __builtin_amdgcn_s_sleep(1); \
    if ((++_sp & 255u) == 0u) { if (xb_ld(&(bar)[XB_TMO])) break; if (_sp > XB_SPIN_CAP) { atomicAdd(&(bar)[XB_TMO], 1u); break; } } } } while (0)

struct GridBar { int dummy; };

__device__ __forceinline__ GridBar gb_init(unsigned* bar) {
  GridBar b;
  b.dummy = 0;
  if (threadIdx.x == 0) (void)xb_add(&bar[XB_XCNT(xb_xcc_id())], 1u);
  return b;
}
__device__ __forceinline__ void gb_census(unsigned* bar, unsigned x, unsigned& nloc, unsigned& nx) {
  const unsigned G = gridDim.x;
  unsigned sum, cnt, mine, sp = 0u;
  for (;;) {
    sum = 0u; cnt = 0u; mine = 0u;
#pragma unroll
    for (unsigned j = 0; j < 16; ++j) {
      const unsigned c = xb_ld(&bar[XB_XCNT(j)]);
      sum += c; cnt += (c > 0u) ? 1u : 0u; mine = (j == x) ? c : mine;
    }
    if (sum == G) break;
    __builtin_amdgcn_s_sleep(1);
    if ((++sp & 255u) == 0u) { if (xb_ld(&bar[XB_TMO])) break; if (sp > XB_SPIN_CAP) { atomicAdd(&bar[XB_TMO], 1u); break; } }
  }
  nloc = mine > 0u ? mine : 1u; nx = cnt > 0u ? cnt : 1u;
}
template <bool FIRST>
__device__ __forceinline__ void gb_sync(GridBar& b, unsigned* bar) {
  asm volatile("s_waitcnt vmcnt(0)" ::: "memory");
  __syncthreads();
  if (threadIdx.x == 0) {
    const unsigned x = xb_xcc_id();
    __builtin_amdgcn_s_waitcnt(0);
    unsigned* slot = bar + 4096 + 2 * blockIdx.x;
    unsigned nloc, nx;
    if (FIRST) { gb_census(bar, x, nloc, nx); slot[0] = nloc; slot[1] = nx; }
    else { nloc = __hip_atomic_load(&slot[0], __ATOMIC_RELAXED, __HIP_MEMORY_SCOPE_AGENT); nx = __hip_atomic_load(&slot[1], __ATOMIC_RELAXED, __HIP_MEMORY_SCOPE_AGENT); }
    const unsigned old = xb_add(&bar[XB_XSUB(x)], 1u);
    const unsigned gen = old / nloc;
    if (old + 1u == (gen + 1u) * nloc) {
      __builtin_amdgcn_fence(__ATOMIC_RELEASE, "agent");
      asm volatile("s_waitcnt vmcnt(0)" ::: "memory");
      const unsigned og = xb_add(&bar[XB_TOP], 1u);
      const unsigned tg = og / nx;
      if (og + 1u == (tg + 1u) * nx) xb_add(&bar[XB_TOPGEN], 1u);
      else XB_SPIN(xb_ld(&bar[XB_TOPGEN]) == tg, bar);
      __builtin_amdgcn_fence(__ATOMIC_ACQUIRE, "agent");
      xb_add(&bar[XB_XGEN(x)], 1u);
      asm volatile("s_waitcnt vmcnt(0)" ::: "memory");
    } else {
      XB_SPIN(xb_ld(&bar[XB_XGEN(x)]) == gen, bar);
      __builtin_amdgcn_fence(__ATOMIC_ACQUIRE, "agent");
      asm volatile("s_waitcnt vmcnt(0)" ::: "memory");
    }
  }
  __syncthreads();
}

template <int PH>
__device__ __forceinline__ void run_phase(const Params& p, char* smem) {
  if constexpr (PH == 0) phase0(p, smem);
  if constexpr (PH == 1) phase1(p, smem);
  if constexpr (PH == 2) phase2(p);
  if constexpr (PH == 3) phase3(p, smem);
  if constexpr (PH == 4) phase4(p, smem);
  if constexpr (PH == 5) phase5(p);
  if constexpr (PH == 6) phase6(p, smem);
  if constexpr (PH == 8) phase8(p, smem);
  if constexpr (PH == 9) phase9(p, smem);
  if constexpr (PH == 10) phase10(p, smem);
}

template <int LO, int HI>
__device__ __forceinline__ void run_range(const Params& p, char* smem, GridBar& gb) {
  if constexpr (LO < HI) {
    run_phase<LO>(p, smem);
    if constexpr (LO + 1 < HI) {
      if constexpr (LO != 7) gb_sync<LO == 0>(gb, (unsigned*)(p.ws + WS_BAR));
      run_range<LO + 1, HI>(p, smem, gb);
    }
  }
}

template <int LO, int HI>
__global__ void __launch_bounds__(256, 2) fwd_kernel(Params p) {
  __shared__ __attribute__((aligned(16))) char smem[SMEM_BYTES];
  if (p.ws == nullptr) cg::this_grid().sync();
  GridBar gb = gb_init((unsigned*)(p.ws + WS_BAR));
  run_range<LO, HI>(p, smem, gb);
}

template <int PH>
static void launch_one(const Params& p, int grid, hipStream_t stream) {
  fwd_kernel<PH, PH + 1><<<grid, 256, 0, stream>>>(p);
}

extern "C" void kernel_launch(void* const* d_in, const int* in_sizes, int n_in, void* d_out, int out_size, void* d_ws,
                              size_t ws_size, hipStream_t stream) {
  Params p{};
  const float** pp = (const float**)&p;
  for (int i = 0; i < 28; ++i) pp[i] = (const float*)d_in[i];
  p.out = (float*)d_out;
  p.ws = (char*)d_ws;
#if MULTI_LAUNCH
  const int grid = 1024;
  p.full1 = ((MROWS / 128) * 20 / grid) * grid; p.full8 = ((NOUT / 128) * 16 / grid) * grid; p.full10 = ((NOUT / 4) / grid) * grid; p.pad_ = 0;
  launch_one<0>(p, grid, stream);
  launch_one<1>(p, grid, stream);
  launch_one<2>(p, grid, stream);
  launch_one<3>(p, grid, stream);
  launch_one<4>(p, grid, stream);
  launch_one<5>(p, grid, stream);
  launch_one<6>(p, grid, stream);
  launch_one<7>(p, grid, stream);
  launch_one<8>(p, grid, stream);
  launch_one<9>(p, grid, stream);
  launch_one<10>(p, grid, stream);
#else
  static int grid_blocks = 0;
  if (!grid_blocks) {
    int dev = 0, cus = 0, per_cu = 0;
    (void)hipGetDevice(&dev);
    (void)hipDeviceGetAttribute(&cus, hipDeviceAttributeMultiprocessorCount, dev);
    (void)hipOccupancyMaxActiveBlocksPerMultiprocessor(&per_cu, fwd_kernel<0, NPH>, 256, 0);
    if (per_cu < 1) per_cu = 1;
    if (per_cu > 4) per_cu = 4;
    grid_blocks = cus * per_cu;
  }
  (void)hipMemsetAsync((char*)d_ws + WS_BAR, 0, XCD_BAR_WORDS * sizeof(unsigned), stream);
  p.full1 = ((MROWS / 128) * 20 / grid_blocks) * grid_blocks;
  p.full8 = ((NOUT / 128) * 16 / grid_blocks) * grid_blocks;
  p.full10 = ((NOUT / 4) / grid_blocks) * grid_blocks;
  p.pad_ = 0;
  void* args[] = {&p};
  hipError_t e = hipLaunchCooperativeKernel((void*)fwd_kernel<0, NPH>, dim3(grid_blocks), dim3(256), args, 0, stream);
  if (e != hipSuccess) fprintf(stderr, "cooperative launch failed: %s (grid %d)\n", hipGetErrorString(e), grid_blocks);
#endif
}
```

```cpp
#include <hip/hip_runtime.h>
#include <hip/hip_cooperative_groups.h>
#include <cstdio>
#include <cstdint>
namespace cg = cooperative_groups;

typedef unsigned short u16;
using bf16x8 = __attribute__((ext_vector_type(8))) short;
using f32x4 = __attribute__((ext_vector_type(4))) float;
using half2v = __attribute__((ext_vector_type(2))) _Float16;
using float2v = __attribute__((ext_vector_type(2))) float;

#ifndef MULTI_LAUNCH
#define MULTI_LAUNCH 0
#endif

constexpr int D = 1024, NIN = 2560;
constexpr int LP = 4112, NB = 4, TP = NB * LP;
constexpr int SB = 128, TS = 512;
constexpr int TTOK = TP + TS;
constexpr int PREV0 = TTOK;
constexpr int MROWS = 17152;
constexpr int TPAD = 17024;
constexpr int NOUT = 16896;
constexpr int PAST = 8192;
constexpr int NPH = 11;

constexpr size_t O_YP = 0;
constexpr size_t O_KWP = 17301504, O_VWP = 17367040, O_WKVP = 17432576, O_SHP = 17563648;
constexpr size_t O_KWS = 17567744, O_VWS = 19664896, O_WKVS = 21762048, O_SHS = 25956352;

constexpr size_t WS_WIN = 0;
constexpr size_t WS_WOUT = WS_WIN + 2560ull * 1024 * 2;
constexpr size_t WS_WQ = WS_WOUT + 1024ull * 1024 * 2;
constexpr size_t WS_SUBK = WS_WQ + 2048ull * 1024 * 2;
constexpr size_t WS_W2W = WS_SUBK + 2ull * 128 * 128 * 2;
constexpr size_t WS_W2A = WS_W2W + 512ull * 64 * 2;
constexpr size_t WS_W2G = WS_W2A + 512ull * 64 * 2;
constexpr size_t WS_B = WS_W2G + 512ull * 128 * 2;
constexpr size_t WS_C = WS_B + (size_t)MROWS * 1024 * 2;
constexpr size_t WS_D = WS_C + (size_t)MROWS * NIN * 2;
constexpr size_t WS_E = WS_D + (size_t)TPAD * 512 * 8;
constexpr size_t WS_END = WS_E + (size_t)TPAD * 512 * 4;
constexpr size_t WS_DEC = WS_D, WS_A = WS_D + (size_t)TPAD * 512 * 4, WS_G = WS_A + (size_t)TPAD * 512 * 2;
constexpr size_t WS_EU = WS_E, WS_EV = WS_E + 16384ull * 512, WS_SCU = WS_EV + 16384ull * 512, WS_SCV = WS_SCU + 65536;
constexpr size_t WS_X1B = WS_D, WS_SSQ = WS_D + 40ull * 1024 * 1024;
constexpr size_t WS_Q = WS_C, WS_IDX = WS_C + (size_t)NOUT * 2048 * 2, WS_GATE = WS_IDX + (size_t)NOUT * 128 * 4;
static_assert(WS_SCV + 65536 <= WS_END, "expert tables overflow region E");
static_assert(WS_X1B + (size_t)NOUT * 2048 <= WS_SSQ && WS_SSQ + (size_t)NOUT * 64 <= WS_E, "x1b/ssq overflow region D");
static_assert(WS_GATE + (size_t)NOUT * 128 * 4 <= WS_D, "idx/gate overflow region C");
constexpr size_t WS_BAR = WS_END;
static_assert(WS_BAR + 32768 <= 256ull * 1024 * 1024, "workspace too large");

constexpr int SMEM_BYTES = 65536;

struct Params {
  const float *x_prompt, *x_sample, *cache_k, *cache_v, *state_wkv, *state_shift, *meta, *norm1_g, *w_in, *mu, *w0,
      *w2w, *a0, *w2a, *w2g, *k_k, *k_a, *r_k, *lnx_w, *lnx_b, *sinks, *w_out, *norm2_g, *w_query, *sub_keys, *eu,
      *ev, *final_g;
  float* out;
  char* ws;
  int full1, full8, full10, pad_;
};

__constant__ double INVF[8] = {1.0, 0.19392274474868576, 0.03760603093086393, 0.007292664737217109,
                               0.001414213562373095, 0.0002742481756762073, 5.318295896944988e-05,
                               1.031338537721246e-05};

__device__ __forceinline__ u16 f2bf(float f) {
  unsigned u = __float_as_uint(f);
  u += 0x7fffu + ((u >> 16) & 1u);
  return (u16)(u >> 16);
}
__device__ __forceinline__ float bf2f(u16 h) { return __uint_as_float(((unsigned)h) << 16); }
__device__ __forceinline__ float bflo(unsigned u) { return __uint_as_float(u << 16); }
__device__ __forceinline__ float bfhi(unsigned u) { return __uint_as_float(u & 0xffff0000u); }
__device__ __forceinline__ unsigned pack2bf(float a, float b) { return (unsigned)f2bf(a) | ((unsigned)f2bf(b) << 16); }
__device__ __forceinline__ u16 f2h(float f) {
  _Float16 h = (_Float16)f;
  return __builtin_bit_cast(u16, h);
}

template <int CTRL>
__device__ __forceinline__ float dppf(float x) {
  return __int_as_float(__builtin_amdgcn_update_dpp(0, __float_as_int(x), CTRL, 0xF, 0xF, false));
}
__device__ __forceinline__ float red4(float x) {
  x += dppf<0xB1>(x);
  x += dppf<0x4E>(x);
  return x;
}
__device__ __forceinline__ float red8(float x) {
  x = red4(x);
  x += dppf<0x141>(x);
  return x;
}
__device__ __forceinline__ float red16(float x) {
  x = red8(x);
  x += dppf<0x140>(x);
  return x;
}
__device__ __forceinline__ float redmax16(float x) {
  x = fmaxf(x, dppf<0xB1>(x));
  x = fmaxf(x, dppf<0x4E>(x));
  x = fmaxf(x, dppf<0x141>(x));
  x = fmaxf(x, dppf<0x140>(x));
  return x;
}
__device__ __forceinline__ float rdlane(float x, int l) {
  return __int_as_float(__builtin_amdgcn_readlane(__float_as_int(x), l));
}
__device__ __forceinline__ float wave_sum(float x) {
  x = red16(x);
  return rdlane(x, 0) + rdlane(x, 16) + rdlane(x, 32) + rdlane(x, 48);
}
__device__ __forceinline__ f32x4 mfma16(bf16x8 a, bf16x8 b, f32x4 c) {
  return __builtin_amdgcn_mfma_f32_16x16x32_bf16(a, b, c, 0, 0, 0);
}
__device__ __forceinline__ float sigmoidf_(float x) { return __builtin_amdgcn_rcpf(1.f + __expf(-x)); }

template <class Epi>
__device__ __forceinline__ void gemm_tile(const u16* __restrict__ A, int lda, const u16* __restrict__ Bt, int ldb, int K,
                                          char* smem, Epi epi) {
  const int tid = threadIdx.x, wid = tid >> 6, lane = tid & 63, wr = wid >> 1, wc = wid & 1, fr = lane & 15,
            fq = lane >> 4;
  f32x4 acc[4][4];
#pragma unroll
  for (int m = 0; m < 4; ++m)
#pragma unroll
    for (int n = 0; n < 4; ++n) acc[m][n] = f32x4{0.f, 0.f, 0.f, 0.f};
  const int nk = K / 64;
  auto stage = [&](int buf, int kt) {
    char* SA = smem + buf * 32768;
    char* SB = SA + 16384;
#pragma unroll
    for (int i = 0; i < 4; ++i) {
      int b = tid * 16 + i * 4096, r = b >> 7, pc = (b >> 4) & 7;
      int c = kt * 64 + ((pc ^ ((r >> 1) & 7)) << 3);
      __builtin_amdgcn_global_load_lds((const unsigned*)(A + (size_t)r * lda + c),
                                       (__attribute__((address_space(3))) unsigned*)(SA + b), 16, 0, 0);
      __builtin_amdgcn_global_load_lds((const unsigned*)(Bt + (size_t)r * ldb + c),
                                       (__attribute__((address_space(3))) unsigned*)(SB + b), 16, 0, 0);
    }
  };
  stage(0, 0);
  asm volatile("s_waitcnt vmcnt(0)" ::: "memory");
  __syncthreads();
  for (int kt = 0; kt < nk; ++kt) {
    const int cur = kt & 1;
    if (kt + 1 < nk) stage(cur ^ 1, kt + 1);
    const char* SA = smem + cur * 32768;
    const char* SB = SA + 16384;
#pragma unroll
    for (int ks = 0; ks < 2; ++ks) {
      bf16x8 At[4], Bl[4];
#pragma unroll
      for (int m = 0; m < 4; ++m) {
        int r = wr * 64 + m * 16 + fr;
        At[m] = *(const bf16x8*)(SA + r * 128 + (((ks * 4 + fq) ^ ((r >> 1) & 7)) << 4));
      }
#pragma unroll
      for (int n = 0; n < 4; ++n) {
        int r = wc * 64 + n * 16 + fr;
        Bl[n] = *(const bf16x8*)(SB + r * 128 + (((ks * 4 + fq) ^ ((r >> 1) & 7)) << 4));
      }
      __builtin_amdgcn_s_setprio(1);
#pragma unroll
      for (int m = 0; m < 4; ++m)
#pragma unroll
        for (int n = 0; n < 4; ++n) acc[m][n] = mfma16(Bl[n], At[m], acc[m][n]);
      __builtin_amdgcn_s_setprio(0);
    }
    asm volatile("s_waitcnt vmcnt(0)" ::: "memory");
    __syncthreads();
  }
#pragma unroll
  for (int m = 0; m < 4; ++m)
#pragma unroll
    for (int n = 0; n < 4; ++n) epi(m, wr * 64 + m * 16 + fr, wc * 64 + n * 16 + fq * 4, acc[m][n]);
}

template <class Epi>
__device__ __forceinline__ void gemm_qtile(const u16* __restrict__ A, int lda, const u16* __restrict__ Bt, int ldb, int K,
                                           char* smem, Epi epi) {
  const int tid = threadIdx.x, wid = tid >> 6, lane = tid & 63, fr = lane & 15, fq = lane >> 4;
  f32x4 acc[2][2];
#pragma unroll
  for (int m = 0; m < 2; ++m)
#pragma unroll
    for (int n = 0; n < 2; ++n) acc[m][n] = f32x4{0.f, 0.f, 0.f, 0.f};
  const int nk = K / 64;
  auto stage = [&](int buf, int kt) {
    char* SA = smem + buf * 32768;
    char* SB = SA + 16384;
    {
      int b = tid * 16, r = b >> 7, pc = (b >> 4) & 7;
      int c = kt * 64 + ((pc ^ ((r >> 1) & 7)) << 3);
      __builtin_amdgcn_global_load_lds((const unsigned*)(A + (size_t)r * lda + c),
                                       (__attribute__((address_space(3))) unsigned*)(SA + b), 16, 0, 0);
    }
#pragma unroll
    for (int i = 0; i < 4; ++i) {
      int b = tid * 16 + i * 4096, r = b >> 7, pc = (b >> 4) & 7;
      int c = kt * 64 + ((pc ^ ((r >> 1) & 7)) << 3);
      __builtin_amdgcn_global_load_lds((const unsigned*)(Bt + (size_t)r * ldb + c),
                                       (__attribute__((address_space(3))) unsigned*)(SB + b), 16, 0, 0);
    }
  };
  stage(0, 0);
  asm volatile("s_waitcnt vmcnt(0)" ::: "memory");
  __syncthreads();
  for (int kt = 0; kt < nk; ++kt) {
    const int cur = kt & 1;
    if (kt + 1 < nk) stage(cur ^ 1, kt + 1);
    const char* SA = smem + cur * 32768;
    const char* SB = SA + 16384;
#pragma unroll
    for (int ks = 0; ks < 2; ++ks) {
      bf16x8 At[2], Bl[2];
#pragma unroll
      for (int m = 0; m < 2; ++m) {
        int r = m * 16 + fr;
        At[m] = *(const bf16x8*)(SA + r * 128 + (((ks * 4 + fq) ^ ((r >> 1) & 7)) << 4));
      }
#pragma unroll
      for (int n = 0; n < 2; ++n) {
        int r = wid * 32 + n * 16 + fr;
        Bl[n] = *(const bf16x8*)(SB + r * 128 + (((ks * 4 + fq) ^ ((r >> 1) & 7)) << 4));
      }
#pragma unroll
      for (int m = 0; m < 2; ++m)
#pragma unroll
        for (int n = 0; n < 2; ++n) acc[m][n] = mfma16(Bl[n], At[m], acc[m][n]);
    }
    asm volatile("s_waitcnt vmcnt(0)" ::: "memory");
    __syncthreads();
  }
#pragma unroll
  for (int m = 0; m < 2; ++m)
#pragma unroll
    for (int n = 0; n < 2; ++n) epi(m, m * 16 + fr, wid * 32 + n * 16 + fq * 4, acc[m][n]);
}

__device__ __forceinline__ int xcd_vid() { return (blockIdx.x & 7) * (gridDim.x >> 3) + (blockIdx.x >> 3); }
__device__ __forceinline__ void grouped_tile(int t, int MT, int NT, int& mt, int& nt) {
  const int GM = 8;
  int per = GM * NT, gid = t / per, rem = t - gid * per;
  int first = gid * GM, gsz = min(MT - first, GM);
  mt = first + rem % gsz;
  nt = rem / gsz;
}

__device__ void transpose_task(const float* __restrict__ src, int K, int N, u16* __restrict__ dst, int tile, char* smem,
                               const float* __restrict__ kscale = nullptr) {
  const int tid = threadIdx.x;
  int tn = N / 64;
  int k0 = (tile / tn) * 64, n0 = (tile % tn) * 64;
  float* t = (float*)smem;
#pragma unroll 4
  for (int it = 0; it < 16; ++it) {
    int k = it * 4 + (tid >> 6), n = tid & 63;
    t[n * 65 + k] = src[(size_t)(k0 + k) * N + n0 + n] * (kscale ? kscale[k0 + k] : 1.f);
  }
  __syncthreads();
#pragma unroll 4
  for (int it = 0; it < 16; ++it) {
    int n = it * 4 + (tid >> 6), k = tid & 63;
    dst[(size_t)(n0 + n) * K + k0 + k] = f2bf(t[n * 65 + k]);
  }
  __syncthreads();
}

__device__ void norm1_task(const Params& p, int task) {
  const int wave = threadIdx.x >> 6, lane = threadIdx.x & 63;
  int row = task * 4 + wave;
  u16* h = (u16*)(p.ws + WS_B) + (size_t)row * D;
  const float* src = nullptr;
  bool donorm = true;
  float* shout = nullptr;
  if (row < TP) {
    int b = row / LP, t = row % LP;
    src = (t < 16) ? p.meta + (size_t)t * D : p.x_prompt + ((size_t)b * 4096 + (t - 16)) * D;
    if (t == LP - 1) shout = p.out + O_SHP + (size_t)b * D;
  } else if (row < TTOK) {
    int r = row - TP;
    src = p.x_sample + (size_t)r * D;
    if ((r & 3) == 3) shout = p.out + O_SHS + (size_t)(r >> 2) * D;
  } else if (row < TTOK + SB) {
    src = p.state_shift + (size_t)(row - TTOK) * D;
    donorm = false;
  }
  if (!src) {
#pragma unroll
    for (int i = 0; i < 4; ++i) *(uint2*)(h + (i * 64 + lane) * 4) = uint2{0u, 0u};
    return;
  }
  float4 v[4];
  float ss = 0.f;
#pragma unroll
  for (int i = 0; i < 4; ++i) {
    v[i] = ((const float4*)src)[i * 64 + lane];
    ss += v[i].x * v[i].x + v[i].y * v[i].y + v[i].z * v[i].z + v[i].w * v[i].w;
  }
  float sc = 1.f;
  if (donorm) {
    ss = wave_sum(ss);
    sc = rsqrtf(ss * (1.f / 1024.f) + 1e-5f);
  }
#pragma unroll
  for (int i = 0; i < 4; ++i) {
    float4 y = v[i];
    if (donorm) {
      float4 g = ((const float4*)p.norm1_g)[i * 64 + lane];
      y.x *= sc * g.x; y.y *= sc * g.y; y.z *= sc * g.z; y.w *= sc * g.w;
    }
    *(uint2*)(h + (i * 64 + lane) * 4) = uint2{pack2bf(y.x, y.y), pack2bf(y.z, y.w)};
    if (shout) ((float4*)shout)[i * 64 + lane] = y;
  }
}

__device__ void phase0(const Params& p, char* smem) {
  constexpr int N_NORM = MROWS / 4;
  constexpr int T_WIN = 16 * 40, T_WOUT = 16 * 16, T_WQ = 16 * 32, T_W2W = 8, T_W2A = 8, T_W2G = 16, T_SUBK = 32;
  constexpr int TOT = N_NORM + T_WIN + T_W2W + T_W2A + T_W2G + T_SUBK;
  for (int task = blockIdx.x; task < TOT; task += gridDim.x) {
    int t = task;
    if (t < N_NORM) { norm1_task(p, t); continue; }
    t -= N_NORM;
    if (t < T_WIN) { transpose_task(p.w_in, 1024, 2560, (u16*)(p.ws + WS_WIN), t, smem); continue; }
    t -= T_WIN;
    if (t < T_W2W) { transpose_task(p.w2w, 64, 512, (u16*)(p.ws + WS_W2W), t, smem); continue; }
    t -= T_W2W;
    if (t < T_W2A) { transpose_task(p.w2a, 64, 512, (u16*)(p.ws + WS_W2A), t, smem); continue; }
    t -= T_W2A;
    if (t < T_W2G) { transpose_task(p.w2g, 128, 512, (u16*)(p.ws + WS_W2G), t, smem); continue; }
    t -= T_W2G;
    {
      int e = (t * 256 + threadIdx.x) * 4;
      float4 v = *(const float4*)(p.sub_keys + e);
      *(uint2*)((u16*)(p.ws + WS_SUBK) + e) = uint2{pack2bf(v.x, v.y), pack2bf(v.z, v.w)};
    }
  }
}

__device__ void phase1(const Params& p, char* smem) {
  const u16* hbuf = (const u16*)(p.ws + WS_B);
  const u16* wt = (const u16*)(p.ws + WS_WIN);
  u16* proj = (u16*)(p.ws + WS_C);
  constexpr int NT = 20, MT = MROWS / 128, TOT = MT * NT;
  const int G = gridDim.x, full = p.full1, ntask = full + 4 * (TOT - full);
  for (int task = xcd_vid(); task < ntask; task += G) {
    int mt, nt;
    if (task < full) {
      grouped_tile(task, MT, NT, mt, nt);
      u16* crow = proj + (size_t)mt * 128 * NIN + nt * 128;
      gemm_tile(hbuf + (size_t)mt * 128 * D, D, wt + (size_t)nt * 128 * D, D, D, smem,
                [&](int m, int r, int c, f32x4 v) { *(uint2*)(crow + (size_t)r * NIN + c) = uint2{pack2bf(v[0], v[1]), pack2bf(v[2], v[3])}; });
    } else {
      int rem = task - full, qd = rem & 3;
      grouped_tile(full + (rem >> 2), MT, NT, mt, nt);
      size_t r0 = (size_t)mt * 128 + qd * 32;
      u16* crow = proj + r0 * NIN + nt * 128;
      gemm_qtile(hbuf + r0 * D, D, wt + (size_t)nt * 128 * D, D, D, smem,
                 [&](int m, int r, int c, f32x4 v) { *(uint2*)(crow + (size_t)r * NIN + c) = uint2{pack2bf(v[0], v[1]), pack2bf(v[2], v[3])}; });
    }
  }
}

__device__ void prepass_task(const Params& p, int task) {
  const int wave = threadIdx.x >> 6, lane = threadIdx.x & 63;
  int row = task * 4 + wave;
  if (row >= TTOK) return;
  u16* proj = (u16*)(p.ws + WS_C);
  u16* act = (u16*)(p.ws + WS_E);
  bool isP = row < TP;
  int b, t, prow;
  float pos;
  if (isP) { b = row / LP; t = row % LP; prow = t > 0 ? row - 1 : -1; pos = (float)t; }
  else { int r = row - TP; b = r >> 2; t = r & 3; prow = t > 0 ? row - 1 : PREV0 + b; pos = (float)(PAST + t); }
  u16* pr = proj + (size_t)row * NIN;
  const u16* pp = prow >= 0 ? proj + (size_t)prow * NIN : nullptr;
  {
    int c = 1536 + lane * 4;
    uint2 a = *(const uint2*)(pr + c);
    uint2 bq = pp ? *(const uint2*)(pp + c) : uint2{0u, 0u};
    float4 mu = *(const float4*)(p.mu + c);
    float x[4] = {bflo(a.x), bfhi(a.x), bflo(a.y), bfhi(a.y)};
    float xp[4] = {bflo(bq.x), bfhi(bq.x), bflo(bq.y), bfhi(bq.y)};
    float mm[4] = {mu.x, mu.y, mu.z, mu.w};
    float o[4];
#pragma unroll
    for (int i = 0; i < 4; ++i) {
      float m = x[i] + (xp[i] - x[i]) * mm[i];
      float r;
      if (lane < 16) r = tanhf(m);
      else if (lane < 32) r = m;
      else r = sigmoidf_(m);
      o[i] = r;
    }
    *(uint2*)(act + (size_t)row * 256 + lane * 4) = uint2{pack2bf(o[0], o[1]), pack2bf(o[2], o[3])};
  }
  float* kwin = nullptr;
  float* vwin = nullptr;
  if (isP) {
    if (t >= LP - 128) {
      kwin = p.out + O_KWP + ((size_t)b * 128 + (t - (LP - 128))) * 128;
      vwin = p.out + O_VWP + ((size_t)b * 128 + (t - (LP - 128))) * 128;
    }
  } else {
    kwin = p.out + O_KWS + ((size_t)b * 128 + 124 + t) * 128;
    vwin = p.out + O_VWS + ((size_t)b * 128 + 124 + t) * 128;
  }
  for (int it = lane; it < 80; it += 64) {
    int hh = it >> 3, d = it & 7;
    int col = 1792 + hh * 64 + d;
    float x1 = bf2f(pr[col]), x2 = bf2f(pr[col + 8]);
    double rev = (double)pos * INVF[d] * 0.15915494309189535;
    float fr = (float)(rev - floor(rev));
    float sn = __builtin_amdgcn_sinf(fr), cs = __builtin_amdgcn_cosf(fr);
    float r1 = x1 * cs - x2 * sn, r2 = x2 * cs + x1 * sn;
    pr[col] = f2bf(r1);
    pr[col + 8] = f2bf(r2);
    if (hh >= 8 && kwin) {
      kwin[(hh - 8) * 64 + d] = r1;
      kwin[(hh - 8) * 64 + d + 8] = r2;
    }
  }
  if (kwin) {
#pragma unroll
    for (int i = 0; i < 2; ++i) {
      int idx = lane * 2 + i;
      if ((idx & 63) >= 16) kwin[idx] = bf2f(pr[2304 + idx]);
      vwin[idx] = bf2f(pr[2432 + idx]);
    }
  }
}

__device__ void phase2(const Params& p) {
  constexpr int N_PRE = TTOK / 4;
  constexpr int N_CP = 256;
  for (int task = blockIdx.x; task < N_PRE + N_CP; task += gridDim.x) {
    if (task < N_PRE) { prepass_task(p, task); continue; }
    int t = task - N_PRE;
    int which = t >> 7, b = t & 127;
    const float4* src = (const float4*)((which ? p.cache_v : p.cache_k) + (size_t)b * 16384 + 512);
    float4* dst = (float4*)(p.out + (which ? O_VWS : O_KWS) + (size_t)b * 16384);
    for (int i = threadIdx.x; i < 3968; i += 256) dst[i] = src[i];
  }
}

__device__ void phase3(const Params& p, char* smem) {
  const u16* act = (const u16*)(p.ws + WS_E);
  float* dec = (float*)(p.ws + WS_DEC);
  u16* ab = (u16*)(p.ws + WS_A);
  u16* gb = (u16*)(p.ws + WS_G);
  constexpr int MT = TPAD / 128;
  for (int tile = blockIdx.x; tile < MT * 12; tile += gridDim.x) {
    int which = tile % 3, rest = tile / 3;
    int nt = rest & 3, mt = rest >> 2;
    size_t r0 = (size_t)mt * 128;
    int c0 = nt * 128;
    if (which == 0) {
      gemm_tile(act + r0 * 256, 256, (const u16*)(p.ws + WS_W2W) + (size_t)c0 * 64, 64, 64, smem,
                [&](int m, int r, int c, f32x4 v) {
                  float4 w0v = *(const float4*)(p.w0 + c0 + c);
                  float w0a[4] = {w0v.x, w0v.y, w0v.z, w0v.w};
                  float o[4];
#pragma unroll
                  for (int e = 0; e < 4; ++e) {
                    float nx = -(w0a[e] + v[e]);
                    float sp = fmaxf(nx, 0.f) + __logf(1.f + __expf(-fabsf(nx)));
                    o[e] = __expf(-__expf(-sp - 0.5f));
                  }
                  *(float4*)(dec + (r0 + r) * 512 + c0 + c) = float4{o[0], o[1], o[2], o[3]};
                });
    } else if (which == 1) {
      gemm_tile(act + r0 * 256 + 64, 256, (const u16*)(p.ws + WS_W2A) + (size_t)c0 * 64, 64, 64, smem,
                [&](int m, int r, int c, f32x4 v) {
                  float4 a0v = *(const float4*)(p.a0 + c0 + c);
                  *(uint2*)(ab + (r0 + r) * 512 + c0 + c) = uint2{pack2bf(sigmoidf_(a0v.x + v[0]), sigmoidf_(a0v.y + v[1])), pack2bf(sigmoidf_(a0v.z + v[2]), sigmoidf_(a0v.w + v[3]))};
                });
    } else {
      gemm_tile(act + r0 * 256 + 128, 256, (const u16*)(p.ws + WS_W2G) + (size_t)c0 * 128, 128, 128, smem,
                [&](int m, int r, int c, f32x4 v) { *(uint2*)(gb + (r0 + r) * 512 + c0 + c) = uint2{pack2bf(v[0], v[1]), pack2bf(v[2], v[3])}; });
    }
  }
}

__device__ void convert_task(const Params& p, int task) {
  const int wave = threadIdx.x >> 6, lane = threadIdx.x & 63;
  int r = task * 4 + wave;
  const float* src = (r < 16384 ? p.eu + (size_t)r * 1024 : p.ev + (size_t)(r - 16384) * 1024) + lane * 16;
  float4 x[4];
  float am = 0.f;
#pragma unroll
  for (int i = 0; i < 4; ++i) {
    x[i] = ((const float4*)src)[i];
    am = fmaxf(am, fmaxf(fmaxf(fabsf(x[i].x), fabsf(x[i].y)), fmaxf(fabsf(x[i].z), fabsf(x[i].w))));
  }
  am = redmax16(am);
  am = fmaxf(fmaxf(rdlane(am, 0), rdlane(am, 16)), fmaxf(rdlane(am, 32), rdlane(am, 48)));
  float scale = am > 0.f ? 7.f / am : 1.f;
  float inv = am > 0.f ? am * (1.f / 7.f) : 1.f;
  float y[16];
#pragma unroll
  for (int i = 0; i < 4; ++i) {
    y[4 * i] = fminf(fmaxf(x[i].x * scale, -6.f), 6.f); y[4 * i + 1] = fminf(fmaxf(x[i].y * scale, -6.f), 6.f);
    y[4 * i + 2] = fminf(fmaxf(x[i].z * scale, -6.f), 6.f); y[4 * i + 3] = fminf(fmaxf(x[i].w * scale, -6.f), 6.f);
  }
  unsigned w0 = 0u, w1 = 0u;
  w0 = __builtin_amdgcn_cvt_scalef32_pk_fp4_f32(w0, y[0], y[1], 1.0f, 0);
  w0 = __builtin_amdgcn_cvt_scalef32_pk_fp4_f32(w0, y[2], y[3], 1.0f, 1);
  w0 = __builtin_amdgcn_cvt_scalef32_pk_fp4_f32(w0, y[4], y[5], 1.0f, 2);
  w0 = __builtin_amdgcn_cvt_scalef32_pk_fp4_f32(w0, y[6], y[7], 1.0f, 3);
  w1 = __builtin_amdgcn_cvt_scalef32_pk_fp4_f32(w1, y[8], y[9], 1.0f, 0);
  w1 = __builtin_amdgcn_cvt_scalef32_pk_fp4_f32(w1, y[10], y[11], 1.0f, 1);
  w1 = __builtin_amdgcn_cvt_scalef32_pk_fp4_f32(w1, y[12], y[13], 1.0f, 2);
  w1 = __builtin_amdgcn_cvt_scalef32_pk_fp4_f32(w1, y[14], y[15], 1.0f, 3);
  *(uint2*)((unsigned char*)(p.ws + WS_EU) + (size_t)r * 512 + lane * 8) = uint2{w0, w1};
  if (lane == 0) ((float*)(p.ws + WS_SCU))[r] = inv;
}

struct ScanRaw {
  uint2 rr, rk, rv, qr, qk, qv, av;
  float4 dc;
};
constexpr int SC_TOK = 332;

__device__ void scan_task(const Params& p, char* smem, int rowbase, int T, int prevrow, int h, int rg,
                          const float* __restrict__ s_in, float* __restrict__ s_out) {
  const int tid = threadIdx.x, wave = tid >> 6, lane = tid & 63, l16 = lane & 15;
  const bool scanner = wave < 2;
  const u16* proj = (const u16*)(p.ws + WS_C);
  const float* dec = (const float*)(p.ws + WS_DEC);
  const u16* ab = (const u16*)(p.ws + WS_A);
  float* yraw = p.out;
  float* bufs = (float*)smem;
  float* yparts = (float*)(smem + 42496);
  float* vkrs = (float*)(smem + 42496 + 16384);
  const int nchunk = (T + 15) >> 4;
  const int il = (wave & 1) * 4 + (lane >> 4), i = rg * 8 + il, j0 = l16 * 4;
  float2v S01 = {0.f, 0.f}, S23 = {0.f, 0.f};
  if (s_in && scanner) {
    float4 s = *(const float4*)(s_in + i * 64 + j0);
    S01 = float2v{s.x, s.y}; S23 = float2v{s.z, s.w};
  }
  const int ptid = tid & 127, cgp = ptid & 15, ttb = ptid >> 4, col = h * 64 + cgp * 4;
  const float4 mu_r = *(const float4*)(p.mu + col), mu_k = *(const float4*)(p.mu + 512 + col),
               mu_v = *(const float4*)(p.mu + 1024 + col);
  const float4 kkw = *(const float4*)(p.k_k + col), kaw = *(const float4*)(p.k_a + col);
  const u16* projc = proj + (size_t)rowbase * NIN + col;
  const float* decc = dec + (size_t)rowbase * 512 + col;
  const u16* abc = ab + (size_t)rowbase * 512 + col;
  const u16* prevp = prevrow >= 0 ? proj + (size_t)prevrow * NIN + col : nullptr;
  auto issue = [&](int c, int tt, ScanRaw& R) {
    int t = c * 16 + tt;
    if (t < T) {
      const size_t ro = (size_t)c * 16 + tt;
      const u16* pr = projc + ro * NIN;
      R.rr = *(const uint2*)(pr);
      R.rk = *(const uint2*)(pr + 512);
      R.rv = *(const uint2*)(pr + 1024);
      const u16* pq = t > 0 ? pr - NIN : prevp;
      if (pq) {
        R.qr = *(const uint2*)(pq);
        R.qk = *(const uint2*)(pq + 512);
        R.qv = *(const uint2*)(pq + 1024);
      } else {
        R.qr = uint2{0, 0}; R.qk = uint2{0, 0}; R.qv = uint2{0, 0};
      }
      R.dc = *(const float4*)(decc + ro * 512);
      R.av = *(const uint2*)(abc + ro * 512);
    }
  };
  auto prep_item = [&](const ScanRaw& R, int tt, float* buf, float* vkr) {
    float xr[4] = {bflo(R.rr.x), bfhi(R.rr.x), bflo(R.rr.y), bfhi(R.rr.y)};
    float xk[4] = {bflo(R.rk.x), bfhi(R.rk.x), bflo(R.rk.y), bfhi(R.rk.y)};
    float xv[4] = {bflo(R.rv.x), bfhi(R.rv.x), bflo(R.rv.y), bfhi(R.rv.y)};
    float pr_[4] = {bflo(R.qr.x), bfhi(R.qr.x), bflo(R.qr.y), bfhi(R.qr.y)};
    float pk_[4] = {bflo(R.qk.x), bfhi(R.qk.x), bflo(R.qk.y), bfhi(R.qk.y)};
    float pv_[4] = {bflo(R.qv.x), bfhi(R.qv.x), bflo(R.qv.y), bfhi(R.qv.y)};
    float aa[4] = {bflo(R.av.x), bfhi(R.av.x), bflo(R.av.y), bfhi(R.av.y)};
    float dcv[4] = {R.dc.x, R.dc.y, R.dc.z, R.dc.w};
    float mur[4] = {mu_r.x, mu_r.y, mu_r.z, mu_r.w}, muk[4] = {mu_k.x, mu_k.y, mu_k.z, mu_k.w},
          muv[4] = {mu_v.x, mu_v.y, mu_v.z, mu_v.w};
    float kw[4] = {kkw.x, kkw.y, kkw.z, kkw.w}, ka[4] = {kaw.x, kaw.y, kaw.z, kaw.w};
    float kkv[4], ss = 0.f;
#pragma unroll
    for (int e = 0; e < 4; ++e) {
      xr[e] = xr[e] + (pr_[e] - xr[e]) * mur[e];
      xk[e] = xk[e] + (pk_[e] - xk[e]) * muk[e];
      xv[e] = xv[e] + (pv_[e] - xv[e]) * muv[e];
      kkv[e] = xk[e] * kw[e];
      ss += kkv[e] * kkv[e];
    }
    ss = red16(ss);
    float inv = __builtin_amdgcn_rsqf(fmaxf(ss, 1e-24f));
    float nk[4], kb[4], km[4];
    float brs = 0.f, krs = 0.f;
#pragma unroll
    for (int e = 0; e < 4; ++e) {
      float kk = kkv[e] * inv;
      nk[e] = -kk;
      kb[e] = kk * aa[e];
      km[e] = xk[e] * (1.f + (aa[e] - 1.f) * ka[e]);
      brs += kb[e] * xr[e];
      krs += km[e] * xr[e];
    }
    brs = red16(brs);
    krs = red16(krs);
    float* bt = buf + tt * SC_TOK + cgp * 4;
    *(float4*)(bt) = float4{xr[0] * dcv[0] + brs * nk[0], xr[1] * dcv[1] + brs * nk[1], xr[2] * dcv[2] + brs * nk[2],
                            xr[3] * dcv[3] + brs * nk[3]};
    *(float4*)(bt + 64) = R.dc;
    *(float4*)(bt + 128) = float4{km[0], km[1], km[2], km[3]};
    *(float4*)(bt + 192) = float4{nk[0], nk[1], nk[2], nk[3]};
    *(float4*)(bt + 256) = float4{kb[0], kb[1], kb[2], kb[3]};
    if ((cgp >> 1) == rg) {
      *(float4*)(buf + tt * SC_TOK + 320 + (cgp & 1) * 4) = float4{xv[0], xv[1], xv[2], xv[3]};
      *(float4*)(vkr + tt * 8 + (cgp & 1) * 4) = float4{xv[0] * krs, xv[1] * krs, xv[2] * krs, xv[3] * krs};
    }
  };
  auto yreduce = [&](int c) {
    const int tt = ptid >> 3, row = ptid & 7;
    const float4* yp = (const float4*)(yparts + (c & 1) * 2048 + ptid * 16);
    float4 a = yp[0], b = yp[1], c4 = yp[2], d = yp[3];
    float y = ((a.x + a.y) + (a.z + a.w)) + ((b.x + b.y) + (b.z + b.w)) + ((c4.x + c4.y) + (c4.z + c4.w)) +
              ((d.x + d.y) + (d.z + d.w)) + vkrs[(c % 3) * 128 + ptid];
    int t = c * 16 + tt;
    if (t < T) yraw[(size_t)(rowbase + t) * 512 + h * 64 + rg * 8 + row] = y;
  };
  ScanRaw R0, R1;
  R0.rr = R0.rk = R0.rv = R0.qr = R0.qk = R0.qv = R0.av = uint2{0, 0}; R0.dc = float4{0, 0, 0, 0};
  R1 = R0;
  if (!scanner) {
    issue(0, ttb, R0);
    issue(0, ttb + 8, R1);
    prep_item(R0, ttb, bufs, vkrs);
    prep_item(R1, ttb + 8, bufs, vkrs);
    if (nchunk > 1) { issue(1, ttb, R0); issue(1, ttb + 8, R1); }
  }
  __syncthreads();
  for (int c = 0; c < nchunk; ++c) {
    if (scanner) {
      const float* buf = bufs + (c & 1) * (16 * SC_TOK);
      float* ypart = yparts + (c & 1) * 2048;
      const int ntok = min(16, T - c * 16);
      const float* bt0 = buf + j0;
      float4 r4 = *(const float4*)(bt0), w4 = *(const float4*)(bt0 + 64), k4 = *(const float4*)(bt0 + 128),
             a4 = *(const float4*)(bt0 + 192), b4 = *(const float4*)(bt0 + 256);
      float vi = buf[320 + il];
      for (int t2 = 0; t2 < ntok; ++t2) {
        int tn = min(t2 + 1, ntok - 1);
        const float* bn = buf + tn * SC_TOK + j0;
        float4 rn = *(const float4*)(bn), wn = *(const float4*)(bn + 64), kn = *(const float4*)(bn + 128),
               an = *(const float4*)(bn + 192), bnn = *(const float4*)(bn + 256);
        float vn = buf[tn * SC_TOK + 320 + il];
        float2v sa2 = S01 * float2v{a4.x, a4.y} + S23 * float2v{a4.z, a4.w};
        float2v q2 = S01 * float2v{r4.x, r4.y} + S23 * float2v{r4.z, r4.w};
        float2v vv = float2v{vi, vi};
        float2v t01 = S01 * float2v{w4.x, w4.y} + vv * float2v{k4.x, k4.y};
        float2v t23 = S23 * float2v{w4.z, w4.w} + vv * float2v{k4.z, k4.w};
        float sa = red16(sa2.x + sa2.y);
        float2v sv = float2v{sa, sa};
        S01 = t01 + sv * float2v{b4.x, b4.y};
        S23 = t23 + sv * float2v{b4.z, b4.w};
        ypart[t2 * 128 + (tid & 127)] = q2.x + q2.y;
        r4 = rn; w4 = wn; k4 = kn; a4 = an; b4 = bnn; vi = vn;
      }
    } else {
      if (c > 0) yreduce(c - 1);
      if (c + 1 < nchunk) {
        float* nb = bufs + ((c + 1) & 1) * (16 * SC_TOK);
        float* nv = vkrs + ((c + 1) % 3) * 128;
        prep_item(R0, ttb, nb, nv);
        prep_item(R1, ttb + 8, nb, nv);
        if (c + 2 < nchunk) { issue(c + 2, ttb, R0); issue(c + 2, ttb + 8, R1); }
      }
    }
    __syncthreads();
  }
  if (scanner) *(float4*)(s_out + i * 64 + j0) = float4{S01.x, S01.y, S23.x, S23.y};
  else yreduce(nchunk - 1);
  __syncthreads();
}

__device__ void attn_prompt_task(const Params& p, char* smem, int task) {
  const int tid = threadIdx.x, w = tid >> 6, lane = tid & 63, fr = lane & 15, fq = lane >> 4;
  int head = task & 7;
  int qt = (task >> 3) % 65;
  int b = task / (8 * 65);
  int kvh = head >> 2;
  u16* KV = (u16*)smem;
  u16* Ps = (u16*)(smem + 9216) + w * 16 * 200;
  const u16* projb = (const u16*)(p.ws + WS_C) + (size_t)b * LP * NIN;
  u16* mix = (u16*)(p.ws + WS_B);
  int q0 = qt * 64, kstart = q0 - 128;
  int qrow = min(q0 + w * 16 + fr, LP - 1);
  bf16x8 qa[2];
#pragma unroll
  for (int ks = 0; ks < 2; ++ks)
    qa[ks] = *(const bf16x8*)(projb + (size_t)qrow * NIN + 1792 + head * 64 + ks * 32 + fq * 8);
  f32x4 S[12];
#pragma unroll
  for (int i = 0; i < 12; ++i) S[i] = f32x4{0.f, 0.f, 0.f, 0.f};
#pragma unroll
  for (int kt = 0; kt < 3; ++kt) {
    {
      int key = tid >> 2, ch = tid & 3;
      int kp = min(max(kstart + kt * 64 + key, 0), LP - 1);
      const uint4* src = (const uint4*)(projb + (size_t)kp * NIN + 2304 + kvh * 64 + ch * 16);
      uint4 v0 = src[0], v1 = src[1];
      *(uint4*)(KV + key * 72 + ch * 16) = v0;
      *(uint4*)(KV + key * 72 + ch * 16 + 8) = v1;
    }
    __syncthreads();
#pragma unroll
    for (int n = 0; n < 4; ++n)
#pragma unroll
      for (int ks = 0; ks < 2; ++ks) {
        bf16x8 kb = *(const bf16x8*)(KV + (n * 16 + fr) * 72 + ks * 32 + fq * 8);
        S[kt * 4 + n] = mfma16(qa[ks], kb, S[kt * 4 + n]);
      }
    __syncthreads();
  }
  float sink = p.sinks[head];
#pragma unroll
  for (int j = 0; j < 4; ++j) {
    int qpos = q0 + w * 16 + fq * 4 + j;
    float mx = -1e30f;
#pragma unroll
    for (int T = 0; T < 12; ++T) {
      int kpos = kstart + T * 16 + fr;
      bool valid = (kpos >= 0) && (kpos <= qpos) && (qpos - kpos < 128);
      float s = valid ? S[T][j] * 0.125f : -1e30f;
      S[T][j] = s;
      mx = fmaxf(mx, s);
    }
    mx = redmax16(mx);
    mx = fmaxf(mx, sink);
    float sum = 0.f;
#pragma unroll
    for (int T = 0; T < 12; ++T) {
      float e = (S[T][j] > -1e29f) ? __expf(S[T][j] - mx) : 0.f;
      S[T][j] = e;
      sum += e;
    }
    sum = red16(sum) + __expf(sink - mx);
    float inv = 1.f / sum;
#pragma unroll
    for (int T = 0; T < 12; ++T) Ps[(fq * 4 + j) * 200 + T * 16 + fr] = f2bf(S[T][j] * inv);
  }
  f32x4 O[4];
#pragma unroll
  for (int i = 0; i < 4; ++i) O[i] = f32x4{0.f, 0.f, 0.f, 0.f};
#pragma unroll
  for (int kt = 0; kt < 3; ++kt) {
    {
      int key = tid >> 2, ch = tid & 3;
      int kp = min(max(kstart + kt * 64 + key, 0), LP - 1);
      const uint4* src = (const uint4*)(projb + (size_t)kp * NIN + 2432 + kvh * 64 + ch * 16);
      uint4 v0 = src[0], v1 = src[1];
      unsigned e[8] = {v0.x, v0.y, v0.z, v0.w, v1.x, v1.y, v1.z, v1.w};
#pragma unroll
      for (int i = 0; i < 8; ++i) {
        KV[(ch * 16 + 2 * i) * 72 + key] = (u16)(e[i] & 0xffffu);
        KV[(ch * 16 + 2 * i + 1) * 72 + key] = (u16)(e[i] >> 16);
      }
    }
    __syncthreads();
#pragma unroll
    for (int ks = 0; ks < 2; ++ks) {
      bf16x8 pa = *(const bf16x8*)(Ps + fr * 200 + kt * 64 + ks * 32 + fq * 8);
#pragma unroll
      for (int n = 0; n < 4; ++n) {
        bf16x8 vb = *(const bf16x8*)(KV + (n * 16 + fr) * 72 + ks * 32 + fq * 8);
        O[n] = mfma16(pa, vb, O[n]);
      }
    }
    __syncthreads();
  }
#pragma unroll
  for (int n = 0; n < 4; ++n)
#pragma unroll
    for (int j = 0; j < 4; ++j) {
      int q = q0 + w * 16 + fq * 4 + j;
      if (q < LP) mix[((size_t)(b * LP + q)) * 1024 + 512 + head * 64 + n * 16 + fr] = f2bf(O[n][j]);
    }
}

__device__ void attn_sample_task(const Params& p, char* smem, int task) {
  const int tid = threadIdx.x;
  int b = task >> 1, kvh = task & 1;
  const u16* proj = (const u16*)(p.ws + WS_C);
  u16* mix = (u16*)(p.ws + WS_B);
  float* Qs = (float*)smem;
  float* Sc = Qs + 1024;
  {
    int qr = tid >> 4, d4 = (tid & 15) * 4, g = qr >> 2, s = qr & 3;
    const u16* src = proj + (size_t)(TP + b * 4 + s) * NIN + 1792 + (kvh * 4 + g) * 64 + d4;
    uint2 v = *(const uint2*)src;
    *(float4*)(Qs + qr * 64 + d4) = float4{bflo(v.x) * 0.125f, bfhi(v.x) * 0.125f, bflo(v.y) * 0.125f, bfhi(v.y) * 0.125f};
  }
  __syncthreads();
  for (int idx = tid; idx < 132 * 16; idx += 256) {
    int kj = idx >> 4, qr = idx & 15, s = qr & 3;
    bool valid = (kj < 128) ? (kj > s) : (kj - 128 <= s);
    float acc = 0.f;
    const float* q = Qs + qr * 64;
    if (kj < 128) {
      const float4* kr = (const float4*)(p.cache_k + (((size_t)b * 128 + kj) * 2 + kvh) * 64);
#pragma unroll
      for (int d = 0; d < 16; ++d) {
        float4 kv = kr[d];
        acc += kv.x * q[d * 4] + kv.y * q[d * 4 + 1] + kv.z * q[d * 4 + 2] + kv.w * q[d * 4 + 3];
      }
    } else {
      const uint2* kr = (const uint2*)(proj + (size_t)(TP + b * 4 + kj - 128) * NIN + 2304 + kvh * 64);
#pragma unroll
      for (int d = 0; d < 16; ++d) {
        uint2 kv = kr[d];
        acc += bflo(kv.x) * q[d * 4] + bfhi(kv.x) * q[d * 4 + 1] + bflo(kv.y) * q[d * 4 + 2] + bfhi(kv.y) * q[d * 4 + 3];
      }
    }
    Sc[qr * 136 + kj] = valid ? acc : -1e30f;
  }
  __syncthreads();
  {
    int qr = tid >> 4, l = tid & 15, g = qr >> 2;
    float sink = p.sinks[kvh * 4 + g];
    float mx = -1e30f;
    for (int kj = l; kj < 132; kj += 16) mx = fmaxf(mx, Sc[qr * 136 + kj]);
    mx = redmax16(mx);
    mx = fmaxf(mx, sink);
    float sum = 0.f;
    for (int kj = l; kj < 132; kj += 16) {
      float s = Sc[qr * 136 + kj];
      float e = (s > -1e29f) ? __expf(s - mx) : 0.f;
      Sc[qr * 136 + kj] = e;
      sum += e;
    }
    sum = red16(sum) + __expf(sink - mx);
    float inv = 1.f / sum;
    for (int kj = l; kj < 132; kj += 16) Sc[qr * 136 + kj] *= inv;
  }
  __syncthreads();
  {
    int qr = tid >> 4, d4 = (tid & 15) * 4, g = qr >> 2, s = qr & 3;
    float4 o = {0.f, 0.f, 0.f, 0.f};
    for (int kj = 0; kj < 128; ++kj) {
      float pw = Sc[qr * 136 + kj];
      float4 v = *(const float4*)(p.cache_v + (((size_t)b * 128 + kj) * 2 + kvh) * 64 + d4);
      o.x += pw * v.x; o.y += pw * v.y; o.z += pw * v.z; o.w += pw * v.w;
    }
    for (int kj = 128; kj < 132; ++kj) {
      float pw = Sc[qr * 136 + kj];
      uint2 v = *(const uint2*)(proj + (size_t)(TP + b * 4 + kj - 128) * NIN + 2432 + kvh * 64 + d4);
      o.x += pw * bflo(v.x); o.y += pw * bfhi(v.x); o.z += pw * bflo(v.y); o.w += pw * bfhi(v.y);
    }
    *(uint2*)(mix + (size_t)(TP + b * 4 + s) * 1024 + 512 + (kvh * 4 + g) * 64 + d4) =
        uint2{pack2bf(o.x, o.y), pack2bf(o.z, o.w)};
  }
  __syncthreads();
}

__device__ void phase4(const Params& p, char* smem) {
  constexpr int N_PS = 256, N_SS = 8192, N_AP = NB * 65 * 8, N_AS = 256;
  constexpr int N_CV = 32768 / 4, T_WOUT = 16 * 16, T_WQ = 16 * 32;
  int first, stride;
  if (gridDim.x >= 2 * N_PS) {
    if ((int)blockIdx.x < N_PS) {
      int t = blockIdx.x;
      int seq = t >> 3, rg = t & 7, b = seq >> 3, h = seq & 7;
      scan_task(p, smem, b * LP, LP, -1, h, rg, nullptr, p.out + O_WKVP + (size_t)seq * 4096);
      return;
    }
    first = N_PS + (blockIdx.x - N_PS);
    stride = gridDim.x - N_PS;
  } else {
    first = blockIdx.x;
    stride = gridDim.x;
  }
  for (int task = first; task < N_PS + N_SS + N_AP + N_AS + N_CV + T_WOUT + T_WQ; task += stride) {
    int t = task;
    if (t < N_PS) {
      int seq = t >> 3, rg = t & 7, b = seq >> 3, h = seq & 7;
      scan_task(p, smem, b * LP, LP, -1, h, rg, nullptr, p.out + O_WKVP + (size_t)seq * 4096);
      continue;
    }
    t -= N_PS;
    if (t < N_SS) {
      int seq = t >> 3, rg = t & 7, b = seq >> 3, h = seq & 7;
      scan_task(p, smem, TP + b * 4, 4, PREV0 + b, h, rg, p.state_wkv + (size_t)seq * 4096,
                p.out + O_WKVS + (size_t)seq * 4096);
      continue;
    }
    t -= N_SS;
    if (t < N_AP) { attn_prompt_task(p, smem, t); continue; }
    t -= N_AP;
    if (t < N_AS) { attn_sample_task(p, smem, t); continue; }
    t -= N_AS;
    if (t < N_CV) { convert_task(p, t); continue; }
    t -= N_CV;
    if (t < T_WOUT) { transpose_task(p.w_out, 1024, 1024, (u16*)(p.ws + WS_WOUT), t, smem); continue; }
    t -= T_WOUT;
    transpose_task(p.w_query, 1024, 2048, (u16*)(p.ws + WS_WQ), t, smem, p.norm2_g);
  }
}

struct PostC { float mu[3][8], ka[8], rk[8], lw[8], lb[8]; };

__device__ __forceinline__ void post_task(const Params& p, int task, const PostC& C) {
  const int wave = threadIdx.x >> 6, lane = threadIdx.x & 63;
  int row = task * 4 + wave;
  if (row >= TTOK) return;
  const u16* proj = (const u16*)(p.ws + WS_C);
  const float* yraw = p.out;
  const u16* ab = (const u16*)(p.ws + WS_A);
  const u16* gb = (const u16*)(p.ws + WS_G);
  u16* mix = (u16*)(p.ws + WS_B);
  int prow;
  if (row < TP) { int t = row % LP; prow = t > 0 ? row - 1 : -1; }
  else { int r = row - TP; prow = (r & 3) ? row - 1 : PREV0 + (r >> 2); }
  int c0 = lane * 8;
  float y[8];
  {
    float4 a = *(const float4*)(yraw + (size_t)row * 512 + c0), bq = *(const float4*)(yraw + (size_t)row * 512 + c0 + 4);
    y[0] = a.x; y[1] = a.y; y[2] = a.z; y[3] = a.w; y[4] = bq.x; y[5] = bq.y; y[6] = bq.z; y[7] = bq.w;
  }
  float s = 0.f;
#pragma unroll
  for (int e = 0; e < 8; ++e) s += y[e];
  float mean = red8(s) * (1.f / 64.f);
  float vs = 0.f;
#pragma unroll
  for (int e = 0; e < 8; ++e) { float d = y[e] - mean; vs += d * d; }
  float rstd = rsqrtf(red8(vs) * (1.f / 64.f) + 64e-5f);
  float xr[8], xk[8], xv[8];
  auto ld8 = [&](int coff, int mi, float* o) {
    uint4 a = *(const uint4*)(proj + (size_t)row * NIN + coff + c0);
    uint4 q = prow >= 0 ? *(const uint4*)(proj + (size_t)prow * NIN + coff + c0) : uint4{0, 0, 0, 0};
    unsigned ua[4] = {a.x, a.y, a.z, a.w}, uq[4] = {q.x, q.y, q.z, q.w};
#pragma unroll
    for (int e = 0; e < 4; ++e) {
      float x0 = bflo(ua[e]), x1 = bfhi(ua[e]), p0 = bflo(uq[e]), p1 = bfhi(uq[e]);
      float m0 = C.mu[mi][2 * e], m1 = C.mu[mi][2 * e + 1];
      o[2 * e] = x0 + (p0 - x0) * m0;
      o[2 * e + 1] = x1 + (p1 - x1) * m1;
    }
  };
  ld8(0, 0, xr);
  ld8(512, 1, xk);
  ld8(1024, 2, xv);
  float aa[8], gg[8];
  {
    uint4 a = *(const uint4*)(ab + (size_t)row * 512 + c0), g = *(const uint4*)(gb + (size_t)row * 512 + c0);
    unsigned ua[4] = {a.x, a.y, a.z, a.w}, ug[4] = {g.x, g.y, g.z, g.w};
#pragma unroll
    for (int e = 0; e < 4; ++e) {
      aa[2 * e] = bflo(ua[e]); aa[2 * e + 1] = bfhi(ua[e]);
      gg[2 * e] = bflo(ug[e]); gg[2 * e + 1] = bfhi(ug[e]);
    }
  }
  float bs = 0.f;
#pragma unroll
  for (int e = 0; e < 8; ++e) {
    float km = xk[e] * (1.f + (aa[e] - 1.f) * C.ka[e]);
    bs += xr[e] * km * C.rk[e];
  }
  bs = red8(bs);
  unsigned o[4];
#pragma unroll
  for (int e = 0; e < 4; ++e) {
    float v0 = ((y[2 * e] - mean) * rstd * C.lw[2 * e] + C.lb[2 * e] + bs * xv[2 * e]) * gg[2 * e];
    float v1 = ((y[2 * e + 1] - mean) * rstd * C.lw[2 * e + 1] + C.lb[2 * e + 1] + bs * xv[2 * e + 1]) * gg[2 * e + 1];
    o[e] = pack2bf(v0, v1);
  }
  *(uint4*)(mix + (size_t)row * 1024 + c0) = uint4{o[0], o[1], o[2], o[3]};
}

__device__ void phase5(const Params& p) {
  const int lane = threadIdx.x & 63, c0 = lane * 8;
  PostC C;
  auto ld = [&](const float* src, float* dst) {
    float4 a = *(const float4*)(src + c0), b = *(const float4*)(src + c0 + 4);
    dst[0] = a.x; dst[1] = a.y; dst[2] = a.z; dst[3] = a.w; dst[4] = b.x; dst[5] = b.y; dst[6] = b.z; dst[7] = b.w;
  };
  ld(p.mu, C.mu[0]); ld(p.mu + 512, C.mu[1]); ld(p.mu + 1024, C.mu[2]);
  ld(p.k_a, C.ka); ld(p.r_k, C.rk); ld(p.lnx_w, C.lw); ld(p.lnx_b, C.lb);
  for (int task = blockIdx.x; task < TTOK / 4; task += gridDim.x) post_task(p, task, C);
}

__device__ void phase6(const Params& p, char* smem) {
  const u16* mix = (const u16*)(p.ws + WS_B);
  const u16* wt = (const u16*)(p.ws + WS_WOUT);
  constexpr int MT = NOUT / 128, NT = 8;
  constexpr int N_CV = 0;
  const int wave = threadIdx.x >> 6, lane = threadIdx.x & 63;
  for (int task = xcd_vid(); task < MT * NT + N_CV; task += gridDim.x) {
    if (task < MT * NT) {
      int mt, nt;
      grouped_tile(task, MT, NT, mt, nt);
      int o0 = mt * 128;
      int arow = o0 + (o0 < 16384 ? 16 * (o0 / 4096 + 1) : 64);
      const float* xin = (o0 < 16384 ? p.x_prompt + (size_t)o0 * D : p.x_sample + (size_t)(o0 - 16384) * D) + nt * 128;
      float* xo = p.out + (size_t)o0 * D + nt * 128;
      u16* xb = (u16*)(p.ws + WS_X1B) + (size_t)o0 * D + nt * 128;
      float rs[4] = {0.f, 0.f, 0.f, 0.f};
      gemm_tile(mix + (size_t)arow * 1024, 1024, wt + (size_t)nt * 128 * 1024, 1024, 1024, smem,
                [&](int m, int r, int c, f32x4 v) {
                  float4 xi = *(const float4*)(xin + (size_t)r * D + c);
                  float4 xv = float4{xi.x + v[0], xi.y + v[1], xi.z + v[2], xi.w + v[3]};
                  *(float4*)(xo + (size_t)r * D + c) = xv;
                  *(uint2*)(xb + (size_t)r * D + c) = uint2{pack2bf(xv.x, xv.y), pack2bf(xv.z, xv.w)};
                  rs[m] += xv.x * xv.x + xv.y * xv.y + xv.z * xv.z + xv.w * xv.w;
                });
      {
        const int lane_ = threadIdx.x & 63, wid_ = threadIdx.x >> 6, wr_ = wid_ >> 1, wc_ = wid_ & 1;
        float* ssq = (float*)(p.ws + WS_SSQ);
#pragma unroll
        for (int m = 0; m < 4; ++m) {
          float t = rs[m];
          t += __shfl_xor(t, 16, 64);
          t += __shfl_xor(t, 32, 64);
          if ((lane_ >> 4) == 0) ssq[(size_t)(o0 + wr_ * 64 + m * 16 + (lane_ & 15)) * 16 + nt * 2 + wc_] = t;
        }
      }
    }
  }
}

__device__ void phase8(const Params& p, char* smem) {
  const u16* xb = (const u16*)(p.ws + WS_X1B);
  const u16* wt = (const u16*)(p.ws + WS_WQ);
  const float* ssq = (const float*)(p.ws + WS_SSQ);
  u16* q = (u16*)(p.ws + WS_Q);
  constexpr int MT = NOUT / 128, NT = 16, TOT = MT * NT;
  const int lane = threadIdx.x & 63, wr = (threadIdx.x >> 6) >> 1, fr = lane & 15;
  const int G = gridDim.x, full = p.full8, ntask = full + 4 * (TOT - full);
  auto row_rstd = [&](size_t row) {
    const float4* sp = (const float4*)(ssq + row * 16);
    float4 a = sp[0], b = sp[1], c = sp[2], d = sp[3];
    float ss = ((a.x + a.y) + (a.z + a.w)) + ((b.x + b.y) + (b.z + b.w)) + ((c.x + c.y) + (c.z + c.w)) + ((d.x + d.y) + (d.z + d.w));
    return rsqrtf(ss * (1.f / 1024.f) + 1e-5f);
  };
  for (int task = xcd_vid(); task < ntask; task += G) {
    int mt, nt;
    if (task < full) {
      grouped_tile(task, MT, NT, mt, nt);
      u16* crow = q + (size_t)mt * 128 * 2048 + nt * 128;
      float rstd[4];
#pragma unroll
      for (int m = 0; m < 4; ++m) rstd[m] = row_rstd((size_t)mt * 128 + wr * 64 + m * 16 + fr);
      gemm_tile(xb + (size_t)mt * 128 * D, D, wt + (size_t)nt * 128 * D, D, D, smem,
                [&](int m, int r, int c, f32x4 v) {
                  float sc = rstd[m];
                  *(uint2*)(crow + (size_t)r * 2048 + c) = uint2{pack2bf(v[0] * sc, v[1] * sc), pack2bf(v[2] * sc, v[3] * sc)};
                });
    } else {
      int rem = task - full, qd = rem & 3;
      grouped_tile(full + (rem >> 2), MT, NT, mt, nt);
      size_t r0 = (size_t)mt * 128 + qd * 32;
      u16* crow = q + r0 * 2048 + nt * 128;
      float rstd[2];
#pragma unroll
      for (int m = 0; m < 2; ++m) rstd[m] = row_rstd(r0 + m * 16 + fr);
      gemm_qtile(xb + r0 * D, D, wt + (size_t)nt * 128 * D, D, D, smem,
                 [&](int m, int r, int c, f32x4 v) {
                   float sc = rstd[m];
                   *(uint2*)(crow + (size_t)r * 2048 + c) = uint2{pack2bf(v[0] * sc, v[1] * sc), pack2bf(v[2] * sc, v[3] * sc)};
                 });
    }
  }
}

__device__ __forceinline__ unsigned ford(float f) {
  unsigned u = __float_as_uint(f);
  return (u & 0x80000000u) ? ~u : (u | 0x80000000u);
}
__device__ __forceinline__ float fdeord(unsigned k) {
  unsigned u = (k & 0x80000000u) ? (k & 0x7fffffffu) : ~k;
  return __uint_as_float(u);
}
__device__ __forceinline__ unsigned umax_(unsigned a, unsigned b) { return a > b ? a : b; }
__device__ __forceinline__ unsigned umin_(unsigned a, unsigned b) { return a < b ? a : b; }

#define CE_DESC(a, b) { unsigned _x = umax_(a, b), _y = umin_(a, b); a = _x; b = _y; }
#define CE_ASC(a, b) { unsigned _x = umin_(a, b), _y = umax_(a, b); a = _x; b = _y; }

template <int N>
__device__ __forceinline__ void bitonic_sort_desc(unsigned (&k)[N]) {
#pragma unroll
  for (int sz = 2; sz <= N; sz <<= 1) {
#pragma unroll
    for (int st = sz >> 1; st > 0; st >>= 1) {
#pragma unroll
      for (int i = 0; i < N; ++i) {
        int l = i ^ st;
        if (l > i) {
          if ((i & sz) == 0) CE_DESC(k[i], k[l]) else CE_ASC(k[i], k[l])
        }
      }
    }
  }
}
template <int N>
__device__ __forceinline__ void bitonic_merge_desc(unsigned (&k)[N]) {
#pragma unroll
  for (int st = N >> 1; st > 0; st >>= 1) {
#pragma unroll
    for (int i = 0; i < N; ++i) {
      int l = i ^ st;
      if (l > i) CE_DESC(k[i], k[l])
    }
  }
}
__device__ __forceinline__ void cross_merge16(unsigned (&k)[16]) {
#pragma unroll
  for (int x = 16; x <= 32; x <<= 1) {
    unsigned o[16];
#pragma unroll
    for (int i = 0; i < 16; ++i) o[i] = (unsigned)__shfl_xor((int)k[i], x, 64);
#pragma unroll
    for (int i = 0; i < 16; ++i) k[i] = umax_(k[i], o[15 - i]);
    bitonic_merge_desc<16>(k);
  }
}

__device__ __forceinline__ unsigned sel16(const unsigned (&a)[16], int k) {
  unsigned r = a[0];
#pragma unroll
  for (int i = 1; i < 16; ++i) r = (k == i) ? a[i] : r;
  return r;
}

__device__ void topk_unit(const Params& p, const char* smem, int tg, int h) {
  const int tid = threadIdx.x, lane = tid & 63, fr = lane & 15, fq = lane >> 4;
  const u16* q = (const u16*)(p.ws + WS_Q);
  int* idxo = (int*)(p.ws + WS_IDX);
  float* gateo = (float*)(p.ws + WS_GATE);
  const int o0 = tg * 16;
  float v1[16], v2[16];
  unsigned pk1[4] = {0u, 0u, 0u, 0u}, pk2[4] = {0u, 0u, 0u, 0u};
#pragma unroll
  for (int c = 0; c < 2; ++c) {
    bf16x8 qb[4];
#pragma unroll
    for (int ks = 0; ks < 4; ++ks)
      qb[ks] = *(const bf16x8*)(q + (size_t)(o0 + fr) * 2048 + (h * 2 + c) * 128 + ks * 32 + fq * 8);
    f32x4 acc[8];
#pragma unroll
    for (int i = 0; i < 8; ++i) acc[i] = f32x4{0.f, 0.f, 0.f, 0.f};
#pragma unroll
    for (int ks = 0; ks < 4; ++ks) {
#pragma unroll
      for (int mt = 0; mt < 8; ++mt) {
        bf16x8 ka = *(const bf16x8*)(smem + (c * 128 + mt * 16 + fr) * 256 + (((ks * 4 + fq) ^ fr) << 4));
        acc[mt] = mfma16(ka, qb[ks], acc[mt]);
      }
      __builtin_amdgcn_sched_barrier(0);
    }
    unsigned lo[16], hi[16];
#pragma unroll
    for (int mt = 0; mt < 4; ++mt)
#pragma unroll
      for (int j = 0; j < 4; ++j) {
        lo[mt * 4 + j] = (ford(acc[mt][j]) & 0xffffff80u) | (unsigned)(127 - (mt * 16 + fq * 4 + j));
        hi[mt * 4 + j] = (ford(acc[mt + 4][j]) & 0xffffff80u) | (unsigned)(127 - ((mt + 4) * 16 + fq * 4 + j));
      }
    bitonic_sort_desc<16>(lo);
    bitonic_sort_desc<16>(hi);
#pragma unroll
    for (int i = 0; i < 16; ++i) lo[i] = umax_(lo[i], hi[15 - i]);
    bitonic_merge_desc<16>(lo);
    cross_merge16(lo);
#pragma unroll
    for (int i = 0; i < 16; ++i) {
      float val = fdeord(lo[i] & 0xffffff80u);
      unsigned ix = (127u - (lo[i] & 0x7fu)) << ((i & 3) * 8);
      if (c == 0) { v1[i] = val; pk1[i >> 2] |= ix; } else { v2[i] = val; pk2[i >> 2] |= ix; }
    }
  }
  unsigned ck[16];
#define CAND(i, j) ((ford(v1[i] + v2[j]) & 0xffffff00u) | (unsigned)((i) * 16 + (j)))
#define SEL4(slot, A, B, C, Dv) ck[slot] = (fq == 0) ? (A) : (fq == 1) ? (B) : (fq == 2) ? (C) : (Dv);
  SEL4(0, CAND(0, 0), CAND(1, 0), CAND(3, 3), CAND(14, 0))
  SEL4(1, CAND(0, 1), CAND(1, 1), CAND(4, 0), CAND(15, 0))
  SEL4(2, CAND(0, 2), CAND(1, 2), CAND(4, 1), 0u)
  SEL4(3, CAND(0, 3), CAND(1, 3), CAND(4, 2), 0u)
  SEL4(4, CAND(0, 4), CAND(1, 4), CAND(5, 0), 0u)
  SEL4(5, CAND(0, 5), CAND(1, 5), CAND(5, 1), 0u)
  SEL4(6, CAND(0, 6), CAND(1, 6), CAND(6, 0), 0u)
  SEL4(7, CAND(0, 7), CAND(1, 7), CAND(6, 1), 0u)
  SEL4(8, CAND(0, 8), CAND(2, 0), CAND(7, 0), 0u)
  SEL4(9, CAND(0, 9), CAND(2, 1), CAND(7, 1), 0u)
  SEL4(10, CAND(0, 10), CAND(2, 2), CAND(8, 0), 0u)
  SEL4(11, CAND(0, 11), CAND(2, 3), CAND(9, 0), 0u)
  SEL4(12, CAND(0, 12), CAND(2, 4), CAND(10, 0), 0u)
  SEL4(13, CAND(0, 13), CAND(3, 0), CAND(11, 0), 0u)
  SEL4(14, CAND(0, 14), CAND(3, 1), CAND(12, 0), 0u)
  SEL4(15, CAND(0, 15), CAND(3, 2), CAND(13, 0), 0u)
#undef SEL4
#undef CAND
  bitonic_sort_desc<16>(ck);
  cross_merge16(ck);
  float top[16], esum = 0.f;
#pragma unroll
  for (int i = 0; i < 16; ++i) top[i] = fdeord(ck[i] & 0xffffff00u);
  const float tmax = top[0];
#pragma unroll
  for (int i = 0; i < 16; ++i) top[i] = __expf(top[i] - tmax);
#pragma unroll
  for (int i = 0; i < 16; ++i) esum += top[i];
  float inv = 1.f / esum;
  int oi[4];
  float og[4];
#pragma unroll
  for (int jj = 0; jj < 4; ++jj) {
    unsigned kk = (fq == 0) ? ck[jj] : (fq == 1) ? ck[4 + jj] : (fq == 2) ? ck[8 + jj] : ck[12 + jj];
    float tv = (fq == 0) ? top[jj] : (fq == 1) ? top[4 + jj] : (fq == 2) ? top[8 + jj] : top[12 + jj];
    int code = (int)(kk & 0xffu);
    int ci = code >> 4, cj = code & 15;
    unsigned d1 = (ci < 8) ? ((ci < 4) ? pk1[0] : pk1[1]) : ((ci < 12) ? pk1[2] : pk1[3]);
    unsigned d2 = (cj < 8) ? ((cj < 4) ? pk2[0] : pk2[1]) : ((cj < 12) ? pk2[2] : pk2[3]);
    int i1 = (int)((d1 >> ((ci & 3) * 8)) & 0xffu), i2 = (int)((d2 >> ((cj & 3) * 8)) & 0xffu);
    oi[jj] = i1 * 128 + i2;
    og[jj] = tv * inv;
  }
  size_t ob = (size_t)(o0 + fr) * 128 + h * 16 + fq * 4;
  *(int4*)(idxo + ob) = int4{oi[0], oi[1], oi[2], oi[3]};
  *(float4*)(gateo + ob) = float4{og[0], og[1], og[2], og[3]};
}

__device__ void phase9(const Params& p, char* smem) {
  const int w = threadIdx.x >> 6;
  {
    const u16* subk = (const u16*)(p.ws + WS_SUBK);
    for (int i = threadIdx.x; i < 4096; i += 256) {
      int row = i >> 4, lc = i & 15;
      *(uint4*)(smem + row * 256 + ((lc ^ (row & 15)) << 4)) = *(const uint4*)(subk + row * 128 + lc * 8);
    }
    __syncthreads();
  }
  for (int task = blockIdx.x; task < (NOUT / 16) * 2; task += gridDim.x) {
    int tg = task >> 1, h = (task & 1) * 4 + w;
    topk_unit(p, smem, tg, h);
  }
  __syncthreads();
}

#define F4(w, b) __builtin_amdgcn_cvt_scalef32_pk_f32_fp4((w), 1.0f, (b))
__device__ __forceinline__ float dot16f8(const float* h, uint2 u, float acc) {
  unsigned w[2] = {u.x, u.y};
#pragma unroll
  for (int i = 0; i < 2; ++i) {
    float2v v0 = F4(w[i], 0), v1 = F4(w[i], 1), v2 = F4(w[i], 2), v3 = F4(w[i], 3);
    acc = fmaf(h[8 * i], v0.x, acc); acc = fmaf(h[8 * i + 1], v0.y, acc);
    acc = fmaf(h[8 * i + 2], v1.x, acc); acc = fmaf(h[8 * i + 3], v1.y, acc);
    acc = fmaf(h[8 * i + 4], v2.x, acc); acc = fmaf(h[8 * i + 5], v2.y, acc);
    acc = fmaf(h[8 * i + 6], v3.x, acc); acc = fmaf(h[8 * i + 7], v3.y, acc);
  }
  return acc;
}
__device__ __forceinline__ void axpy16f8(float a, uint2 v, float* acc) {
  unsigned w[2] = {v.x, v.y};
#pragma unroll
  for (int i = 0; i < 2; ++i) {
    float2v v0 = F4(w[i], 0), v1 = F4(w[i], 1), v2 = F4(w[i], 2), v3 = F4(w[i], 3);
    acc[8 * i] = fmaf(a, v0.x, acc[8 * i]); acc[8 * i + 1] = fmaf(a, v0.y, acc[8 * i + 1]);
    acc[8 * i + 2] = fmaf(a, v1.x, acc[8 * i + 2]); acc[8 * i + 3] = fmaf(a, v1.y, acc[8 * i + 3]);
    acc[8 * i + 4] = fmaf(a, v2.x, acc[8 * i + 4]); acc[8 * i + 5] = fmaf(a, v2.y, acc[8 * i + 5]);
    acc[8 * i + 6] = fmaf(a, v3.x, acc[8 * i + 6]); acc[8 * i + 7] = fmaf(a, v3.y, acc[8 * i + 7]);
  }
}
__device__ __forceinline__ float reduce4(float d0, float d1, float d2, float d3) {
  auto s1 = __builtin_amdgcn_permlane32_swap(__float_as_uint(d0), __float_as_uint(d1), false, false);
  float s01 = __uint_as_float(s1[0]) + __uint_as_float(s1[1]);
  auto s2 = __builtin_amdgcn_permlane32_swap(__float_as_uint(d2), __float_as_uint(d3), false, false);
  float s23 = __uint_as_float(s2[0]) + __uint_as_float(s2[1]);
  auto s3 = __builtin_amdgcn_permlane16_swap(__float_as_uint(s01), __float_as_uint(s23), false, false);
  float t = __uint_as_float(s3[0]) + __uint_as_float(s3[1]);
  return red16(t);
}

__device__ void gather_task(const Params& p, int task) {
  const int wave = threadIdx.x >> 6, lane = threadIdx.x & 63;
  int o = task * 4 + wave;
  const unsigned char* eu8 = (const unsigned char*)(p.ws + WS_EU) + lane * 8;
  const unsigned char* ev8 = (const unsigned char*)(p.ws + WS_EV) + lane * 8;
  const float* scu = (const float*)(p.ws + WS_SCU);
  const float* scv = (const float*)(p.ws + WS_SCV);
  const int* idx = (const int*)(p.ws + WS_IDX) + (size_t)o * 128;
  const float* gate = (const float*)(p.ws + WS_GATE) + (size_t)o * 128;
  float* xrow = p.out + (size_t)o * D + lane * 16;
  float hf[16];
  {
    float x[16];
#pragma unroll
    for (int i = 0; i < 4; ++i) {
      float4 a = ((const float4*)xrow)[i];
      x[4 * i] = a.x; x[4 * i + 1] = a.y; x[4 * i + 2] = a.z; x[4 * i + 3] = a.w;
    }
    float ss2 = 0.f;
#pragma unroll
    for (int i = 0; i < 16; ++i) ss2 += x[i] * x[i];
    ss2 = wave_sum(ss2);
    float sc2 = rsqrtf(ss2 * (1.f / 1024.f) + 1e-5f);
    const float* g2 = p.norm2_g + lane * 16;
#pragma unroll
    for (int i = 0; i < 4; ++i) {
      float4 gg = ((const float4*)g2)[i];
      hf[4 * i] = x[4 * i] * sc2 * gg.x; hf[4 * i + 1] = x[4 * i + 1] * sc2 * gg.y;
      hf[4 * i + 2] = x[4 * i + 2] * sc2 * gg.z; hf[4 * i + 3] = x[4 * i + 3] * sc2 * gg.w;
    }
  }
  float acc[16];
#pragma unroll
  for (int i = 0; i < 16; ++i) acc[i] = 0.f;
  const int rw = lane >> 4;
  const int kl = (lane & 3) * 4 + ((rw == 1) ? 2 : (rw == 2) ? 1 : rw);
  for (int kb = 0; kb < 8; ++kb) {
    int myidx = idx[kb * 16 + (lane & 15)];
    int myidx2 = idx[kb * 16 + kl];
    float mygate = gate[kb * 16 + kl];
    float su = scu[myidx2], sv = scv[myidx2];
    float mypre = 0.f;
#pragma unroll
    for (int e8 = 0; e8 < 2; ++e8) {
      uint2 ua[8];
#pragma unroll
      for (int e = 0; e < 8; ++e) {
        int ei = __builtin_amdgcn_readlane(myidx, e8 * 8 + e);
        ua[e] = *(const uint2*)(eu8 + (size_t)ei * 512);
      }
      float d[8];
#pragma unroll
      for (int e = 0; e < 8; ++e) d[e] = dot16f8(hf, ua[e], 0.f);
      float tot0 = reduce4(d[0], d[1], d[2], d[3]);
      float tot1 = reduce4(d[4], d[5], d[6], d[7]);
      mypre = ((lane & 3) == e8 * 2) ? tot0 : mypre;
      mypre = ((lane & 3) == e8 * 2 + 1) ? tot1 : mypre;
    }
    mypre *= su;
    float myact = 0.5f * mypre * (1.f + erff(mypre * 0.70710678118654752f)) * mygate * sv;
#pragma unroll
    for (int e8 = 0; e8 < 2; ++e8) {
      uint2 va[8];
      float a[8];
#pragma unroll
      for (int e = 0; e < 8; ++e) {
        int ei = __builtin_amdgcn_readlane(myidx, e8 * 8 + e);
        const int e3 = e & 3, e4 = e8 * 2 + (e >> 2);
        const int pr = (e3 == 1) ? 2 : (e3 == 2) ? 1 : e3;
        a[e] = rdlane(myact, pr * 16 + e4);
        va[e] = *(const uint2*)(ev8 + (size_t)ei * 512);
      }
#pragma unroll
      for (int e = 0; e < 8; ++e) axpy16f8(a[e], va[e], acc);
    }
  }
  float x[16];
#pragma unroll
  for (int i = 0; i < 4; ++i) {
    float4 a = ((const float4*)xrow)[i];
    x[4 * i] = a.x; x[4 * i + 1] = a.y; x[4 * i + 2] = a.z; x[4 * i + 3] = a.w;
  }
  float ss = 0.f;
#pragma unroll
  for (int i = 0; i < 16; ++i) { x[i] += acc[i]; ss += x[i] * x[i]; }
  ss = wave_sum(ss);
  float sc = rsqrtf(ss * (1.f / 1024.f) + 1e-5f);
  const float* g = p.final_g + lane * 16;
#pragma unroll
  for (int i = 0; i < 4; ++i) {
    float4 gg = ((const float4*)g)[i];
    ((float4*)xrow)[i] = float4{x[4 * i] * sc * gg.x, x[4 * i + 1] * sc * gg.y, x[4 * i + 2] * sc * gg.z, x[4 * i + 3] * sc * gg.w};
  }
}

__device__ void gather_task_block(const Params& p, char* smem, int o) {
  const int wave = threadIdx.x >> 6, lane = threadIdx.x & 63;
  const unsigned char* eu8 = (const unsigned char*)(p.ws + WS_EU) + lane * 8;
  const unsigned char* ev8 = (const unsigned char*)(p.ws + WS_EV) + lane * 8;
  const float* scu = (const float*)(p.ws + WS_SCU);
  const float* scv = (const float*)(p.ws + WS_SCV);
  const int* idx = (const int*)(p.ws + WS_IDX) + (size_t)o * 128;
  const float* gate = (const float*)(p.ws + WS_GATE) + (size_t)o * 128;
  float* orow = p.out + (size_t)o * D;
  float hf[16];
  {
    const float* xrow = orow + lane * 16;
    float x[16];
#pragma unroll
    for (int i = 0; i < 4; ++i) {
      float4 a = ((const float4*)xrow)[i];
      x[4 * i] = a.x; x[4 * i + 1] = a.y; x[4 * i + 2] = a.z; x[4 * i + 3] = a.w;
    }
    float ss2 = 0.f;
#pragma unroll
    for (int i = 0; i < 16; ++i) ss2 += x[i] * x[i];
    ss2 = wave_sum(ss2);
    float sc2 = rsqrtf(ss2 * (1.f / 1024.f) + 1e-5f);
    const float* g2 = p.norm2_g + lane * 16;
#pragma unroll
    for (int i = 0; i < 4; ++i) {
      float4 gg = ((const float4*)g2)[i];
      hf[4 * i] = x[4 * i] * sc2 * gg.x; hf[4 * i + 1] = x[4 * i + 1] * sc2 * gg.y;
      hf[4 * i + 2] = x[4 * i + 2] * sc2 * gg.z; hf[4 * i + 3] = x[4 * i + 3] * sc2 * gg.w;
    }
  }
  float acc[16];
#pragma unroll
  for (int i = 0; i < 16; ++i) acc[i] = 0.f;
  const int rw = lane >> 4;
  const int kl = (lane & 3) * 4 + ((rw == 1) ? 2 : (rw == 2) ? 1 : rw);
#pragma unroll
  for (int kq = 0; kq < 2; ++kq) {
    const int kb = wave * 2 + kq;
    int myidx = idx[kb * 16 + (lane & 15)];
    int myidx2 = idx[kb * 16 + kl];
    float mygate = gate[kb * 16 + kl];
    float su = scu[myidx2], sv = scv[myidx2];
    float mypre = 0.f;
#pragma unroll
    for (int e8 = 0; e8 < 2; ++e8) {
      uint2 ua[8];
#pragma unroll
      for (int e = 0; e < 8; ++e) {
        int ei = __builtin_amdgcn_readlane(myidx, e8 * 8 + e);
        ua[e] = *(const uint2*)(eu8 + (size_t)ei * 512);
      }
      float d[8];
#pragma unroll
      for (int e = 0; e < 8; ++e) d[e] = dot16f8(hf, ua[e], 0.f);
      float tot0 = reduce4(d[0], d[1], d[2], d[3]);
      float tot1 = reduce4(d[4], d[5], d[6], d[7]);
      mypre = ((lane & 3) == e8 * 2) ? tot0 : mypre;
      mypre = ((lane & 3) == e8 * 2 + 1) ? tot1 : mypre;
    }
    mypre *= su;
    float myact = 0.5f * mypre * (1.f + erff(mypre * 0.70710678118654752f)) * mygate * sv;
#pragma unroll
    for (int e8 = 0; e8 < 2; ++e8) {
      uint2 va[8];
      float a[8];
#pragma unroll
      for (int e = 0; e < 8; ++e) {
        int ei = __builtin_amdgcn_readlane(myidx, e8 * 8 + e);
        const int e3 = e & 3, e4 = e8 * 2 + (e >> 2);
        const int pr = (e3 == 1) ? 2 : (e3 == 2) ? 1 : e3;
        a[e] = rdlane(myact, pr * 16 + e4);
        va[e] = *(const uint2*)(ev8 + (size_t)ei * 512);
      }
#pragma unroll
      for (int e = 0; e < 8; ++e) axpy16f8(a[e], va[e], acc);
    }
  }
  float* part = (float*)smem;
  float* red = part + 4096;
#pragma unroll
  for (int i = 0; i < 4; ++i)
    *(float4*)(part + wave * 1024 + lane * 16 + 4 * i) = float4{acc[4 * i], acc[4 * i + 1], acc[4 * i + 2], acc[4 * i + 3]};
  __syncthreads();
  const int c = threadIdx.x * 4;
  float4 xv = *(const float4*)(orow + c);
#pragma unroll
  for (int k = 0; k < 4; ++k) {
    float4 pv = *(const float4*)(part + k * 1024 + c);
    xv.x += pv.x; xv.y += pv.y; xv.z += pv.z; xv.w += pv.w;
  }
  float ss = wave_sum(xv.x * xv.x + xv.y * xv.y + xv.z * xv.z + xv.w * xv.w);
  if (lane == 0) red[wave] = ss;
  __syncthreads();
  ss = (red[0] + red[1]) + (red[2] + red[3]);
  float sc = rsqrtf(ss * (1.f / 1024.f) + 1e-5f);
  float4 gg = *(const float4*)(p.final_g + c);
  *(float4*)(orow + c) = float4{xv.x * sc * gg.x, xv.y * sc * gg.y, xv.z * sc * gg.z, xv.w * sc * gg.w};
  __syncthreads();
}

__device__ void phase10(const Params& p, char* smem) {
  const int G = gridDim.x, full = p.full10;
  for (int task = blockIdx.x; task < full; task += G) gather_task(p, task);
  for (int o = full * 4 + blockIdx.x; o < NOUT; o += G) gather_task_block(p, smem, o);
}

#define XB_TMO      128
#define XB_XCNT(j)  (256  + 64 * (j))
#define XB_XSUB(j)  (1280 + 64 * (j))
#define XB_XGEN(j)  (2304 + 64 * (j))
#define XB_TOP      3328
#define XB_TOPGEN   3392
#define XCD_BAR_WORDS 3456
#define XB_SPIN_CAP (1u << 20)
__device__ __forceinline__ unsigned xb_ld(unsigned* p) { return __hip_atomic_load(p, __ATOMIC_RELAXED, __HIP_MEMORY_SCOPE_AGENT); }
__device__ __forceinline__ unsigned xb_add(unsigned* p, unsigned v) { return __hip_atomic_fetch_add(p, v, __ATOMIC_RELAXED, __HIP_MEMORY_SCOPE_AGENT); }
__device__ __forceinline__ unsigned xb_xcc_id() { return (unsigned)__builtin_amdgcn_s_getreg((3 << 11) | 20) & 0xFu; }
#define XB_SPIN(cond, bar) do { unsigned _sp = 0; while (cond) { __builtin_amdgcn_s_sleep(1); \
    if ((++_sp & 255u) == 0u) { if (xb_ld(&(bar)[XB_TMO])) break; if (_sp > XB_SPIN_CAP) { atomicAdd(&(bar)[XB_TMO], 1u); break; } } } } while (0)

struct GridBar { int dummy; };

__device__ __forceinline__ GridBar gb_init(unsigned* bar) {
  GridBar b;
  b.dummy = 0;
  if (threadIdx.x == 0) (void)xb_add(&bar[XB_XCNT(xb_xcc_id())], 1u);
  return b;
}
__device__ __forceinline__ void gb_census(unsigned* bar, unsigned x, unsigned& nloc, unsigned& nx) {
  const unsigned G = gridDim.x;
  unsigned sum, cnt, mine, sp = 0u;
  for (;;) {
    sum = 0u; cnt = 0u; mine = 0u;
#pragma unroll
    for (unsigned j = 0; j < 16; ++j) {
      const unsigned c = xb_ld(&bar[XB_XCNT(j)]);
      sum += c; cnt += (c > 0u) ? 1u : 0u; mine = (j == x) ? c : mine;
    }
    if (sum == G) break;
    __builtin_amdgcn_s_sleep(1);
    if ((++sp & 255u) == 0u) { if (xb_ld(&bar[XB_TMO])) break; if (sp > XB_SPIN_CAP) { atomicAdd(&bar[XB_TMO], 1u); break; } }
  }
  nloc = mine > 0u ? mine : 1u; nx = cnt > 0u ? cnt : 1u;
}
template <bool FIRST>
__device__ __forceinline__ void gb_sync(GridBar& b, unsigned* bar) {
  asm volatile("s_waitcnt vmcnt(0)" ::: "memory");
  __syncthreads();
  if (threadIdx.x == 0) {
    const unsigned x = xb_xcc_id();
    __builtin_amdgcn_s_waitcnt(0);
    unsigned* slot = bar + 4096 + 2 * blockIdx.x;
    unsigned nloc, nx;
    if (FIRST) { gb_census(bar, x, nloc, nx); slot[0] = nloc; slot[1] = nx; }
    else { nloc = __hip_atomic_load(&slot[0], __ATOMIC_RELAXED, __HIP_MEMORY_SCOPE_AGENT); nx = __hip_atomic_load(&slot[1], __ATOMIC_RELAXED, __HIP_MEMORY_SCOPE_AGENT); }
    const unsigned old = xb_add(&bar[XB_XSUB(x)], 1u);
    const unsigned gen = old / nloc;
    if (old + 1u == (gen + 1u) * nloc) {
      __builtin_amdgcn_fence(__ATOMIC_RELEASE, "agent");
      asm volatile("s_waitcnt vmcnt(0)" ::: "memory");
      const unsigned og = xb_add(&bar[XB_TOP], 1u);
      const unsigned tg = og / nx;
      if (og + 1u == (tg + 1u) * nx) xb_add(&bar[XB_TOPGEN], 1u);
      else XB_SPIN(xb_ld(&bar[XB_TOPGEN]) == tg, bar);
      __builtin_amdgcn_fence(__ATOMIC_ACQUIRE, "agent");
      xb_add(&bar[XB_XGEN(x)], 1u);
      asm volatile("s_waitcnt vmcnt(0)" ::: "memory");
    } else {
      XB_SPIN(xb_ld(&bar[XB_XGEN(x)]) == gen, bar);
      __builtin_amdgcn_fence(__ATOMIC_ACQUIRE, "agent");
      asm volatile("s_waitcnt vmcnt(0)" ::: "memory");
    }
  }
  __syncthreads();
}

template <int PH>
__device__ __forceinline__ void run_phase(const Params& p, char* smem) {
  if constexpr (PH == 0) phase0(p, smem);
  if constexpr (PH == 1) phase1(p, smem);
  if constexpr (PH == 2) phase2(p);
  if constexpr (PH == 3) phase3(p, smem);
  if constexpr (PH == 4) phase4(p, smem);
  if constexpr (PH == 5) phase5(p);
  if constexpr (PH == 6) phase6(p, smem);
  if constexpr (PH == 8) phase8(p, smem);
  if constexpr (PH == 9) phase9(p, smem);
  if constexpr (PH == 10) phase10(p, smem);
}

template <int LO, int HI>
__device__ __forceinline__ void run_range(const Params& p, char* smem, GridBar& gb) {
  if constexpr (LO < HI) {
    run_phase<LO>(p, smem);
    if constexpr (LO + 1 < HI) {
      if constexpr (LO != 7) gb_sync<LO == 0>(gb, (unsigned*)(p.ws + WS_BAR));
      run_range<LO + 1, HI>(p, smem, gb);
    }
  }
}

template <int LO, int HI>
__global__ void __launch_bounds__(256, 2) fwd_kernel(Params p) {
  __shared__ __attribute__((aligned(16))) char smem[SMEM_BYTES];
  if (p.ws == nullptr) cg::this_grid().sync();
  GridBar gb = gb_init((unsigned*)(p.ws + WS_BAR));
  run_range<LO, HI>(p, smem, gb);
}

template <int PH>
static void launch_one(const Params& p, int grid, hipStream_t stream) {
  fwd_kernel<PH, PH + 1><<<grid, 256, 0, stream>>>(p);
}

extern "C" void kernel_launch(void* const* d_in, const int* in_sizes, int n_in, void* d_out, int out_size, void* d_ws,
                              size_t ws_size, hipStream_t stream) {
  Params p{};
  const float** pp = (const float**)&p;
  for (int i = 0; i < 28; ++i) pp[i] = (const float*)d_in[i];
  p.out = (float*)d_out;
  p.ws = (char*)d_ws;
#if MULTI_LAUNCH
  const int grid = 1024;
  p.full1 = ((MROWS / 128) * 20 / grid) * grid; p.full8 = ((NOUT / 128) * 16 / grid) * grid; p.full10 = ((NOUT / 4) / grid) * grid; p.pad_ = 0;
  launch_one<0>(p, grid, stream);
  launch_one<1>(p, grid, stream);
  launch_one<2>(p, grid, stream);
  launch_one<3>(p, grid, stream);
  launch_one<4>(p, grid, stream);
  launch_one<5>(p, grid, stream);
  launch_one<6>(p, grid, stream);
  launch_one<7>(p, grid, stream);
  launch_one<8>(p, grid, stream);
  launch_one<9>(p, grid, stream);
  launch_one<10>(p, grid, stream);
#else
  static int grid_blocks = 0;
  if (!grid_blocks) {
    int dev = 0, cus = 0, per_cu = 0;
    (void)hipGetDevice(&dev);
    (void)hipDeviceGetAttribute(&cus, hipDeviceAttributeMultiprocessorCount, dev);
    (void)hipOccupancyMaxActiveBlocksPerMultiprocessor(&per_cu, fwd_kernel<0, NPH>, 256, 0);
    if (per_cu < 1) per_cu = 1;
    if (per_cu > 4) per_cu = 4;
    grid_blocks = cus * per_cu;
  }
  (void)hipMemsetAsync((char*)d_ws + WS_BAR, 0, XCD_BAR_WORDS * sizeof(unsigned), stream);
  p.full1 = ((MROWS / 128) * 20 / grid_blocks) * grid_blocks;
  p.full8 = ((NOUT / 128) * 16 / grid_blocks) * grid_blocks;
  p.full10 = ((NOUT / 4) / grid_blocks) * grid_blocks;
  p.pad_ = 0;
  void* args[] = {&p};
  hipError_t e = hipLaunchCooperativeKernel((void*)fwd_kernel<0, NPH>, dim3(grid_blocks), dim3(256), args, 0, stream);
  if (e != hipSuccess) fprintf(stderr, "cooperative launch failed: %s (grid %d)\n", hipGetErrorString(e), grid_blocks);
#endif
}
```

```cpp
#include <hip/hip_runtime.h>
#include <hip/hip_cooperative_groups.h>
#include <cstdio>
#include <cstdint>
namespace cg = cooperative_groups;

typedef unsigned short u16;
using bf16x8 = __attribute__((ext_vector_type(8))) short;
using f32x4 = __attribute__((ext_vector_type(4))) float;
using half2v = __attribute__((ext_vector_type(2))) _Float16;
using float2v = __attribute__((ext_vector_type(2))) float;

#ifndef MULTI_LAUNCH
#define MULTI_LAUNCH 0
#endif

constexpr int D = 1024, NIN = 2560;
constexpr int LP = 4112, NB = 4, TP = NB * LP;
constexpr int SB = 128, TS = 512;
constexpr int TTOK = TP + TS;
constexpr int PREV0 = TTOK;
constexpr int MROWS = 17152;
constexpr int TPAD = 17024;
constexpr int NOUT = 16896;
constexpr int PAST = 8192;
constexpr int NPH = 11;

constexpr size_t O_YP = 0;
constexpr size_t O_KWP = 17301504, O_VWP = 17367040, O_WKVP = 17432576, O_SHP = 17563648;
constexpr size_t O_KWS = 17567744, O_VWS = 19664896, O_WKVS = 21762048, O_SHS = 25956352;

constexpr size_t WS_WIN = 0;
constexpr size_t WS_WOUT = WS_WIN + 2560ull * 1024 * 2;
constexpr size_t WS_WQ = WS_WOUT + 1024ull * 1024 * 2;
constexpr size_t WS_SUBK = WS_WQ + 2048ull * 1024 * 2;
constexpr size_t WS_W2W = WS_SUBK + 2ull * 128 * 128 * 2;
constexpr size_t WS_W2A = WS_W2W + 512ull * 64 * 2;
constexpr size_t WS_W2G = WS_W2A + 512ull * 64 * 2;
constexpr size_t WS_B = WS_W2G + 512ull * 128 * 2;
constexpr size_t WS_C = WS_B + (size_t)MROWS * 1024 * 2;
constexpr size_t WS_D = WS_C + (size_t)MROWS * NIN * 2;
constexpr size_t WS_E = WS_D + (size_t)TPAD * 512 * 8;
constexpr size_t WS_END = WS_E + (size_t)TPAD * 512 * 4;
constexpr size_t WS_DEC = WS_D, WS_A = WS_D + (size_t)TPAD * 512 * 4, WS_G = WS_A + (size_t)TPAD * 512 * 2;
constexpr size_t WS_EU = WS_E, WS_EV = WS_E + 16384ull * 512, WS_SCU = WS_EV + 16384ull * 512, WS_SCV = WS_SCU + 65536;
constexpr size_t WS_X1B = WS_D, WS_SSQ = WS_D + 40ull * 1024 * 1024;
constexpr size_t WS_Q = WS_C, WS_IDX = WS_C + (size_t)NOUT * 2048 * 2, WS_GATE = WS_IDX + (size_t)NOUT * 128 * 4;
static_assert(WS_SCV + 65536 <= WS_END, "expert tables overflow region E");
static_assert(WS_X1B + (size_t)NOUT * 2048 <= WS_SSQ && WS_SSQ + (size_t)NOUT * 64 <= WS_E, "x1b/ssq overflow region D");
static_assert(WS_GATE + (size_t)NOUT * 128 * 4 <= WS_D, "idx/gate overflow region C");
constexpr size_t WS_BAR = WS_END;
static_assert(WS_BAR + 32768 <= 256ull * 1024 * 1024, "workspace too large");

constexpr int SMEM_BYTES = 65536;

struct Params {
  const float *x_prompt, *x_sample, *cache_k, *cache_v, *state_wkv, *state_shift, *meta, *norm1_g, *w_in, *mu, *w0,
      *w2w, *a0, *w2a, *w2g, *k_k, *k_a, *r_k, *lnx_w, *lnx_b, *sinks, *w_out, *norm2_g, *w_query, *sub_keys, *eu,
      *ev, *final_g;
  float* out;
  char* ws;
  int full1, full8, full10, pad_;
};

__constant__ double INVF[8] = {1.0, 0.19392274474868576, 0.03760603093086393, 0.007292664737217109,
                               0.001414213562373095, 0.0002742481756762073, 5.318295896944988e-05,
                               1.031338537721246e-05};

__device__ __forceinline__ u16 f2bf(float f) {
  unsigned u = __float_as_uint(f);
  u += 0x7fffu + ((u >> 16) & 1u);
  return (u16)(u >> 16);
}
__device__ __forceinline__ float bf2f(u16 h) { return __uint_as_float(((unsigned)h) << 16); }
__device__ __forceinline__ float bflo(unsigned u) { return __uint_as_float(u << 16); }
__device__ __forceinline__ float bfhi(unsigned u) { return __uint_as_float(u & 0xffff0000u); }
__device__ __forceinline__ unsigned pack2bf(float a, float b) { return (unsigned)f2bf(a) | ((unsigned)f2bf(b) << 16); }
__device__ __forceinline__ u16 f2h(float f) {
  _Float16 h = (_Float16)f;
  return __builtin_bit_cast(u16, h);
}

template <int CTRL>
__device__ __forceinline__ float dppf(float x) {
  return __int_as_float(__builtin_amdgcn_update_dpp(0, __float_as_int(x), CTRL, 0xF, 0xF, false));
}
__device__ __forceinline__ float red4(float x) {
  x += dppf<0xB1>(x);
  x += dppf<0x4E>(x);
  return x;
}
__device__ __forceinline__ float red8(float x) {
  x = red4(x);
  x += dppf<0x141>(x);
  return x;
}
__device__ __forceinline__ float red16(float x) {
  x = red8(x);
  x += dppf<0x140>(x);
  return x;
}
__device__ __forceinline__ float redmax16(float x) {
  x = fmaxf(x, dppf<0xB1>(x));
  x = fmaxf(x, dppf<0x4E>(x));
  x = fmaxf(x, dppf<0x141>(x));
  x = fmaxf(x, dppf<0x140>(x));
  return x;
}
__device__ __forceinline__ float rdlane(float x, int l) {
  return __int_as_float(__builtin_amdgcn_readlane(__float_as_int(x), l));
}
__device__ __forceinline__ float wave_sum(float x) {
  x = red16(x);
  return rdlane(x, 0) + rdlane(x, 16) + rdlane(x, 32) + rdlane(x, 48);
}
__device__ __forceinline__ f32x4 mfma16(bf16x8 a, bf16x8 b, f32x4 c) {
  return __builtin_amdgcn_mfma_f32_16x16x32_bf16(a, b, c, 0, 0, 0);
}
__device__ __forceinline__ float sigmoidf_(float x) { return __builtin_amdgcn_rcpf(1.f + __expf(-x)); }

template <class Epi>
__device__ __forceinline__ void gemm_tile(const u16* __restrict__ A, int lda, const u16* __restrict__ Bt, int ldb, int K,
                                          char* smem, Epi epi) {
  const int tid = threadIdx.x, wid = tid >> 6, lane = tid & 63, wr = wid >> 1, wc = wid & 1, fr = lane & 15,
            fq = lane >> 4;
  f32x4 acc[4][4];
#pragma unroll
  for (int m = 0; m < 4; ++m)
#pragma unroll
    for (int n = 0; n < 4; ++n) acc[m][n] = f32x4{0.f, 0.f, 0.f, 0.f};
  const int nk = K / 64;
  auto stage = [&](int buf, int kt) {
    char* SA = smem + buf * 32768;
    char* SB = SA + 16384;
#pragma unroll
    for (int i = 0; i < 4; ++i) {
      int b = tid * 16 + i * 4096, r = b >> 7, pc = (b >> 4) & 7;
      int c = kt * 64 + ((pc ^ ((r >> 1) & 7)) << 3);
      __builtin_amdgcn_global_load_lds((const unsigned*)(A + (size_t)r * lda + c),
                                       (__attribute__((address_space(3))) unsigned*)(SA + b), 16, 0, 0);
      __builtin_amdgcn_global_load_lds((const unsigned*)(Bt + (size_t)r * ldb + c),
                                       (__attribute__((address_space(3))) unsigned*)(SB + b), 16, 0, 0);
    }
  };
  stage(0, 0);
  asm volatile("s_waitcnt vmcnt(0)" ::: "memory");
  __syncthreads();
  for (int kt = 0; kt < nk; ++kt) {
    const int cur = kt & 1;
    if (kt + 1 < nk) stage(cur ^ 1, kt + 1);
    const char* SA = smem + cur * 32768;
    const char* SB = SA + 16384;
#pragma unroll
    for (int ks = 0; ks < 2; ++ks) {
      bf16x8 At[4], Bl[4];
#pragma unroll
      for (int m = 0; m < 4; ++m) {
        int r = wr * 64 + m * 16 + fr;
        At[m] = *(const bf16x8*)(SA + r * 128 + (((ks * 4 + fq) ^ ((r >> 1) & 7)) << 4));
      }
#pragma unroll
      for (int n = 0; n < 4; ++n) {
        int r = wc * 64 + n * 16 + fr;
        Bl[n] = *(const bf16x8*)(SB + r * 128 + (((ks * 4 + fq) ^ ((r >> 1) & 7)) << 4));
      }
      __builtin_amdgcn_s_setprio(1);
#pragma unroll
      for (int m = 0; m < 4; ++m)
#pragma unroll
        for (int n = 0; n < 4; ++n) acc[m][n] = mfma16(Bl[n], At[m], acc[m][n]);
      __builtin_amdgcn_s_setprio(0);
    }
    asm volatile("s_waitcnt vmcnt(0)" ::: "memory");
    __syncthreads();
  }
#pragma unroll
  for (int m = 0; m < 4; ++m)
#pragma unroll
    for (int n = 0; n < 4; ++n) epi(m, wr * 64 + m * 16 + fr, wc * 64 + n * 16 + fq * 4, acc[m][n]);
}

template <class Epi>
__device__ __forceinline__ void gemm_qtile(const u16* __restrict__ A, int lda, const u16* __restrict__ Bt, int ldb, int K,
                                           char* smem, Epi epi) {
  const int tid = threadIdx.x, wid = tid >> 6, lane = tid & 63, fr = lane & 15, fq = lane >> 4;
  f32x4 acc[2][2];
#pragma unroll
  for (int m = 0; m < 2; ++m)
#pragma unroll
    for (int n = 0; n < 2; ++n) acc[m][n] = f32x4{0.f, 0.f, 0.f, 0.f};
  const int nk = K / 64;
  auto stage = [&](int buf, int kt) {
    char* SA = smem + buf * 32768;
    char* SB = SA + 16384;
    {
      int b = tid * 16, r = b >> 7, pc = (b >> 4) & 7;
      int c = kt * 64 + ((pc ^ ((r >> 1) & 7)) << 3);
      __builtin_amdgcn_global_load_lds((const unsigned*)(A + (size_t)r * lda + c),
                                       (__attribute__((address_space(3))) unsigned*)(SA + b), 16, 0, 0);
    }
#pragma unroll
    for (int i = 0; i < 4; ++i) {
      int b = tid * 16 + i * 4096, r = b >> 7, pc = (b >> 4) & 7;
      int c = kt * 64 + ((pc ^ ((r >> 1) & 7)) << 3);
      __builtin_amdgcn_global_load_lds((const unsigned*)(Bt + (size_t)r * ldb + c),
                                       (__attribute__((address_space(3))) unsigned*)(SB + b), 16, 0, 0);
    }
  };
  stage(0, 0);
  asm volatile("s_waitcnt vmcnt(0)" ::: "memory");
  __syncthreads();
  for (int kt = 0; kt < nk; ++kt) {
    const int cur = kt & 1;
    if (kt + 1 < nk) stage(cur ^ 1, kt + 1);
    const char* SA = smem + cur * 32768;
    const char* SB = SA + 16384;
#pragma unroll
    for (int ks = 0; ks < 2; ++ks) {
      bf16x8 At[2], Bl[2];
#pragma unroll
      for (int m = 0; m < 2; ++m) {
        int r = m * 16 + fr;
        At[m] = *(const bf16x8*)(SA + r * 128 + (((ks * 4 + fq) ^ ((r >> 1) & 7)) << 4));
      }
#pragma unroll
      for (int n = 0; n < 2; ++n) {
        int r = wid * 32 + n * 16 + fr;
        Bl[n] = *(const bf16x8*)(SB + r * 128 + (((ks * 4 + fq) ^ ((r >> 1) & 7)) << 4));
      }
#pragma unroll
      for (int m = 0; m < 2; ++m)
#pragma unroll
        for (int n = 0; n < 2; ++n) acc[m][n] = mfma16(Bl[n], At[m], acc[m][n]);
    }
    asm volatile("s_waitcnt vmcnt(0)" ::: "memory");
    __syncthreads();
  }
#pragma unroll
  for (int m = 0; m < 2; ++m)
#pragma unroll
    for (int n = 0; n < 2; ++n) epi(m, m * 16 + fr, wid * 32 + n * 16 + fq * 4, acc[m][n]);
}

__device__ __forceinline__ int xcd_vid() { return (blockIdx.x & 7) * (gridDim.x >> 3) + (blockIdx.x >> 3); }
__device__ __forceinline__ void grouped_tile(int t, int MT, int NT, int& mt, int& nt) {
  const int GM = 8;
  int per = GM * NT, gid = t / per, rem = t - gid * per;
  int first = gid * GM, gsz = min(MT - first, GM);
  mt = first + rem % gsz;
  nt = rem / gsz;
}

__device__ void transpose_task(const float* __restrict__ src, int K, int N, u16* __restrict__ dst, int tile, char* smem,
                               const float* __restrict__ kscale = nullptr) {
  const int tid = threadIdx.x;
  int tn = N / 64;
  int k0 = (tile / tn) * 64, n0 = (tile % tn) * 64;
  float* t = (float*)smem;
#pragma unroll 4
  for (int it = 0; it < 16; ++it) {
    int k = it * 4 + (tid >> 6), n = tid & 63;
    t[n * 65 + k] = src[(size_t)(k0 + k) * N + n0 + n] * (kscale ? kscale[k0 + k] : 1.f);
  }
  __syncthreads();
#pragma unroll 4
  for (int it = 0; it < 16; ++it) {
    int n = it * 4 + (tid >> 6), k = tid & 63;
    dst[(size_t)(n0 + n) * K + k0 + k] = f2bf(t[n * 65 + k]);
  }
  __syncthreads();
}

__device__ void norm1_task(const Params& p, int task) {
  const int wave = threadIdx.x >> 6, lane = threadIdx.x & 63;
  int row = task * 4 + wave;
  u16* h = (u16*)(p.ws + WS_B) + (size_t)row * D;
  const float* src = nullptr;
  bool donorm = true;
  float* shout = nullptr;
  if (row < TP) {
    int b = row / LP, t = row % LP;
    src = (t < 16) ? p.meta + (size_t)t * D : p.x_prompt + ((size_t)b * 4096 + (t - 16)) * D;
    if (t == LP - 1) shout = p.out + O_SHP + (size_t)b * D;
  } else if (row < TTOK) {
    int r = row - TP;
    src = p.x_sample + (size_t)r * D;
    if ((r & 3) == 3) shout = p.out + O_SHS + (size_t)(r >> 2) * D;
  } else if (row < TTOK + SB) {
    src = p.state_shift + (size_t)(row - TTOK) * D;
    donorm = false;
  }
  if (!src) {
#pragma unroll
    for (int i = 0; i < 4; ++i) *(uint2*)(h + (i * 64 + lane) * 4) = uint2{0u, 0u};
    return;
  }
  float4 v[4];
  float ss = 0.f;
#pragma unroll
  for (int i = 0; i < 4; ++i) {
    v[i] = ((const float4*)src)[i * 64 + lane];
    ss += v[i].x * v[i].x + v[i].y * v[i].y + v[i].z * v[i].z + v[i].w * v[i].w;
  }
  float sc = 1.f;
  if (donorm) {
    ss = wave_sum(ss);
    sc = rsqrtf(ss * (1.f / 1024.f) + 1e-5f);
  }
#pragma unroll
  for (int i = 0; i < 4; ++i) {
    float4 y = v[i];
    if (donorm) {
      float4 g = ((const float4*)p.norm1_g)[i * 64 + lane];
      y.x *= sc * g.x; y.y *= sc * g.y; y.z *= sc * g.z; y.w *= sc * g.w;
    }
    *(uint2*)(h + (i * 64 + lane) * 4) = uint2{pack2bf(y.x, y.y), pack2bf(y.z, y.w)};
    if (shout) ((float4*)shout)[i * 64 + lane] = y;
  }
}

__device__ void phase0(const Params& p, char* smem) {
  constexpr int N_NORM = MROWS / 4;
  constexpr int T_WIN = 16 * 40, T_WOUT = 16 * 16, T_WQ = 16 * 32, T_W2W = 8, T_W2A = 8, T_W2G = 16, T_SUBK = 32;
  constexpr int TOT = N_NORM + T_WIN + T_W2W + T_W2A + T_W2G + T_SUBK;
  for (int task = blockIdx.x; task < TOT; task += gridDim.x) {
    int t = task;
    if (t < N_NORM) { norm1_task(p, t); continue; }
    t -= N_NORM;
    if (t < T_WIN) { transpose_task(p.w_in, 1024, 2560, (u16*)(p.ws + WS_WIN), t, smem); continue; }
    t -= T_WIN;
    if (t < T_W2W) { transpose_task(p.w2w, 64, 512, (u16*)(p.ws + WS_W2W), t, smem); continue; }
    t -= T_W2W;
    if (t < T_W2A) { transpose_task(p.w2a, 64, 512, (u16*)(p.ws + WS_W2A), t, smem); continue; }
    t -= T_W2A;
    if (t < T_W2G) { transpose_task(p.w2g, 128, 512, (u16*)(p.ws + WS_W2G), t, smem); continue; }
    t -= T_W2G;
    {
      int e = (t * 256 + threadIdx.x) * 4;
      float4 v = *(const float4*)(p.sub_keys + e);
      *(uint2*)((u16*)(p.ws + WS_SUBK) + e) = uint2{pack2bf(v.x, v.y), pack2bf(v.z, v.w)};
    }
  }
}

__device__ void phase1(const Params& p, char* smem) {
  const u16* hbuf = (const u16*)(p.ws + WS_B);
  const u16* wt = (const u16*)(p.ws + WS_WIN);
  u16* proj = (u16*)(p.ws + WS_C);
  constexpr int NT = 20, MT = MROWS / 128, TOT = MT * NT;
  const int G = gridDim.x, full = p.full1, ntask = full + 4 * (TOT - full);
  for (int task = xcd_vid(); task < ntask; task += G) {
    int mt, nt;
    if (task < full) {
      grouped_tile(task, MT, NT, mt, nt);
      u16* crow = proj + (size_t)mt * 128 * NIN + nt * 128;
      gemm_tile(hbuf + (size_t)mt * 128 * D, D, wt + (size_t)nt * 128 * D, D, D, smem,
                [&](int m, int r, int c, f32x4 v) { *(uint2*)(crow + (size_t)r * NIN + c) = uint2{pack2bf(v[0], v[1]), pack2bf(v[2], v[3])}; });
    } else {
      int rem = task - full, qd = rem & 3;
      grouped_tile(full + (rem >> 2), MT, NT, mt, nt);
      size_t r0 = (size_t)mt * 128 + qd * 32;
      u16* crow = proj + r0 * NIN + nt * 128;
      gemm_qtile(hbuf + r0 * D, D, wt + (size_t)nt * 128 * D, D, D, smem,
                 [&](int m, int r, int c, f32x4 v) { *(uint2*)(crow + (size_t)r * NIN + c) = uint2{pack2bf(v[0], v[1]), pack2bf(v[2], v[3])}; });
    }
  }
}

__device__ void prepass_task(const Params& p, int task) {
  const int wave = threadIdx.x >> 6, lane = threadIdx.x & 63;
  int row = task * 4 + wave;
  if (row >= TTOK) return;
  u16* proj = (u16*)(p.ws + WS_C);
  u16* act = (u16*)(p.ws + WS_E);
  bool isP = row < TP;
  int b, t, prow;
  float pos;
  if (isP) { b = row / LP; t = row % LP; prow = t > 0 ? row - 1 : -1; pos = (float)t; }
  else { int r = row - TP; b = r >> 2; t = r & 3; prow = t > 0 ? row - 1 : PREV0 + b; pos = (float)(PAST + t); }
  u16* pr = proj + (size_t)row * NIN;
  const u16* pp = prow >= 0 ? proj + (size_t)prow * NIN : nullptr;
  {
    int c = 1536 + lane * 4;
    uint2 a = *(const uint2*)(pr + c);
    uint2 bq = pp ? *(const uint2*)(pp + c) : uint2{0u, 0u};
    float4 mu = *(const float4*)(p.mu + c);
    float x[4] = {bflo(a.x), bfhi(a.x), bflo(a.y), bfhi(a.y)};
    float xp[4] = {bflo(bq.x), bfhi(bq.x), bflo(bq.y), bfhi(bq.y)};
    float mm[4] = {mu.x, mu.y, mu.z, mu.w};
    float o[4];
#pragma unroll
    for (int i = 0; i < 4; ++i) {
      float m = x[i] + (xp[i] - x[i]) * mm[i];
      float r;
      if (lane < 16) r = tanhf(m);
      else if (lane < 32) r = m;
      else r = sigmoidf_(m);
      o[i] = r;
    }
    *(uint2*)(act + (size_t)row * 256 + lane * 4) = uint2{pack2bf(o[0], o[1]), pack2bf(o[2], o[3])};
  }
  float* kwin = nullptr;
  float* vwin = nullptr;
  if (isP) {
    if (t >= LP - 128) {
      kwin = p.out + O_KWP + ((size_t)b * 128 + (t - (LP - 128))) * 128;
      vwin = p.out + O_VWP + ((size_t)b * 128 + (t - (LP - 128))) * 128;
    }
  } else {
    kwin = p.out + O_KWS + ((size_t)b * 128 + 124 + t) * 128;
    vwin = p.out + O_VWS + ((size_t)b * 128 + 124 + t) * 128;
  }
  for (int it = lane; it < 80; it += 64) {
    int hh = it >> 3, d = it & 7;
    int col = 1792 + hh * 64 + d;
    float x1 = bf2f(pr[col]), x2 = bf2f(pr[col + 8]);
    double rev = (double)pos * INVF[d] * 0.15915494309189535;
    float fr = (float)(rev - floor(rev));
    float sn = __builtin_amdgcn_sinf(fr), cs = __builtin_amdgcn_cosf(fr);
    float r1 = x1 * cs - x2 * sn, r2 = x2 * cs + x1 * sn;
    pr[col] = f2bf(r1);
    pr[col + 8] = f2bf(r2);
    if (hh >= 8 && kwin) {
      kwin[(hh - 8) * 64 + d] = r1;
      kwin[(hh - 8) * 64 + d + 8] = r2;
    }
  }
  if (kwin) {
#pragma unroll
    for (int i = 0; i < 2; ++i) {
      int idx = lane * 2 + i;
      if ((idx & 63) >= 16) kwin[idx] = bf2f(pr[2304 + idx]);
      vwin[idx] = bf2f(pr[2432 + idx]);
    }
  }
}

__device__ void phase2(const Params& p) {
  constexpr int N_PRE = TTOK / 4;
  constexpr int N_CP = 256;
  for (int task = blockIdx.x; task < N_PRE + N_CP; task += gridDim.x) {
    if (task < N_PRE) { prepass_task(p, task); continue; }
    int t = task - N_PRE;
    int which = t >> 7, b = t & 127;
    const float4* src = (const float4*)((which ? p.cache_v : p.cache_k) + (size_t)b * 16384 + 512);
    float4* dst = (float4*)(p.out + (which ? O_VWS : O_KWS) + (size_t)b * 16384);
    for (int i = threadIdx.x; i < 3968; i += 256) dst[i] = src[i];
  }
}

__device__ void phase3(const Params& p, char* smem) {
  const u16* act = (const u16*)(p.ws + WS_E);
  float* dec = (float*)(p.ws + WS_DEC);
  u16* ab = (u16*)(p.ws + WS_A);
  u16* gb = (u16*)(p.ws + WS_G);
  constexpr int MT = TPAD / 128;
  for (int tile = blockIdx.x; tile < MT * 12; tile += gridDim.x) {
    int which = tile % 3, rest = tile / 3;
    int nt = rest & 3, mt = rest >> 2;
    size_t r0 = (size_t)mt * 128;
    int c0 = nt * 128;
    if (which == 0) {
      gemm_tile(act + r0 * 256, 256, (const u16*)(p.ws + WS_W2W) + (size_t)c0 * 64, 64, 64, smem,
                [&](int m, int r, int c, f32x4 v) {
                  float4 w0v = *(const float4*)(p.w0 + c0 + c);
                  float w0a[4] = {w0v.x, w0v.y, w0v.z, w0v.w};
                  float o[4];
#pragma unroll
                  for (int e = 0; e < 4; ++e) {
                    float nx = -(w0a[e] + v[e]);
                    float sp = fmaxf(nx, 0.f) + __logf(1.f + __expf(-fabsf(nx)));
                    o[e] = __expf(-__expf(-sp - 0.5f));
                  }
                  *(float4*)(dec + (r0 + r) * 512 + c0 + c) = float4{o[0], o[1], o[2], o[3]};
                });
    } else if (which == 1) {
      gemm_tile(act + r0 * 256 + 64, 256, (const u16*)(p.ws + WS_W2A) + (size_t)c0 * 64, 64, 64, smem,
                [&](int m, int r, int c, f32x4 v) {
                  float4 a0v = *(const float4*)(p.a0 + c0 + c);
                  *(uint2*)(ab + (r0 + r) * 512 + c0 + c) = uint2{pack2bf(sigmoidf_(a0v.x + v[0]), sigmoidf_(a0v.y + v[1])), pack2bf(sigmoidf_(a0v.z + v[2]), sigmoidf_(a0v.w + v[3]))};
                });
    } else {
      gemm_tile(act + r0 * 256 + 128, 256, (const u16*)(p.ws + WS_W2G) + (size_t)c0 * 128, 128, 128, smem,
                [&](int m, int r, int c, f32x4 v) { *(uint2*)(gb + (r0 + r) * 512 + c0 + c) = uint2{pack2bf(v[0], v[1]), pack2bf(v[2], v[3])}; });
    }
  }
}

__device__ void convert_task(const Params& p, int task) {
  const int wave = threadIdx.x >> 6, lane = threadIdx.x & 63;
  int r = task * 4 + wave;
  const float* src = (r < 16384 ? p.eu + (size_t)r * 1024 : p.ev + (size_t)(r - 16384) * 1024) + lane * 16;
  float4 x[4];
  float am = 0.f;
#pragma unroll
  for (int i = 0; i < 4; ++i) {
    x[i] = ((const float4*)src)[i];
    am = fmaxf(am, fmaxf(fmaxf(fabsf(x[i].x), fabsf(x[i].y)), fmaxf(fabsf(x[i].z), fabsf(x[i].w))));
  }
  am = redmax16(am);
  am = fmaxf(fmaxf(rdlane(am, 0), rdlane(am, 16)), fmaxf(rdlane(am, 32), rdlane(am, 48)));
  float scale = am > 0.f ? 7.f / am : 1.f;
  float inv = am > 0.f ? am * (1.f / 7.f) : 1.f;
  float y[16];
#pragma unroll
  for (int i = 0; i < 4; ++i) {
    y[4 * i] = fminf(fmaxf(x[i].x * scale, -6.f), 6.f); y[4 * i + 1] = fminf(fmaxf(x[i].y * scale, -6.f), 6.f);
    y[4 * i + 2] = fminf(fmaxf(x[i].z * scale, -6.f), 6.f); y[4 * i + 3] = fminf(fmaxf(x[i].w * scale, -6.f), 6.f);
  }
  unsigned w0 = 0u, w1 = 0u;
  w0 = __builtin_amdgcn_cvt_scalef32_pk_fp4_f32(w0, y[0], y[1], 1.0f, 0);
  w0 = __builtin_amdgcn_cvt_scalef32_pk_fp4_f32(w0, y[2], y[3], 1.0f, 1);
  w0 = __builtin_amdgcn_cvt_scalef32_pk_fp4_f32(w0, y[4], y[5], 1.0f, 2);
  w0 = __builtin_amdgcn_cvt_scalef32_pk_fp4_f32(w0, y[6], y[7], 1.0f, 3);
  w1 = __builtin_amdgcn_cvt_scalef32_pk_fp4_f32(w1, y[8], y[9], 1.0f, 0);
  w1 = __builtin_amdgcn_cvt_scalef32_pk_fp4_f32(w1, y[10], y[11], 1.0f, 1);
  w1 = __builtin_amdgcn_cvt_scalef32_pk_fp4_f32(w1, y[12], y[13], 1.0f, 2);
  w1 = __builtin_amdgcn_cvt_scalef32_pk_fp4_f32(w1, y[14], y[15], 1.0f, 3);
  *(uint2*)((unsigned char*)(p.ws + WS_EU) + (size_t)r * 512 + lane * 8) = uint2{w0, w1};
  if (lane == 0) ((float*)(p.ws + WS_SCU))[r] = inv;
}

struct ScanRaw {
  uint2 rr, rk, rv, qr, qk, qv, av;
  float4 dc;
};
constexpr int SC_TOK = 332;

__device__ void scan_task(const Params& p, char* smem, int rowbase, int T, int prevrow, int h, int rg,
                          const float* __restrict__ s_in, float* __restrict__ s_out) {
  const int tid = threadIdx.x, wave = tid >> 6, lane = tid & 63, l16 = lane & 15;
  const bool scanner = wave < 2;
  const u16* proj = (const u16*)(p.ws + WS_C);
  const float* dec = (const float*)(p.ws + WS_DEC);
  const u16* ab = (const u16*)(p.ws + WS_A);
  float* yraw = p.out;
  float* bufs = (float*)smem;
  float* yparts = (float*)(smem + 42496);
  float* vkrs = (float*)(smem + 42496 + 16384);
  const int nchunk = (T + 15) >> 4;
  const int il = (wave & 1) * 4 + (lane >> 4), i = rg * 8 + il, j0 = l16 * 4;
  float2v S01 = {0.f, 0.f}, S23 = {0.f, 0.f};
  if (s_in && scanner) {
    float4 s = *(const float4*)(s_in + i * 64 + j0);
    S01 = float2v{s.x, s.y}; S23 = float2v{s.z, s.w};
  }
  const int ptid = tid & 127, cgp = ptid & 15, ttb = ptid >> 4, col = h * 64 + cgp * 4;
  const float4 mu_r = *(const float4*)(p.mu + col), mu_k = *(const float4*)(p.mu + 512 + col),
               mu_v = *(const float4*)(p.mu + 1024 + col);
  const float4 kkw = *(const float4*)(p.k_k + col), kaw = *(const float4*)(p.k_a + col);
  const u16* projc = proj + (size_t)rowbase * NIN + col;
  const float* decc = dec + (size_t)rowbase * 512 + col;
  const u16* abc = ab + (size_t)rowbase * 512 + col;
  const u16* prevp = prevrow >= 0 ? proj + (size_t)prevrow * NIN + col : nullptr;
  auto issue = [&](int c, int tt, ScanRaw& R) {
    int t = c * 16 + tt;
    if (t < T) {
      const size_t ro = (size_t)c * 16 + tt;
      const u16* pr = projc + ro * NIN;
      R.rr = *(const uint2*)(pr);
      R.rk = *(const uint2*)(pr + 512);
      R.rv = *(const uint2*)(pr + 1024);
      const u16* pq = t > 0 ? pr - NIN : prevp;
      if (pq) {
        R.qr = *(const uint2*)(pq);
        R.qk = *(const uint2*)(pq + 512);
        R.qv = *(const uint2*)(pq + 1024);
      } else {
        R.qr = uint2{0, 0}; R.qk = uint2{0, 0}; R.qv = uint2{0, 0};
      }
      R.dc = *(const float4*)(decc + ro * 512);
      R.av = *(const uint2*)(abc + ro * 512);
    }
  };
  auto prep_item = [&](const ScanRaw& R, int tt, float* buf, float* vkr) {
    float xr[4] = {bflo(R.rr.x), bfhi(R.rr.x), bflo(R.rr.y), bfhi(R.rr.y)};
    float xk[4] = {bflo(R.rk.x), bfhi(R.rk.x), bflo(R.rk.y), bfhi(R.rk.y)};
    float xv[4] = {bflo(R.rv.x), bfhi(R.rv.x), bflo(R.rv.y), bfhi(R.rv.y)};
    float pr_[4] = {bflo(R.qr.x), bfhi(R.qr.x), bflo(R.qr.y), bfhi(R.qr.y)};
    float pk_[4] = {bflo(R.qk.x), bfhi(R.qk.x), bflo(R.qk.y), bfhi(R.qk.y)};
    float pv_[4] = {bflo(R.qv.x), bfhi(R.qv.x), bflo(R.qv.y), bfhi(R.qv.y)};
    float aa[4] = {bflo(R.av.x), bfhi(R.av.x), bflo(R.av.y), bfhi(R.av.y)};
    float dcv[4] = {R.dc.x, R.dc.y, R.dc.z, R.dc.w};
    float mur[4] = {mu_r.x, mu_r.y, mu_r.z, mu_r.w}, muk[4] = {mu_k.x, mu_k.y, mu_k.z, mu_k.w},
          muv[4] = {mu_v.x, mu_v.y, mu_v.z, mu_v.w};
    float kw[4] = {kkw.x, kkw.y, kkw.z, kkw.w}, ka[4] = {kaw.x, kaw.y, kaw.z, kaw.w};
    float kkv[4], ss = 0.f;
#pragma unroll
    for (int e = 0; e < 4; ++e) {
      xr[e] = xr[e] + (pr_[e] - xr[e]) * mur[e];
      xk[e] = xk[e] + (pk_[e] - xk[e]) * muk[e];
      xv[e] = xv[e] + (pv_[e] - xv[e]) * muv[e];
      kkv[e] = xk[e] * kw[e];
      ss += kkv[e] * kkv[e];
    }
    ss = red16(ss);
    float inv = __builtin_amdgcn_rsqf(fmaxf(ss, 1e-24f));
    float nk[4], kb[4], km[4];
    float brs = 0.f, krs = 0.f;
#pragma unroll
    for (int e = 0; e < 4; ++e) {
      float kk = kkv[e] * inv;
      nk[e] = -kk;
      kb[e] = kk * aa[e];
      km[e] = xk[e] * (1.f + (aa[e] - 1.f) * ka[e]);
      brs += kb[e] * xr[e];
      krs += km[e] * xr[e];
    }
    brs = red16(brs);
    krs = red16(krs);
    float* bt = buf + tt * SC_TOK + cgp * 4;
    *(float4*)(bt) = float4{xr[0] * dcv[0] + brs * nk[0], xr[1] * dcv[1] + brs * nk[1], xr[2] * dcv[2] + brs * nk[2],
                            xr[3] * dcv[3] + brs * nk[3]};
    *(float4*)(bt + 64) = R.dc;
    *(float4*)(bt + 128) = float4{km[0], km[1], km[2], km[3]};
    *(float4*)(bt + 192) = float4{nk[0], nk[1], nk[2], nk[3]};
    *(float4*)(bt + 256) = float4{kb[0], kb[1], kb[2], kb[3]};
    if ((cgp >> 1) == rg) {
      *(float4*)(buf + tt * SC_TOK + 320 + (cgp & 1) * 4) = float4{xv[0], xv[1], xv[2], xv[3]};
      *(float4*)(vkr + tt * 8 + (cgp & 1) * 4) = float4{xv[0] * krs, xv[1] * krs, xv[2] * krs, xv[3] * krs};
    }
  };
  auto yreduce = [&](int c) {
    const int tt = ptid >> 3, row = ptid & 7;
    const float4* yp = (const float4*)(yparts + (c & 1) * 2048 + ptid * 16);
    float4 a = yp[0], b = yp[1], c4 = yp[2], d = yp[3];
    float y = ((a.x + a.y) + (a.z + a.w)) + ((b.x + b.y) + (b.z + b.w)) + ((c4.x + c4.y) + (c4.z + c4.w)) +
              ((d.x + d.y) + (d.z + d.w)) + vkrs[(c % 3) * 128 + ptid];
    int t = c * 16 + tt;
    if (t < T) yraw[(size_t)(rowbase + t) * 512 + h * 64 + rg * 8 + row] = y;
  };
  ScanRaw R0, R1;
  R0.rr = R0.rk = R0.rv = R0.qr = R0.qk = R0.qv = R0.av = uint2{0, 0}; R0.dc = float4{0, 0, 0, 0};
  R1 = R0;
  if (!scanner) {
    issue(0, ttb, R0);
    issue(0, ttb + 8, R1);
    prep_item(R0, ttb, bufs, vkrs);
    prep_item(R1, ttb + 8, bufs, vkrs);
    if (nchunk > 1) { issue(1, ttb, R0); issue(1, ttb + 8, R1); }
  }
  __syncthreads();
  for (int c = 0; c < nchunk; ++c) {
    if (scanner) {
      const float* buf = bufs + (c & 1) * (16 * SC_TOK);
      float* ypart = yparts + (c & 1) * 2048;
      const int ntok = min(16, T - c * 16);
      const float* bt0 = buf + j0;
      float4 r4 = *(const float4*)(bt0), w4 = *(const float4*)(bt0 + 64), k4 = *(const float4*)(bt0 + 128),
             a4 = *(const float4*)(bt0 + 192), b4 = *(const float4*)(bt0 + 256);
      float vi = buf[320 + il];
      for (int t2 = 0; t2 < ntok; ++t2) {
        int tn = min(t2 + 1, ntok - 1);
        const float* bn = buf + tn * SC_TOK + j0;
        float4 rn = *(const float4*)(bn), wn = *(const float4*)(bn + 64), kn = *(const float4*)(bn + 128),
               an = *(const float4*)(bn + 192), bnn = *(const float4*)(bn + 256);
        float vn = buf[tn * SC_TOK + 320 + il];
        float2v sa2 = S01 * float2v{a4.x, a4.y} + S23 * float2v{a4.z, a4.w};
        float2v q2 = S01 * float2v{r4.x, r4.y} + S23 * float2v{r4.z, r4.w};
        float2v vv = float2v{vi, vi};
        float2v t01 = S01 * float2v{w4.x, w4.y} + vv * float2v{k4.x, k4.y};
        float2v t23 = S23 * float2v{w4.z, w4.w} + vv * float2v{k4.z, k4.w};
        float sa = red16(sa2.x + sa2.y);
        float2v sv = float2v{sa, sa};
        S01 = t01 + sv * float2v{b4.x, b4.y};
        S23 = t23 + sv * float2v{b4.z, b4.w};
        ypart[t2 * 128 + (tid & 127)] = q2.x + q2.y;
        r4 = rn; w4 = wn; k4 = kn; a4 = an; b4 = bnn; vi = vn;
      }
    } else {
      if (c > 0) yreduce(c - 1);
      if (c + 1 < nchunk) {
        float* nb = bufs + ((c + 1) & 1) * (16 * SC_TOK);
        float* nv = vkrs + ((c + 1) % 3) * 128;
        prep_item(R0, ttb, nb, nv);
        prep_item(R1, ttb + 8, nb, nv);
        if (c + 2 < nchunk) { issue(c + 2, ttb, R0); issue(c + 2, ttb + 8, R1); }
      }
    }
    __syncthreads();
  }
  if (scanner) *(float4*)(s_out + i * 64 + j0) = float4{S01.x, S01.y, S23.x, S23.y};
  else yreduce(nchunk - 1);
  __syncthreads();
}

__device__ void attn_prompt_task(const Params& p, char* smem, int task) {
  const int tid = threadIdx.x, w = tid >> 6, lane = tid & 63, fr = lane & 15, fq = lane >> 4;
  int head = task & 7;
  int qt = (task >> 3) % 65;
  int b = task / (8 * 65);
  int kvh = head >> 2;
  u16* KV = (u16*)smem;
  u16* Ps = (u16*)(smem + 9216) + w * 16 * 200;
  const u16* projb = (const u16*)(p.ws + WS_C) + (size_t)b * LP * NIN;
  u16* mix = (u16*)(p.ws + WS_B);
  int q0 = qt * 64, kstart = q0 - 128;
  int qrow = min(q0 + w * 16 + fr, LP - 1);
  bf16x8 qa[2];
#pragma unroll
  for (int ks = 0; ks < 2; ++ks)
    qa[ks] = *(const bf16x8*)(projb + (size_t)qrow * NIN + 1792 + head * 64 + ks * 32 + fq * 8);
  f32x4 S[12];
#pragma unroll
  for (int i = 0; i < 12; ++i) S[i] = f32x4{0.f, 0.f, 0.f, 0.f};
#pragma unroll
  for (int kt = 0; kt < 3; ++kt) {
    {
      int key = tid >> 2, ch = tid & 3;
      int kp = min(max(kstart + kt * 64 + key, 0), LP - 1);
      const uint4* src = (const uint4*)(projb + (size_t)kp * NIN + 2304 + kvh * 64 + ch * 16);
      uint4 v0 = src[0], v1 = src[1];
      *(uint4*)(KV + key * 72 + ch * 16) = v0;
      *(uint4*)(KV + key * 72 + ch * 16 + 8) = v1;
    }
    __syncthreads();
#pragma unroll
    for (int n = 0; n < 4; ++n)
#pragma unroll
      for (int ks = 0; ks < 2; ++ks) {
        bf16x8 kb = *(const bf16x8*)(KV + (n * 16 + fr) * 72 + ks * 32 + fq * 8);
        S[kt * 4 + n] = mfma16(qa[ks], kb, S[kt * 4 + n]);
      }
    __syncthreads();
  }
  float sink = p.sinks[head];
#pragma unroll
  for (int j = 0; j < 4; ++j) {
    int qpos = q0 + w * 16 + fq * 4 + j;
    float mx = -1e30f;
#pragma unroll
    for (int T = 0; T < 12; ++T) {
      int kpos = kstart + T * 16 + fr;
      bool valid = (kpos >= 0) && (kpos <= qpos) && (qpos - kpos < 128);
      float s = valid ? S[T][j] * 0.125f : -1e30f;
      S[T][j] = s;
      mx = fmaxf(mx, s);
    }
    mx = redmax16(mx);
    mx = fmaxf(mx, sink);
    float sum = 0.f;
#pragma unroll
    for (int T = 0; T < 12; ++T) {
      float e = (S[T][j] > -1e29f) ? __expf(S[T][j] - mx) : 0.f;
      S[T][j] = e;
      sum += e;
    }
    sum = red16(sum) + __expf(sink - mx);
    float inv = 1.f / sum;
#pragma unroll
    for (int T = 0; T < 12; ++T) Ps[(fq * 4 + j) * 200 + T * 16 + fr] = f2bf(S[T][j] * inv);
  }
  f32x4 O[4];
#pragma unroll
  for (int i = 0; i < 4; ++i) O[i] = f32x4{0.f, 0.f, 0.f, 0.f};
#pragma unroll
  for (int kt = 0; kt < 3; ++kt) {
    {
      int key = tid >> 2, ch = tid & 3;
      int kp = min(max(kstart + kt * 64 + key, 0), LP - 1);
      const uint4* src = (const uint4*)(projb + (size_t)kp * NIN + 2432 + kvh * 64 + ch * 16);
      uint4 v0 = src[0], v1 = src[1];
      unsigned e[8] = {v0.x, v0.y, v0.z, v0.w, v1.x, v1.y, v1.z, v1.w};
#pragma unroll
      for (int i = 0; i < 8; ++i) {
        KV[(ch * 16 + 2 * i) * 72 + key] = (u16)(e[i] & 0xffffu);
        KV[(ch * 16 + 2 * i + 1) * 72 + key] = (u16)(e[i] >> 16);
      }
    }
    __syncthreads();
#pragma unroll
    for (int ks = 0; ks < 2; ++ks) {
      bf16x8 pa = *(const bf16x8*)(Ps + fr * 200 + kt * 64 + ks * 32 + fq * 8);
#pragma unroll
      for (int n = 0; n < 4; ++n) {
        bf16x8 vb = *(const bf16x8*)(KV + (n * 16 + fr) * 72 + ks * 32 + fq * 8);
        O[n] = mfma16(pa, vb, O[n]);
      }
    }
    __syncthreads();
  }
#pragma unroll
  for (int n = 0; n < 4; ++n)
#pragma unroll
    for (int j = 0; j < 4; ++j) {
      int q = q0 + w * 16 + fq * 4 + j;
      if (q < LP) mix[((size_t)(b * LP + q)) * 1024 + 512 + head * 64 + n * 16 + fr] = f2bf(O[n][j]);
    }
}

__device__ void attn_sample_task(const Params& p, char* smem, int task) {
  const int tid = threadIdx.x;
  int b = task >> 1, kvh = task & 1;
  const u16* proj = (const u16*)(p.ws + WS_C);
  u16* mix = (u16*)(p.ws + WS_B);
  float* Qs = (float*)smem;
  float* Sc = Qs + 1024;
  {
    int qr = tid >> 4, d4 = (tid & 15) * 4, g = qr >> 2, s = qr & 3;
    const u16* src = proj + (size_t)(TP + b * 4 + s) * NIN + 1792 + (kvh * 4 + g) * 64 + d4;
    uint2 v = *(const uint2*)src;
    *(float4*)(Qs + qr * 64 + d4) = float4{bflo(v.x) * 0.125f, bfhi(v.x) * 0.125f, bflo(v.y) * 0.125f, bfhi(v.y) * 0.125f};
  }
  __syncthreads();
  for (int idx = tid; idx < 132 * 16; idx += 256) {
    int kj = idx >> 4, qr = idx & 15, s = qr & 3;
    bool valid = (kj < 128) ? (kj > s) : (kj - 128 <= s);
    float acc = 0.f;
    const float* q = Qs + qr * 64;
    if (kj < 128) {
      const float4* kr = (const float4*)(p.cache_k + (((size_t)b * 128 + kj) * 2 + kvh) * 64);
#pragma unroll
      for (int d = 0; d < 16; ++d) {
        float4 kv = kr[d];
        acc += kv.x * q[d * 4] + kv.y * q[d * 4 + 1] + kv.z * q[d * 4 + 2] + kv.w * q[d * 4 + 3];
      }
    } else {
      const uint2* kr = (const uint2*)(proj + (size_t)(TP + b * 4 + kj - 128) * NIN + 2304 + kvh * 64);
#pragma unroll
      for (int d = 0; d < 16; ++d) {
        uint2 kv = kr[d];
        acc += bflo(kv.x) * q[d * 4] + bfhi(kv.x) * q[d * 4 + 1] + bflo(kv.y) * q[d * 4 + 2] + bfhi(kv.y) * q[d * 4 + 3];
      }
    }
    Sc[qr * 136 + kj] = valid ? acc : -1e30f;
  }
  __syncthreads();
  {
    int qr = tid >> 4, l = tid & 15, g = qr >> 2;
    float sink = p.sinks[kvh * 4 + g];
    float mx = -1e30f;
    for (int kj = l; kj < 132; kj += 16) mx = fmaxf(mx, Sc[qr * 136 + kj]);
    mx = redmax16(mx);
    mx = fmaxf(mx, sink);
    float sum = 0.f;
    for (int kj = l; kj < 132; kj += 16) {
      float s = Sc[qr * 136 + kj];
      float e = (s > -1e29f) ? __expf(s - mx) : 0.f;
      Sc[qr * 136 + kj] = e;
      sum += e;
    }
    sum = red16(sum) + __expf(sink - mx);
    float inv = 1.f / sum;
    for (int kj = l; kj < 132; kj += 16) Sc[qr * 136 + kj] *= inv;
  }
  __syncthreads();
  {
    int qr = tid >> 4, d4 = (tid & 15) * 4, g = qr >> 2, s = qr & 3;
    float4 o = {0.f, 0.f, 0.f, 0.f};
    for (int kj = 0; kj < 128; ++kj) {
      float pw = Sc[qr * 136 + kj];
      float4 v = *(const float4*)(p.cache_v + (((size_t)b * 128 + kj) * 2 + kvh) * 64 + d4);
      o.x += pw * v.x; o.y += pw * v.y; o.z += pw * v.z; o.w += pw * v.w;
    }
    for (int kj = 128; kj < 132; ++kj) {
      float pw = Sc[qr * 136 + kj];
      uint2 v = *(const uint2*)(proj + (size_t)(TP + b * 4 + kj - 128) * NIN + 2432 + kvh * 64 + d4);
      o.x += pw * bflo(v.x); o.y += pw * bfhi(v.x); o.z += pw * bflo(v.y); o.w += pw * bfhi(v.y);
    }
    *(uint2*)(mix + (size_t)(TP + b * 4 + s) * 1024 + 512 + (kvh * 4 + g) * 64 + d4) =
        uint2{pack2bf(o.x, o.y), pack2bf(o.z, o.w)};
  }
  __syncthreads();
}

__device__ void phase4(const Params& p, char* smem) {
  constexpr int N_PS = 256, N_SS = 8192, N_AP = NB * 65 * 8, N_AS = 256;
  constexpr int N_CV = 32768 / 4, T_WOUT = 16 * 16, T_WQ = 16 * 32;
  int first, stride;
  if (gridDim.x >= 2 * N_PS) {
    if ((int)blockIdx.x < N_PS) {
      int t = blockIdx.x;
      int seq = t >> 3, rg = t & 7, b = seq >> 3, h = seq & 7;
      scan_task(p, smem, b * LP, LP, -1, h, rg, nullptr, p.out + O_WKVP + (size_t)seq * 4096);
      return;
    }
    first = N_PS + (blockIdx.x - N_PS);
    stride = gridDim.x - N_PS;
  } else {
    first = blockIdx.x;
    stride = gridDim.x;
  }
  for (int task = first; task < N_PS + N_SS + N_AP + N_AS + N_CV + T_WOUT + T_WQ; task += stride) {
    int t = task;
    if (t < N_PS) {
      int seq = t >> 3, rg = t & 7, b = seq >> 3, h = seq & 7;
      scan_task(p, smem, b * LP, LP, -1, h, rg, nullptr, p.out + O_WKVP + (size_t)seq * 4096);
      continue;
    }
    t -= N_PS;
    if (t < N_SS) {
      int seq = t >> 3, rg = t & 7, b = seq >> 3, h = seq & 7;
      scan_task(p, smem, TP + b * 4, 4, PREV0 + b, h, rg, p.state_wkv + (size_t)seq * 4096,
                p.out + O_WKVS + (size_t)seq * 4096);
      continue;
    }
    t -= N_SS;
    if (t < N_AP) { attn_prompt_task(p, smem, t); continue; }
    t -= N_AP;
    if (t < N_AS) { attn_sample_task(p, smem, t); continue; }
    t -= N_AS;
    if (t < N_CV) { convert_task(p, t); continue; }
    t -= N_CV;
    if (t < T_WOUT) { transpose_task(p.w_out, 1024, 1024, (u16*)(p.ws + WS_WOUT), t, smem); continue; }
    t -= T_WOUT;
    transpose_task(p.w_query, 1024, 2048, (u16*)(p.ws + WS_WQ), t, smem, p.norm2_g);
  }
}

struct PostC { float mu[3][8], ka[8], rk[8], lw[8], lb[8]; };

__device__ __forceinline__ void post_task(const Params& p, int task, const PostC& C) {
  const int wave = threadIdx.x >> 6, lane = threadIdx.x & 63;
  int row = task * 4 + wave;
  if (row >= TTOK) return;
  const u16* proj = (const u16*)(p.ws + WS_C);
  const float* yraw = p.out;
  const u16* ab = (const u16*)(p.ws + WS_A);
  const u16* gb = (const u16*)(p.ws + WS_G);
  u16* mix = (u16*)(p.ws + WS_B);
  int prow;
  if (row < TP) { int t = row % LP; prow = t > 0 ? row - 1 : -1; }
  else { int r = row - TP; prow = (r & 3) ? row - 1 : PREV0 + (r >> 2); }
  int c0 = lane * 8;
  float y[8];
  {
    float4 a = *(const float4*)(yraw + (size_t)row * 512 + c0), bq = *(const float4*)(yraw + (size_t)row * 512 + c0 + 4);
    y[0] = a.x; y[1] = a.y; y[2] = a.z; y[3] = a.w; y[4] = bq.x; y[5] = bq.y; y[6] = bq.z; y[7] = bq.w;
  }
  float s = 0.f;
#pragma unroll
  for (int e = 0; e < 8; ++e) s += y[e];
  float mean = red8(s) * (1.f / 64.f);
  float vs = 0.f;
#pragma unroll
  for (int e = 0; e < 8; ++e) { float d = y[e] - mean; vs += d * d; }
  float rstd = rsqrtf(red8(vs) * (1.f / 64.f) + 64e-5f);
  float xr[8], xk[8], xv[8];
  auto ld8 = [&](int coff, int mi, float* o) {
    uint4 a = *(const uint4*)(proj + (size_t)row * NIN + coff + c0);
    uint4 q = prow >= 0 ? *(const uint4*)(proj + (size_t)prow * NIN + coff + c0) : uint4{0, 0, 0, 0};
    unsigned ua[4] = {a.x, a.y, a.z, a.w}, uq[4] = {q.x, q.y, q.z, q.w};
#pragma unroll
    for (int e = 0; e < 4; ++e) {
      float x0 = bflo(ua[e]), x1 = bfhi(ua[e]), p0 = bflo(uq[e]), p1 = bfhi(uq[e]);
      float m0 = C.mu[mi][2 * e], m1 = C.mu[mi][2 * e + 1];
      o[2 * e] = x0 + (p0 - x0) * m0;
      o[2 * e + 1] = x1 + (p1 - x1) * m1;
    }
  };
  ld8(0, 0, xr);
  ld8(512, 1, xk);
  ld8(1024, 2, xv);
  float aa[8], gg[8];
  {
    uint4 a = *(const uint4*)(ab + (size_t)row * 512 + c0), g = *(const uint4*)(gb + (size_t)row * 512 + c0);
    unsigned ua[4] = {a.x, a.y, a.z, a.w}, ug[4] = {g.x, g.y, g.z, g.w};
#pragma unroll
    for (int e = 0; e < 4; ++e) {
      aa[2 * e] = bflo(ua[e]); aa[2 * e + 1] = bfhi(ua[e]);
      gg[2 * e] = bflo(ug[e]); gg[2 * e + 1] = bfhi(ug[e]);
    }
  }
  float bs = 0.f;
#pragma unroll
  for (int e = 0; e < 8; ++e) {
    float km = xk[e] * (1.f + (aa[e] - 1.f) * C.ka[e]);
    bs += xr[e] * km * C.rk[e];
  }
  bs = red8(bs);
  unsigned o[4];
#pragma unroll
  for (int e = 0; e < 4; ++e) {
    float v0 = ((y[2 * e] - mean) * rstd * C.lw[2 * e] + C.lb[2 * e] + bs * xv[2 * e]) * gg[2 * e];
    float v1 = ((y[2 * e + 1] - mean) * rstd * C.lw[2 * e + 1] + C.lb[2 * e + 1] + bs * xv[2 * e + 1]) * gg[2 * e + 1];
    o[e] = pack2bf(v0, v1);
  }
  *(uint4*)(mix + (size_t)row * 1024 + c0) = uint4{o[0], o[1], o[2], o[3]};
}

__device__ void phase5(const Params& p) {
  const int lane = threadIdx.x & 63, c0 = lane * 8;
  PostC C;
  auto ld = [&](const float* src, float* dst) {
    float4 a = *(const float4*)(src + c0), b = *(const float4*)(src + c0 + 4);
    dst[0] = a.x; dst[1] = a.y; dst[2] = a.z; dst[3] = a.w; dst[4] = b.x; dst[5] = b.y; dst[6] = b.z; dst[7] = b.w;
  };
  ld(p.mu, C.mu[0]); ld(p.mu + 512, C.mu[1]); ld(p.mu + 1024, C.mu[2]);
  ld(p.k_a, C.ka); ld(p.r_k, C.rk); ld(p.lnx_w, C.lw); ld(p.lnx_b, C.lb);
  for (int task = blockIdx.x; task < TTOK / 4; task += gridDim.x) post_task(p, task, C);
}

__device__ void phase6(const Params& p, char* smem) {
  const u16* mix = (const u16*)(p.ws + WS_B);
  const u16* wt = (const u16*)(p.ws + WS_WOUT);
  constexpr int MT = NOUT / 128, NT = 8;
  constexpr int N_CV = 0;
  const int wave = threadIdx.x >> 6, lane = threadIdx.x & 63;
  for (int task = xcd_vid(); task < MT * NT + N_CV; task += gridDim.x) {
    if (task < MT * NT) {
      int mt, nt;
      grouped_tile(task, MT, NT, mt, nt);
      int o0 = mt * 128;
      int arow = o0 + (o0 < 16384 ? 16 * (o0 / 4096 + 1) : 64);
      const float* xin = (o0 < 16384 ? p.x_prompt + (size_t)o0 * D : p.x_sample + (size_t)(o0 - 16384) * D) + nt * 128;
      float* xo = p.out + (size_t)o0 * D + nt * 128;
      u16* xb = (u16*)(p.ws + WS_X1B) + (size_t)o0 * D + nt * 128;
      float rs[4] = {0.f, 0.f, 0.f, 0.f};
      gemm_tile(mix + (size_t)arow * 1024, 1024, wt + (size_t)nt * 128 * 1024, 1024, 1024, smem,
                [&](int m, int r, int c, f32x4 v) {
                  float4 xi = *(const float4*)(xin + (size_t)r * D + c);
                  float4 xv = float4{xi.x + v[0], xi.y + v[1], xi.z + v[2], xi.w + v[3]};
                  *(float4*)(xo + (size_t)r * D + c) = xv;
                  *(uint2*)(xb + (size_t)r * D + c) = uint2{pack2bf(xv.x, xv.y), pack2bf(xv.z, xv.w)};
                  rs[m] += xv.x * xv.x + xv.y * xv.y + xv.z * xv.z + xv.w * xv.w;
                });
      {
        const int lane_ = threadIdx.x & 63, wid_ = threadIdx.x >> 6, wr_ = wid_ >> 1, wc_ = wid_ & 1;
        float* ssq = (float*)(p.ws + WS_SSQ);
#pragma unroll
        for (int m = 0; m < 4; ++m) {
          float t = rs[m];
          t += __shfl_xor(t, 16, 64);
          t += __shfl_xor(t, 32, 64);
          if ((lane_ >> 4) == 0) ssq[(size_t)(o0 + wr_ * 64 + m * 16 + (lane_ & 15)) * 16 + nt * 2 + wc_] = t;
        }
      }
    }
  }
}

__device__ void phase8(const Params& p, char* smem) {
  const u16* xb = (const u16*)(p.ws + WS_X1B);
  const u16* wt = (const u16*)(p.ws + WS_WQ);
  const float* ssq = (const float*)(p.ws + WS_SSQ);
  u16* q = (u16*)(p.ws + WS_Q);
  constexpr int MT = NOUT / 128, NT = 16, TOT = MT * NT;
  const int lane = threadIdx.x & 63, wr = (threadIdx.x >> 6) >> 1, fr = lane & 15;
  const int G = gridDim.x, full = p.full8, ntask = full + 4 * (TOT - full);
  auto row_rstd = [&](size_t row) {
    const float4* sp = (const float4*)(ssq + row * 16);
    float4 a = sp[0], b = sp[1], c = sp[2], d = sp[3];
    float ss = ((a.x + a.y) + (a.z + a.w)) + ((b.x + b.y) + (b.z + b.w)) + ((c.x + c.y) + (c.z + c.w)) + ((d.x + d.y) + (d.z + d.w));
    return rsqrtf(ss * (1.f / 1024.f) + 1e-5f);
  };
  for (int task = xcd_vid(); task < ntask; task += G) {
    int mt, nt;
    if (task < full) {
      grouped_tile(task, MT, NT, mt, nt);
      u16* crow = q + (size_t)mt * 128 * 2048 + nt * 128;
      float rstd[4];
#pragma unroll
      for (int m = 0; m < 4; ++m) rstd[m] = row_rstd((size_t)mt * 128 + wr * 64 + m * 16 + fr);
      gemm_tile(xb + (size_t)mt * 128 * D, D, wt + (size_t)nt * 128 * D, D, D, smem,
                [&](int m, int r, int c, f32x4 v) {
                  float sc = rstd[m];
                  *(uint2*)(crow + (size_t)r * 2048 + c) = uint2{pack2bf(v[0] * sc, v[1] * sc), pack2bf(v[2] * sc, v[3] * sc)};
                });
    } else {
      int rem = task - full, qd = rem & 3;
      grouped_tile(full + (rem >> 2), MT, NT, mt, nt);
      size_t r0 = (size_t)mt * 128 + qd * 32;
      u16* crow = q + r0 * 2048 + nt * 128;
      float rstd[2];
#pragma unroll
      for (int m = 0; m < 2; ++m) rstd[m] = row_rstd(r0 + m * 16 + fr);
      gemm_qtile(xb + r0 * D, D, wt + (size_t)nt * 128 * D, D, D, smem,
                 [&](int m, int r, int c, f32x4 v) {
                   float sc = rstd[m];
                   *(uint2*)(crow + (size_t)r * 2048 + c) = uint2{pack2bf(v[0] * sc, v[1] * sc), pack2bf(v[2] * sc, v[3] * sc)};
                 });
    }
  }
}

__device__ __forceinline__ unsigned ford(float f) {
  unsigned u = __float_as_uint(f);
  return (u & 0x80000000u) ? ~u : (u | 0x80000000u);
}
__device__ __forceinline__ float fdeord(unsigned k) {
  unsigned u = (k & 0x80000000u) ? (k & 0x7fffffffu) : ~k;
  return __uint_as_float(u);
}
__device__ __forceinline__ unsigned umax_(unsigned a, unsigned b) { return a > b ? a : b; }
__device__ __forceinline__ unsigned umin_(unsigned a, unsigned b) { return a < b ? a : b; }

#define CE_DESC(a, b) { unsigned _x = umax_(a, b), _y = umin_(a, b); a = _x; b = _y; }
#define CE_ASC(a, b) { unsigned _x = umin_(a, b), _y = umax_(a, b); a = _x; b = _y; }

template <int N>
__device__ __forceinline__ void bitonic_sort_desc(unsigned (&k)[N]) {
#pragma unroll
  for (int sz = 2; sz <= N; sz <<= 1) {
#pragma unroll
    for (int st = sz >> 1; st > 0; st >>= 1) {
#pragma unroll
      for (int i = 0; i < N; ++i) {
        int l = i ^ st;
        if (l > i) {
          if ((i & sz) == 0) CE_DESC(k[i], k[l]) else CE_ASC(k[i], k[l])
        }
      }
    }
  }
}
template <int N>
__device__ __forceinline__ void bitonic_merge_desc(unsigned (&k)[N]) {
#pragma unroll
  for (int st = N >> 1; st > 0; st >>= 1) {
#pragma unroll
    for (int i = 0; i < N; ++i) {
      int l = i ^ st;
      if (l > i) CE_DESC(k[i], k[l])
    }
  }
}
__device__ __forceinline__ void cross_merge16(unsigned (&k)[16]) {
#pragma unroll
  for (int x = 16; x <= 32; x <<= 1) {
    unsigned o[16];
#pragma unroll
    for (int i = 0; i < 16; ++i) o[i] = (unsigned)__shfl_xor((int)k[i], x, 64);
#pragma unroll
    for (int i = 0; i < 16; ++i) k[i] = umax_(k[i], o[15 - i]);
    bitonic_merge_desc<16>(k);
  }
}

__device__ __forceinline__ unsigned sel16(const unsigned (&a)[16], int k) {
  unsigned r = a[0];
#pragma unroll
  for (int i = 1; i < 16; ++i) r = (k == i) ? a[i] : r;
  return r;
}

__device__ void topk_unit(const Params& p, const char* smem, int tg, int h) {
  const int tid = threadIdx.x, lane = tid & 63, fr = lane & 15, fq = lane >> 4;
  const u16* q = (const u16*)(p.ws + WS_Q);
  int* idxo = (int*)(p.ws + WS_IDX);
  float* gateo = (float*)(p.ws + WS_GATE);
  const int o0 = tg * 16;
  float v1[16], v2[16];
  unsigned pk1[4] = {0u, 0u, 0u, 0u}, pk2[4] = {0u, 0u, 0u, 0u};
#pragma unroll
  for (int c = 0; c < 2; ++c) {
    bf16x8 qb[4];
#pragma unroll
    for (int ks = 0; ks < 4; ++ks)
      qb[ks] = *(const bf16x8*)(q + (size_t)(o0 + fr) * 2048 + (h * 2 + c) * 128 + ks * 32 + fq * 8);
    f32x4 acc[8];
#pragma unroll
    for (int i = 0; i < 8; ++i) acc[i] = f32x4{0.f, 0.f, 0.f, 0.f};
#pragma unroll
    for (int ks = 0; ks < 4; ++ks) {
#pragma unroll
      for (int mt = 0; mt < 8; ++mt) {
        bf16x8 ka = *(const bf16x8*)(smem + (c * 128 + mt * 16 + fr) * 256 + (((ks * 4 + fq) ^ fr) << 4));
        acc[mt] = mfma16(ka, qb[ks], acc[mt]);
      }
      __builtin_amdgcn_sched_barrier(0);
    }
    unsigned lo[16], hi[16];
#pragma unroll
    for (int mt = 0; mt < 4; ++mt)
#pragma unroll
      for (int j = 0; j < 4; ++j) {
        lo[mt * 4 + j] = (ford(acc[mt][j]) & 0xffffff80u) | (unsigned)(127 - (mt * 16 + fq * 4 + j));
        hi[mt * 4 + j] = (ford(acc[mt + 4][j]) & 0xffffff80u) | (unsigned)(127 - ((mt + 4) * 16 + fq * 4 + j));
      }
    bitonic_sort_desc<16>(lo);
    bitonic_sort_desc<16>(hi);
#pragma unroll
    for (int i = 0; i < 16; ++i) lo[i] = umax_(lo[i], hi[15 - i]);
    bitonic_merge_desc<16>(lo);
    cross_merge16(lo);
#pragma unroll
    for (int i = 0; i < 16; ++i) {
      float val = fdeord(lo[i] & 0xffffff80u);
      unsigned ix = (127u - (lo[i] & 0x7fu)) << ((i & 3) * 8);
      if (c == 0) { v1[i] = val; pk1[i >> 2] |= ix; } else { v2[i] = val; pk2[i >> 2] |= ix; }
    }
  }
  unsigned ck[16];
#define CAND(i, j) ((ford(v1[i] + v2[j]) & 0xffffff00u) | (unsigned)((i) * 16 + (j)))
#define SEL4(slot, A, B, C, Dv) ck[slot] = (fq == 0) ? (A) : (fq == 1) ? (B) : (fq == 2) ? (C) : (Dv);
  SEL4(0, CAND(0, 0), CAND(1, 0), CAND(3, 3), CAND(14, 0))
  SEL4(1, CAND(0, 1), CAND(1, 1), CAND(4, 0), CAND(15, 0))
  SEL4(2, CAND(0, 2), CAND(1, 2), CAND(4, 1), 0u)
  SEL4(3, CAND(0, 3), CAND(1, 3), CAND(4, 2), 0u)
  SEL4(4, CAND(0, 4), CAND(1, 4), CAND(5, 0), 0u)
  SEL4(5, CAND(0, 5), CAND(1, 5), CAND(5, 1), 0u)
  SEL4(6, CAND(0, 6), CAND(1, 6), CAND(6, 0), 0u)
  SEL4(7, CAND(0, 7), CAND(1, 7), CAND(6, 1), 0u)
  SEL4(8, CAND(0, 8), CAND(2, 0), CAND(7, 0), 0u)
  SEL4(9, CAND(0, 9), CAND(2, 1), CAND(7, 1), 0u)
  SEL4(10, CAND(0, 10), CAND(2, 2), CAND(8, 0), 0u)
  SEL4(11, CAND(0, 11), CAND(2, 3), CAND(9, 0), 0u)
  SEL4(12, CAND(0, 12), CAND(2, 4), CAND(10, 0), 0u)
  SEL4(13, CAND(0, 13), CAND(3, 0), CAND(11, 0), 0u)
  SEL4(14, CAND(0, 14), CAND(3, 1), CAND(12, 0), 0u)
  SEL4(15, CAND(0, 15), CAND(3, 2), CAND(13, 0), 0u)
#undef SEL4
#undef CAND
  bitonic_sort_desc<16>(ck);
  cross_merge16(ck);
  float top[16], esum = 0.f;
#pragma unroll
  for (int i = 0; i < 16; ++i) top[i] = fdeord(ck[i] & 0xffffff00u);
  const float tmax = top[0];
#pragma unroll
  for (int i = 0; i < 16; ++i) top[i] = __expf(top[i] - tmax);
#pragma unroll
  for (int i = 0; i < 16; ++i) esum += top[i];
  float inv = 1.f / esum;
  int oi[4];
  float og[4];
#pragma unroll
  for (int jj = 0; jj < 4; ++jj) {
    unsigned kk = (fq == 0) ? ck[jj] : (fq == 1) ? ck[4 + jj] : (fq == 2) ? ck[8 + jj] : ck[12 + jj];
    float tv = (fq == 0) ? top[jj] : (fq == 1) ? top[4 + jj] : (fq == 2) ? top[8 + jj] : top[12 + jj];
    int code = (int)(kk & 0xffu);
    int ci = code >> 4, cj = code & 15;
    unsigned d1 = (ci < 8) ? ((ci < 4) ? pk1[0] : pk1[1]) : ((ci < 12) ? pk1[2] : pk1[3]);
    unsigned d2 = (cj < 8) ? ((cj < 4) ? pk2[0] : pk2[1]) : ((cj < 12) ? pk2[2] : pk2[3]);
    int i1 = (int)((d1 >> ((ci & 3) * 8)) & 0xffu), i2 = (int)((d2 >> ((cj & 3) * 8)) & 0xffu);
    oi[jj] = i1 * 128 + i2;
    og[jj] = tv * inv;
  }
  size_t ob = (size_t)(o0 + fr) * 128 + h * 16 + fq * 4;
  *(int4*)(idxo + ob) = int4{oi[0], oi[1], oi[2], oi[3]};
  *(float4*)(gateo + ob) = float4{og[0], og[1], og[2], og[3]};
}

__device__ void phase9(const Params& p, char* smem) {
  const int w = threadIdx.x >> 6;
  {
    const u16* subk = (const u16*)(p.ws + WS_SUBK);
    for (int i = threadIdx.x; i < 4096; i += 256) {
      int row = i >> 4, lc = i & 15;
      *(uint4*)(smem + row * 256 + ((lc ^ (row & 15)) << 4)) = *(const uint4*)(subk + row * 128 + lc * 8);
    }
    __syncthreads();
  }
  for (int task = blockIdx.x; task < (NOUT / 16) * 2; task += gridDim.x) {
    int tg = task >> 1, h = (task & 1) * 4 + w;
    topk_unit(p, smem, tg, h);
  }
  __syncthreads();
}

#define F4(w, b) __builtin_amdgcn_cvt_scalef32_pk_f32_fp4((w), 1.0f, (b))
__device__ __forceinline__ float dot16f8(const float* h, uint2 u, float acc) {
  const float2v* h2 = (const float2v*)h;
  float2v a2 = {acc, 0.f};
  unsigned w[2] = {u.x, u.y};
#pragma unroll
  for (int i = 0; i < 2; ++i) {
    a2 = __builtin_elementwise_fma(h2[4 * i], F4(w[i], 0), a2);
    a2 = __builtin_elementwise_fma(h2[4 * i + 1], F4(w[i], 1), a2);
    a2 = __builtin_elementwise_fma(h2[4 * i + 2], F4(w[i], 2), a2);
    a2 = __builtin_elementwise_fma(h2[4 * i + 3], F4(w[i], 3), a2);
  }
  return a2.x + a2.y;
}
__device__ __forceinline__ void axpy16f8(float a, uint2 v, float* acc) {
  float2v* c2 = (float2v*)acc;
  const float2v aa = {a, a};
  unsigned w[2] = {v.x, v.y};
#pragma unroll
  for (int i = 0; i < 2; ++i) {
    c2[4 * i] = __builtin_elementwise_fma(aa, F4(w[i], 0), c2[4 * i]);
    c2[4 * i + 1] = __builtin_elementwise_fma(aa, F4(w[i], 1), c2[4 * i + 1]);
    c2[4 * i + 2] = __builtin_elementwise_fma(aa, F4(w[i], 2), c2[4 * i + 2]);
    c2[4 * i + 3] = __builtin_elementwise_fma(aa, F4(w[i], 3), c2[4 * i + 3]);
  }
}
__device__ __forceinline__ float reduce4(float d0, float d1, float d2, float d3) {
  auto s1 = __builtin_amdgcn_permlane32_swap(__float_as_uint(d0), __float_as_uint(d1), false, false);
  float s01 = __uint_as_float(s1[0]) + __uint_as_float(s1[1]);
  auto s2 = __builtin_amdgcn_permlane32_swap(__float_as_uint(d2), __float_as_uint(d3), false, false);
  float s23 = __uint_as_float(s2[0]) + __uint_as_float(s2[1]);
  auto s3 = __builtin_amdgcn_permlane16_swap(__float_as_uint(s01), __float_as_uint(s23), false, false);
  float t = __uint_as_float(s3[0]) + __uint_as_float(s3[1]);
  return red16(t);
}

__device__ void gather_task(const Params& p, int task) {
  const int wave = threadIdx.x >> 6, lane = threadIdx.x & 63;
  int o = task * 4 + wave;
  const unsigned char* eu8 = (const unsigned char*)(p.ws + WS_EU) + lane * 8;
  const unsigned char* ev8 = (const unsigned char*)(p.ws + WS_EV) + lane * 8;
  const float* scu = (const float*)(p.ws + WS_SCU);
  const float* scv = (const float*)(p.ws + WS_SCV);
  const int* idx = (const int*)(p.ws + WS_IDX) + (size_t)o * 128;
  const float* gate = (const float*)(p.ws + WS_GATE) + (size_t)o * 128;
  float* xrow = p.out + (size_t)o * D + lane * 16;
  __attribute__((aligned(8))) float hf[16];
  {
    float x[16];
#pragma unroll
    for (int i = 0; i < 4; ++i) {
      float4 a = ((const float4*)xrow)[i];
      x[4 * i] = a.x; x[4 * i + 1] = a.y; x[4 * i + 2] = a.z; x[4 * i + 3] = a.w;
    }
    float ss2 = 0.f;
#pragma unroll
    for (int i = 0; i < 16; ++i) ss2 += x[i] * x[i];
    ss2 = wave_sum(ss2);
    float sc2 = rsqrtf(ss2 * (1.f / 1024.f) + 1e-5f);
    const float* g2 = p.norm2_g + lane * 16;
#pragma unroll
    for (int i = 0; i < 4; ++i) {
      float4 gg = ((const float4*)g2)[i];
      hf[4 * i] = x[4 * i] * sc2 * gg.x; hf[4 * i + 1] = x[4 * i + 1] * sc2 * gg.y;
      hf[4 * i + 2] = x[4 * i + 2] * sc2 * gg.z; hf[4 * i + 3] = x[4 * i + 3] * sc2 * gg.w;
    }
  }
  __attribute__((aligned(8))) float acc[16];
#pragma unroll
  for (int i = 0; i < 16; ++i) acc[i] = 0.f;
  const int rw = lane >> 4;
  const int kl = (lane & 3) * 4 + ((rw == 1) ? 2 : (rw == 2) ? 1 : rw);
  for (int kb = 0; kb < 8; ++kb) {
    int myidx = idx[kb * 16 + (lane & 15)];
    int myidx2 = idx[kb * 16 + kl];
    float mygate = gate[kb * 16 + kl];
    float su = scu[myidx2], sv = scv[myidx2];
    float mypre = 0.f;
#pragma unroll
    for (int e8 = 0; e8 < 2; ++e8) {
      uint2 ua[8];
#pragma unroll
      for (int e = 0; e < 8; ++e) {
        int ei = __builtin_amdgcn_readlane(myidx, e8 * 8 + e);
        ua[e] = *(const uint2*)(eu8 + (size_t)ei * 512);
      }
      float d[8];
#pragma unroll
      for (int e = 0; e < 8; ++e) d[e] = dot16f8(hf, ua[e], 0.f);
      float tot0 = reduce4(d[0], d[1], d[2], d[3]);
      float tot1 = reduce4(d[4], d[5], d[6], d[7]);
      mypre = ((lane & 3) == e8 * 2) ? tot0 : mypre;
      mypre = ((lane & 3) == e8 * 2 + 1) ? tot1 : mypre;
    }
    mypre *= su;
    float myact = 0.5f * mypre * (1.f + erff(mypre * 0.70710678118654752f)) * mygate * sv;
#pragma unroll
    for (int e8 = 0; e8 < 2; ++e8) {
      uint2 va[8];
      float a[8];
#pragma unroll
      for (int e = 0; e < 8; ++e) {
        int ei = __builtin_amdgcn_readlane(myidx, e8 * 8 + e);
        const int e3 = e & 3, e4 = e8 * 2 + (e >> 2);
        const int pr = (e3 == 1) ? 2 : (e3 == 2) ? 1 : e3;
        a[e] = rdlane(myact, pr * 16 + e4);
        va[e] = *(const uint2*)(ev8 + (size_t)ei * 512);
      }
#pragma unroll
      for (int e = 0; e < 8; ++e) axpy16f8(a[e], va[e], acc);
    }
  }
  float x[16];
#pragma unroll
  for (int i = 0; i < 4; ++i) {
    float4 a = ((const float4*)xrow)[i];
    x[4 * i] = a.x; x[4 * i + 1] = a.y; x[4 * i + 2] = a.z; x[4 * i + 3] = a.w;
  }
  float ss = 0.f;
#pragma unroll
  for (int i = 0; i < 16; ++i) { x[i] += acc[i]; ss += x[i] * x[i]; }
  ss = wave_sum(ss);
  float sc = rsqrtf(ss * (1.f / 1024.f) + 1e-5f);
  const float* g = p.final_g + lane * 16;
#pragma unroll
  for (int i = 0; i < 4; ++i) {
    float4 gg = ((const float4*)g)[i];
    ((float4*)xrow)[i] = float4{x[4 * i] * sc * gg.x, x[4 * i + 1] * sc * gg.y, x[4 * i + 2] * sc * gg.z, x[4 * i + 3] * sc * gg.w};
  }
}

__device__ void gather_task_block(const Params& p, char* smem, int o) {
  const int wave = threadIdx.x >> 6, lane = threadIdx.x & 63;
  const unsigned char* eu8 = (const unsigned char*)(p.ws + WS_EU) + lane * 8;
  const unsigned char* ev8 = (const unsigned char*)(p.ws + WS_EV) + lane * 8;
  const float* scu = (const float*)(p.ws + WS_SCU);
  const float* scv = (const float*)(p.ws + WS_SCV);
  const int* idx = (const int*)(p.ws + WS_IDX) + (size_t)o * 128;
  const float* gate = (const float*)(p.ws + WS_GATE) + (size_t)o * 128;
  float* orow = p.out + (size_t)o * D;
  __attribute__((aligned(8))) float hf[16];
  {
    const float* xrow = orow + lane * 16;
    float x[16];
#pragma unroll
    for (int i = 0; i < 4; ++i) {
      float4 a = ((const float4*)xrow)[i];
      x[4 * i] = a.x; x[4 * i + 1] = a.y; x[4 * i + 2] = a.z; x[4 * i + 3] = a.w;
    }
    float ss2 = 0.f;
#pragma unroll
    for (int i = 0; i < 16; ++i) ss2 += x[i] * x[i];
    ss2 = wave_sum(ss2);
    float sc2 = rsqrtf(ss2 * (1.f / 1024.f) + 1e-5f);
    const float* g2 = p.norm2_g + lane * 16;
#pragma unroll
    for (int i = 0; i < 4; ++i) {
      float4 gg = ((const float4*)g2)[i];
      hf[4 * i] = x[4 * i] * sc2 * gg.x; hf[4 * i + 1] = x[4 * i + 1] * sc2 * gg.y;
      hf[4 * i + 2] = x[4 * i + 2] * sc2 * gg.z; hf[4 * i + 3] = x[4 * i + 3] * sc2 * gg.w;
    }
  }
  __attribute__((aligned(8))) float acc[16];
#pragma unroll
  for (int i = 0; i < 16; ++i) acc[i] = 0.f;
  const int rw = lane >> 4;
  const int kl = (lane & 3) * 4 + ((rw == 1) ? 2 : (rw == 2) ? 1 : rw);
#pragma unroll
  for (int kq = 0; kq < 2; ++kq) {
    const int kb = wave * 2 + kq;
    int myidx = idx[kb * 16 + (lane & 15)];
    int myidx2 = idx[kb * 16 + kl];
    float mygate = gate[kb * 16 + kl];
    float su = scu[myidx2], sv = scv[myidx2];
    float mypre = 0.f;
#pragma unroll
    for (int e8 = 0; e8 < 2; ++e8) {
      uint2 ua[8];
#pragma unroll
      for (int e = 0; e < 8; ++e) {
        int ei = __builtin_amdgcn_readlane(myidx, e8 * 8 + e);
        ua[e] = *(const uint2*)(eu8 + (size_t)ei * 512);
      }
      float d[8];
#pragma unroll
      for (int e = 0; e < 8; ++e) d[e] = dot16f8(hf, ua[e], 0.f);
      float tot0 = reduce4(d[0], d[1], d[2], d[3]);
      float tot1 = reduce4(d[4], d[5], d[6], d[7]);
      mypre = ((lane & 3) == e8 * 2) ? tot0 : mypre;
      mypre = ((lane & 3) == e8 * 2 + 1) ? tot1 : mypre;
    }
    mypre *= su;
    float myact = 0.5f * mypre * (1.f + erff(mypre * 0.70710678118654752f)) * mygate * sv;
#pragma unroll
    for (int e8 = 0; e8 < 2; ++e8) {
      uint2 va[8];
      float a[8];
#pragma unroll
      for (int e = 0; e < 8; ++e) {
        int ei = __builtin_amdgcn_readlane(myidx, e8 * 8 + e);
        const int e3 = e & 3, e4 = e8 * 2 + (e >> 2);
        const int pr = (e3 == 1) ? 2 : (e3 == 2) ? 1 : e3;
        a[e] = rdlane(myact, pr * 16 + e4);
        va[e] = *(const uint2*)(ev8 + (size_t)ei * 512);
      }
#pragma unroll
      for (int e = 0; e < 8; ++e) axpy16f8(a[e], va[e], acc);
    }
  }
  float* part = (float*)smem;
  float* red = part + 4096;
#pragma unroll
  for (int i = 0; i < 4; ++i)
    *(float4*)(part + wave * 1024 + lane * 16 + 4 * i) = float4{acc[4 * i], acc[4 * i + 1], acc[4 * i + 2], acc[4 * i + 3]};
  __syncthreads();
  const int c = threadIdx.x * 4;
  float4 xv = *(const float4*)(orow + c);
#pragma unroll
  for (int k = 0; k < 4; ++k) {
    float4 pv = *(const float4*)(part + k * 1024 + c);
    xv.x += pv.x; xv.y += pv.y; xv.z += pv.z; xv.w += pv.w;
  }
  float ss = wave_sum(xv.x * xv.x + xv.y * xv.y + xv.z * xv.z + xv.w * xv.w);
  if (lane == 0) red[wave] = ss;
  __syncthreads();
  ss = (red[0] + red[1]) + (red[2] + red[3]);
  float sc = rsqrtf(ss * (1.f / 1024.f) + 1e-5f);
  float4 gg = *(const float4*)(p.final_g + c);
  *(float4*)(orow + c) = float4{xv.x * sc * gg.x, xv.y * sc * gg.y, xv.z * sc * gg.z, xv.w * sc * gg.w};
  __syncthreads();
}

__device__ void phase10(const Params& p, char* smem) {
  const int G = gridDim.x, full = p.full10;
  for (int task = blockIdx.x; task < full; task += G) gather_task(p, task);
  for (int o = full * 4 + blockIdx.x; o < NOUT; o += G) gather_task_block(p, smem, o);
}

#define XB_TMO      128
#define XB_XCNT(j)  (256  + 64 * (j))
#define XB_XSUB(j)  (1280 + 64 * (j))
#define XB_XGEN(j)  (2304 + 64 * (j))
#define XB_TOP      3328
#define XB_TOPGEN   3392
#define XCD_BAR_WORDS 3456
#define XB_SPIN_CAP (1u << 20)
__device__ __forceinline__ unsigned xb_ld(unsigned* p) { return __hip_atomic_load(p, __ATOMIC_RELAXED, __HIP_MEMORY_SCOPE_AGENT); }
__device__ __forceinline__ unsigned xb_add(unsigned* p, unsigned v) { return __hip_atomic_fetch_add(p, v, __ATOMIC_RELAXED, __HIP_MEMORY_SCOPE_AGENT); }
__device__ __forceinline__ unsigned xb_xcc_id() { return (unsigned)__builtin_amdgcn_s_getreg((3 << 11) | 20) & 0xFu; }
#define XB_SPIN(cond, bar) do { unsigned _sp = 0; while (cond) { __builtin_amdgcn_s_sleep(1); \
    if ((++_sp & 255u) == 0u) { if (xb_ld(&(bar)[XB_TMO])) break; if (_sp > XB_SPIN_CAP) { atomicAdd(&(bar)[XB_TMO], 1u); break; } } } } while (0)

struct GridBar { int dummy; };

__device__ __forceinline__ GridBar gb_init(unsigned* bar) {
  GridBar b;
  b.dummy = 0;
  if (threadIdx.x == 0) (void)xb_add(&bar[XB_XCNT(xb_xcc_id())], 1u);
  return b;
}
__device__ __forceinline__ void gb_census(unsigned* bar, unsigned x, unsigned& nloc, unsigned& nx) {
  const unsigned G = gridDim.x;
  unsigned sum, cnt, mine, sp = 0u;
  for (;;) {
    sum = 0u; cnt = 0u; mine = 0u;
#pragma unroll
    for (unsigned j = 0; j < 16; ++j) {
      const unsigned c = xb_ld(&bar[XB_XCNT(j)]);
      sum += c; cnt += (c > 0u) ? 1u : 0u; mine = (j == x) ? c : mine;
    }
    if (sum == G) break;
    __builtin_amdgcn_s_sleep(1);
    if ((++sp & 255u) == 0u) { if (xb_ld(&bar[XB_TMO])) break; if (sp > XB_SPIN_CAP) { atomicAdd(&bar[XB_TMO], 1u); break; } }
  }
  nloc = mine > 0u ? mine : 1u; nx = cnt > 0u ? cnt : 1u;
}
template <bool FIRST>
__device__ __forceinline__ void gb_sync(GridBar& b, unsigned* bar) {
  asm volatile("s_waitcnt vmcnt(0)" ::: "memory");
  __syncthreads();
  if (threadIdx.x == 0) {
    const unsigned x = xb_xcc_id();
    __builtin_amdgcn_s_waitcnt(0);
    unsigned* slot = bar + 4096 + 2 * blockIdx.x;
    unsigned nloc, nx;
    if (FIRST) { gb_census(bar, x, nloc, nx); slot[0] = nloc; slot[1] = nx; }
    else { nloc = __hip_atomic_load(&slot[0], __ATOMIC_RELAXED, __HIP_MEMORY_SCOPE_AGENT); nx = __hip_atomic_load(&slot[1], __ATOMIC_RELAXED, __HIP_MEMORY_SCOPE_AGENT); }
    const unsigned old = xb_add(&bar[XB_XSUB(x)], 1u);
    const unsigned gen = old / nloc;
    if (old + 1u == (gen + 1u) * nloc) {
      __builtin_amdgcn_fence(__ATOMIC_RELEASE, "agent");
      asm volatile("s_waitcnt vmcnt(0)" ::: "memory");
      const unsigned og = xb_add(&bar[XB_TOP], 1u);
      const unsigned tg = og / nx;
      if (og + 1u == (tg + 1u) * nx) xb_add(&bar[XB_TOPGEN], 1u);
      else XB_SPIN(xb_ld(&bar[XB_TOPGEN]) == tg, bar);
      __builtin_amdgcn_fence(__ATOMIC_ACQUIRE, "agent");
      xb_add(&bar[XB_XGEN(x)], 1u);
      asm volatile("s_waitcnt vmcnt(0)" ::: "memory");
    } else {
      XB_SPIN(xb_ld(&bar[XB_XGEN(x)]) == gen, bar);
      __builtin_amdgcn_fence(__ATOMIC_ACQUIRE, "agent");
      asm volatile("s_waitcnt vmcnt(0)" ::: "memory");
    }
  }
  __syncthreads();
}

template <int PH>
__device__ __forceinline__ void run_phase(const Params& p, char* smem) {
  if constexpr (PH == 0) phase0(p, smem);
  if constexpr (PH == 1) phase1(p, smem);
  if constexpr (PH == 2) phase2(p);
  if constexpr (PH == 3) phase3(p, smem);
  if constexpr (PH == 4) phase4(p, smem);
  if constexpr (PH == 5) phase5(p);
  if constexpr (PH == 6) phase6(p, smem);
  if constexpr (PH == 8) phase8(p, smem);
  if constexpr (PH == 9) phase9(p, smem);
  if constexpr (PH == 10) phase10(p, smem);
}

template <int LO, int HI>
__device__ __forceinline__ void run_range(const Params& p, char* smem, GridBar& gb) {
  if constexpr (LO < HI) {
    run_phase<LO>(p, smem);
    if constexpr (LO + 1 < HI) {
      if constexpr (LO != 7) gb_sync<LO == 0>(gb, (unsigned*)(p.ws + WS_BAR));
      run_range<LO + 1, HI>(p, smem, gb);
    }
  }
}

template <int LO, int HI>
__global__ void __launch_bounds__(256, 2) fwd_kernel(Params p) {
  __shared__ __attribute__((aligned(16))) char smem[SMEM_BYTES];
  if (p.ws == nullptr) cg::this_grid().sync();
  GridBar gb = gb_init((unsigned*)(p.ws + WS_BAR));
  run_range<LO, HI>(p, smem, gb);
}

template <int PH>
static void launch_one(const Params& p, int grid, hipStream_t stream) {
  fwd_kernel<PH, PH + 1><<<grid, 256, 0, stream>>>(p);
}

extern "C" void kernel_launch(void* const* d_in, const int* in_sizes, int n_in, void* d_out, int out_size, void* d_ws,
                              size_t ws_size, hipStream_t stream) {
  Params p{};
  const float** pp = (const float**)&p;
  for (int i = 0; i < 28; ++i) pp[i] = (const float*)d_in[i];
  p.out = (float*)d_out;
  p.ws = (char*)d_ws;
#if MULTI_LAUNCH
  const int grid = 1024;
  p.full1 = ((MROWS / 128) * 20 / grid) * grid; p.full8 = ((NOUT / 128) * 16 / grid) * grid; p.full10 = ((NOUT / 4) / grid) * grid; p.pad_ = 0;
  launch_one<0>(p, grid, stream);
  launch_one<1>(p, grid, stream);
  launch_one<2>(p, grid, stream);
  launch_one<3>(p, grid, stream);
  launch_one<4>(p, grid, stream);
  launch_one<5>(p, grid, stream);
  launch_one<6>(p, grid, stream);
  launch_one<7>(p, grid, stream);
  launch_one<8>(p, grid, stream);
  launch_one<9>(p, grid, stream);
  launch_one<10>(p, grid, stream);
#else
  static int grid_blocks = 0;
  if (!grid_blocks) {
    int dev = 0, cus = 0, per_cu = 0;
    (void)hipGetDevice(&dev);
    (void)hipDeviceGetAttribute(&cus, hipDeviceAttributeMultiprocessorCount, dev);
    (void)hipOccupancyMaxActiveBlocksPerMultiprocessor(&per_cu, fwd_kernel<0, NPH>, 256, 0);
    if (per_cu < 1) per_cu = 1;
    if (per_cu > 4) per_cu = 4;
    grid_blocks = cus * per_cu;
  }
  (void)hipMemsetAsync((char*)d_ws + WS_BAR, 0, XCD_BAR_WORDS * sizeof(unsigned), stream);
  p.full1 = ((MROWS / 128) * 20 / grid_blocks) * grid_blocks;
  p.full8 = ((NOUT / 128) * 16 / grid_blocks) * grid_blocks;
  p.full10 = ((NOUT / 4) / grid_blocks) * grid_blocks;
  p.pad_ = 0;
  void* args[] = {&p};
  hipError_t e = hipLaunchCooperativeKernel((void*)fwd_kernel<0, NPH>, dim3(grid_blocks), dim3(256), args, 0, stream);
  if (e != hipSuccess) fprintf(stderr, "cooperative launch failed: %s (grid %d)\n", hipGetErrorString(e), grid_blocks);
#endif
}
```

```cpp
#include <hip/hip_runtime.h>
#include <hip/hip_cooperative_groups.h>
#include <cstdio>
#include <cstdint>
namespace cg = cooperative_groups;

typedef unsigned short u16;
using bf16x8 = __attribute__((ext_vector_type(8))) short;
using f32x4 = __attribute__((ext_vector_type(4))) float;
using half2v = __attribute__((ext_vector_type(2))) _Float16;
using float2v = __attribute__((ext_vector_type(2))) float;

#ifndef MULTI_LAUNCH
#define MULTI_LAUNCH 0
#endif

constexpr int D = 1024, NIN = 2560;
constexpr int LP = 4112, NB = 4, TP = NB * LP;
constexpr int SB = 128, TS = 512;
constexpr int TTOK = TP + TS;
constexpr int PREV0 = TTOK;
constexpr int MROWS = 17152;
constexpr int TPAD = 17024;
constexpr int NOUT = 16896;
constexpr int PAST = 8192;
constexpr int NPH = 11;

constexpr size_t O_YP = 0;
constexpr size_t O_KWP = 17301504, O_VWP = 17367040, O_WKVP = 17432576, O_SHP = 17563648;
constexpr size_t O_KWS = 17567744, O_VWS = 19664896, O_WKVS = 21762048, O_SHS = 25956352;

constexpr size_t WS_WIN = 0;
constexpr size_t WS_WOUT = WS_WIN + 2560ull * 1024 * 2;
constexpr size_t WS_WQ = WS_WOUT + 1024ull * 1024 * 2;
constexpr size_t WS_SUBK = WS_WQ + 2048ull * 1024 * 2;
constexpr size_t WS_W2W = WS_SUBK + 2ull * 128 * 128 * 2;
constexpr size_t WS_W2A = WS_W2W + 512ull * 64 * 2;
constexpr size_t WS_W2G = WS_W2A + 512ull * 64 * 2;
constexpr size_t WS_B = WS_W2G + 512ull * 128 * 2;
constexpr size_t WS_C = WS_B + (size_t)MROWS * 1024 * 2;
constexpr size_t WS_D = WS_C + (size_t)MROWS * NIN * 2;
constexpr size_t WS_E = WS_D + (size_t)TPAD * 512 * 8;
constexpr size_t WS_END = WS_E + (size_t)TPAD * 512 * 4;
constexpr size_t WS_DEC = WS_D, WS_A = WS_D + (size_t)TPAD * 512 * 4, WS_G = WS_A + (size_t)TPAD * 512 * 2;
constexpr size_t WS_EU = WS_E, WS_EV = WS_E + 16384ull * 512, WS_SCU = WS_EV + 16384ull * 512, WS_SCV = WS_SCU + 65536;
constexpr size_t WS_X1B = WS_D, WS_SSQ = WS_D + 40ull * 1024 * 1024;
constexpr size_t WS_Q = WS_C, WS_IDX = WS_C + (size_t)NOUT * 2048 * 2, WS_GATE = WS_IDX + (size_t)NOUT * 128 * 4;
static_assert(WS_SCV + 65536 <= WS_END, "expert tables overflow region E");
static_assert(WS_X1B + (size_t)NOUT * 2048 <= WS_SSQ && WS_SSQ + (size_t)NOUT * 64 <= WS_E, "x1b/ssq overflow region D");
static_assert(WS_GATE + (size_t)NOUT * 128 * 4 <= WS_D, "idx/gate overflow region C");
constexpr size_t WS_BAR = WS_END;
static_assert(WS_BAR + 32768 <= 256ull * 1024 * 1024, "workspace too large");

constexpr int SMEM_BYTES = 65536;

struct Params {
  const float *x_prompt, *x_sample, *cache_k, *cache_v, *state_wkv, *state_shift, *meta, *norm1_g, *w_in, *mu, *w0,
      *w2w, *a0, *w2a, *w2g, *k_k, *k_a, *r_k, *lnx_w, *lnx_b, *sinks, *w_out, *norm2_g, *w_query, *sub_keys, *eu,
      *ev, *final_g;
  float* out;
  char* ws;
  int full1, full8, full10, pad_;
};

__constant__ double INVF[8] = {1.0, 0.19392274474868576, 0.03760603093086393, 0.007292664737217109,
                               0.001414213562373095, 0.0002742481756762073, 5.318295896944988e-05,
                               1.031338537721246e-05};

__device__ __forceinline__ u16 f2bf(float f) {
  unsigned u = __float_as_uint(f);
  u += 0x7fffu + ((u >> 16) & 1u);
  return (u16)(u >> 16);
}
__device__ __forceinline__ float bf2f(u16 h) { return __uint_as_float(((unsigned)h) << 16); }
__device__ __forceinline__ float bflo(unsigned u) { return __uint_as_float(u << 16); }
__device__ __forceinline__ float bfhi(unsigned u) { return __uint_as_float(u & 0xffff0000u); }
__device__ __forceinline__ unsigned pack2bf(float a, float b) { return (unsigned)f2bf(a) | ((unsigned)f2bf(b) << 16); }
__device__ __forceinline__ u16 f2h(float f) {
  _Float16 h = (_Float16)f;
  return __builtin_bit_cast(u16, h);
}

template <int CTRL>
__device__ __forceinline__ float dppf(float x) {
  return __int_as_float(__builtin_amdgcn_update_dpp(0, __float_as_int(x), CTRL, 0xF, 0xF, false));
}
__device__ __forceinline__ float red4(float x) {
  x += dppf<0xB1>(x);
  x += dppf<0x4E>(x);
  return x;
}
__device__ __forceinline__ float red8(float x) {
  x = red4(x);
  x += dppf<0x141>(x);
  return x;
}
__device__ __forceinline__ float red16(float x) {
  x = red8(x);
  x += dppf<0x140>(x);
  return x;
}
__device__ __forceinline__ float redmax16(float x) {
  x = fmaxf(x, dppf<0xB1>(x));
  x = fmaxf(x, dppf<0x4E>(x));
  x = fmaxf(x, dppf<0x141>(x));
  x = fmaxf(x, dppf<0x140>(x));
  return x;
}
__device__ __forceinline__ float rdlane(float x, int l) {
  return __int_as_float(__builtin_amdgcn_readlane(__float_as_int(x), l));
}
__device__ __forceinline__ float wave_sum(float x) {
  x = red16(x);
  return rdlane(x, 0) + rdlane(x, 16) + rdlane(x, 32) + rdlane(x, 48);
}
__device__ __forceinline__ f32x4 mfma16(bf16x8 a, bf16x8 b, f32x4 c) {
  return __builtin_amdgcn_mfma_f32_16x16x32_bf16(a, b, c, 0, 0, 0);
}
__device__ __forceinline__ float sigmoidf_(float x) { return __builtin_amdgcn_rcpf(1.f + __expf(-x)); }

template <class Epi>
__device__ __forceinline__ void gemm_tile(const u16* __restrict__ A, int lda, const u16* __restrict__ Bt, int ldb, int K,
                                          char* smem, Epi epi) {
  const int tid = threadIdx.x, wid = tid >> 6, lane = tid & 63, wr = wid >> 1, wc = wid & 1, fr = lane & 15,
            fq = lane >> 4;
  f32x4 acc[4][4];
#pragma unroll
  for (int m = 0; m < 4; ++m)
#pragma unroll
    for (int n = 0; n < 4; ++n) acc[m][n] = f32x4{0.f, 0.f, 0.f, 0.f};
  const int nk = K / 64;
  auto stage = [&](int buf, int kt) {
    char* SA = smem + buf * 32768;
    char* SB = SA + 16384;
#pragma unroll
    for (int i = 0; i < 4; ++i) {
      int b = tid * 16 + i * 4096, r = b >> 7, pc = (b >> 4) & 7;
      int c = kt * 64 + ((pc ^ ((r >> 1) & 7)) << 3);
      __builtin_amdgcn_global_load_lds((const unsigned*)(A + (size_t)r * lda + c),
                                       (__attribute__((address_space(3))) unsigned*)(SA + b), 16, 0, 0);
      __builtin_amdgcn_global_load_lds((const unsigned*)(Bt + (size_t)r * ldb + c),
                                       (__attribute__((address_space(3))) unsigned*)(SB + b), 16, 0, 0);
    }
  };
  stage(0, 0);
  asm volatile("s_waitcnt vmcnt(0)" ::: "memory");
  __syncthreads();
  for (int kt = 0; kt < nk; ++kt) {
    const int cur = kt & 1;
    if (kt + 1 < nk) stage(cur ^ 1, kt + 1);
    const char* SA = smem + cur * 32768;
    const char* SB = SA + 16384;
#pragma unroll
    for (int ks = 0; ks < 2; ++ks) {
      bf16x8 At[4], Bl[4];
#pragma unroll
      for (int m = 0; m < 4; ++m) {
        int r = wr * 64 + m * 16 + fr;
        At[m] = *(const bf16x8*)(SA + r * 128 + (((ks * 4 + fq) ^ ((r >> 1) & 7)) << 4));
      }
#pragma unroll
      for (int n = 0; n < 4; ++n) {
        int r = wc * 64 + n * 16 + fr;
        Bl[n] = *(const bf16x8*)(SB + r * 128 + (((ks * 4 + fq) ^ ((r >> 1) & 7)) << 4));
      }
      __builtin_amdgcn_s_setprio(1);
#pragma unroll
      for (int m = 0; m < 4; ++m)
#pragma unroll
        for (int n = 0; n < 4; ++n) acc[m][n] = mfma16(Bl[n], At[m], acc[m][n]);
      __builtin_amdgcn_s_setprio(0);
    }
    asm volatile("s_waitcnt vmcnt(0)" ::: "memory");
    __syncthreads();
  }
#pragma unroll
  for (int m = 0; m < 4; ++m)
#pragma unroll
    for (int n = 0; n < 4; ++n) epi(m, wr * 64 + m * 16 + fr, wc * 64 + n * 16 + fq * 4, acc[m][n]);
}

template <class Epi>
__device__ __forceinline__ void gemm_qtile(const u16* __restrict__ A, int lda, const u16* __restrict__ Bt, int ldb, int K,
                                           char* smem, Epi epi) {
  const int tid = threadIdx.x, wid = tid >> 6, lane = tid & 63, fr = lane & 15, fq = lane >> 4;
  f32x4 acc[2][2];
#pragma unroll
  for (int m = 0; m < 2; ++m)
#pragma unroll
    for (int n = 0; n < 2; ++n) acc[m][n] = f32x4{0.f, 0.f, 0.f, 0.f};
  const int nk = K / 64;
  auto stage = [&](int buf, int kt) {
    char* SA = smem + buf * 32768;
    char* SB = SA + 16384;
    {
      int b = tid * 16, r = b >> 7, pc = (b >> 4) & 7;
      int c = kt * 64 + ((pc ^ ((r >> 1) & 7)) << 3);
      __builtin_amdgcn_global_load_lds((const unsigned*)(A + (size_t)r * lda + c),
                                       (__attribute__((address_space(3))) unsigned*)(SA + b), 16, 0, 0);
    }
#pragma unroll
    for (int i = 0; i < 4; ++i) {
      int b = tid * 16 + i * 4096, r = b >> 7, pc = (b >> 4) & 7;
      int c = kt * 64 + ((pc ^ ((r >> 1) & 7)) << 3);
      __builtin_amdgcn_global_load_lds((const unsigned*)(Bt + (size_t)r * ldb + c),
                                       (__attribute__((address_space(3))) unsigned*)(SB + b), 16, 0, 0);
    }
  };
  stage(0, 0);
  asm volatile("s_waitcnt vmcnt(0)" ::: "memory");
  __syncthreads();
  for (int kt = 0; kt < nk; ++kt) {
    const int cur = kt & 1;
    if (kt + 1 < nk) stage(cur ^ 1, kt + 1);
    const char* SA = smem + cur * 32768;
    const char* SB = SA + 16384;
#pragma unroll
    for (int ks = 0; ks < 2; ++ks) {
      bf16x8 At[2], Bl[2];
#pragma unroll
      for (int m = 0; m < 2; ++m) {
        int r = m * 16 + fr;
        At[m] = *(const bf16x8*)(SA + r * 128 + (((ks * 4 + fq) ^ ((r >> 1) & 7)) << 4));
      }
#pragma unroll
      for (int n = 0; n < 2; ++n) {
        int r = wid * 32 + n * 16 + fr;
        Bl[n] = *(const bf16x8*)(SB + r * 128 + (((ks * 4 + fq) ^ ((r >> 1) & 7)) << 4));
      }
#pragma unroll
      for (int m = 0; m < 2; ++m)
#pragma unroll
        for (int n = 0; n < 2; ++n) acc[m][n] = mfma16(Bl[n], At[m], acc[m][n]);
    }
    asm volatile("s_waitcnt vmcnt(0)" ::: "memory");
    __syncthreads();
  }
#pragma unroll
  for (int m = 0; m < 2; ++m)
#pragma unroll
    for (int n = 0; n < 2; ++n) epi(m, m * 16 + fr, wid * 32 + n * 16 + fq * 4, acc[m][n]);
}

__device__ __forceinline__ int xcd_vid() { return (blockIdx.x & 7) * (gridDim.x >> 3) + (blockIdx.x >> 3); }
__device__ __forceinline__ void grouped_tile(int t, int MT, int NT, int& mt, int& nt) {
  const int GM = 8;
  int per = GM * NT, gid = t / per, rem = t - gid * per;
  int first = gid * GM, gsz = min(MT - first, GM);
  mt = first + rem % gsz;
  nt = rem / gsz;
}

__device__ void transpose_task(const float* __restrict__ src, int K, int N, u16* __restrict__ dst, int tile, char* smem,
                               const float* __restrict__ kscale = nullptr) {
  const int tid = threadIdx.x;
  int tn = N / 64;
  int k0 = (tile / tn) * 64, n0 = (tile % tn) * 64;
  float* t = (float*)smem;
#pragma unroll 4
  for (int it = 0; it < 16; ++it) {
    int k = it * 4 + (tid >> 6), n = tid & 63;
    t[n * 65 + k] = src[(size_t)(k0 + k) * N + n0 + n] * (kscale ? kscale[k0 + k] : 1.f);
  }
  __syncthreads();
#pragma unroll 4
  for (int it = 0; it < 16; ++it) {
    int n = it * 4 + (tid >> 6), k = tid & 63;
    dst[(size_t)(n0 + n) * K + k0 + k] = f2bf(t[n * 65 + k]);
  }
  __syncthreads();
}

__device__ void norm1_task(const Params& p, int task) {
  const int wave = threadIdx.x >> 6, lane = threadIdx.x & 63;
  int row = task * 4 + wave;
  u16* h = (u16*)(p.ws + WS_B) + (size_t)row * D;
  const float* src = nullptr;
  bool donorm = true;
  float* shout = nullptr;
  if (row < TP) {
    int b = row / LP, t = row % LP;
    src = (t < 16) ? p.meta + (size_t)t * D : p.x_prompt + ((size_t)b * 4096 + (t - 16)) * D;
    if (t == LP - 1) shout = p.out + O_SHP + (size_t)b * D;
  } else if (row < TTOK) {
    int r = row - TP;
    src = p.x_sample + (size_t)r * D;
    if ((r & 3) == 3) shout = p.out + O_SHS + (size_t)(r >> 2) * D;
  } else if (row < TTOK + SB) {
    src = p.state_shift + (size_t)(row - TTOK) * D;
    donorm = false;
  }
  if (!src) {
#pragma unroll
    for (int i = 0; i < 4; ++i) *(uint2*)(h + (i * 64 + lane) * 4) = uint2{0u, 0u};
    return;
  }
  float4 v[4];
  float ss = 0.f;
#pragma unroll
  for (int i = 0; i < 4; ++i) {
    v[i] = ((const float4*)src)[i * 64 + lane];
    ss += v[i].x * v[i].x + v[i].y * v[i].y + v[i].z * v[i].z + v[i].w * v[i].w;
  }
  float sc = 1.f;
  if (donorm) {
    ss = wave_sum(ss);
    sc = rsqrtf(ss * (1.f / 1024.f) + 1e-5f);
  }
#pragma unroll
  for (int i = 0; i < 4; ++i) {
    float4 y = v[i];
    if (donorm) {
      float4 g = ((const float4*)p.norm1_g)[i * 64 + lane];
      y.x *= sc * g.x; y.y *= sc * g.y; y.z *= sc * g.z; y.w *= sc * g.w;
    }
    *(uint2*)(h + (i * 64 + lane) * 4) = uint2{pack2bf(y.x, y.y), pack2bf(y.z, y.w)};
    if (shout) ((float4*)shout)[i * 64 + lane] = y;
  }
}

__device__ void phase0(const Params& p, char* smem) {
  constexpr int N_NORM = MROWS / 4;
  constexpr int T_WIN = 16 * 40, T_WOUT = 16 * 16, T_WQ = 16 * 32, T_W2W = 8, T_W2A = 8, T_W2G = 16, T_SUBK = 32;
  constexpr int TOT = N_NORM + T_WIN + T_W2W + T_W2A + T_W2G + T_SUBK;
  for (int task = blockIdx.x; task < TOT; task += gridDim.x) {
    int t = task;
    if (t < N_NORM) { norm1_task(p, t); continue; }
    t -= N_NORM;
    if (t < T_WIN) { transpose_task(p.w_in, 1024, 2560, (u16*)(p.ws + WS_WIN), t, smem); continue; }
    t -= T_WIN;
    if (t < T_W2W) { transpose_task(p.w2w, 64, 512, (u16*)(p.ws + WS_W2W), t, smem); continue; }
    t -= T_W2W;
    if (t < T_W2A) { transpose_task(p.w2a, 64, 512, (u16*)(p.ws + WS_W2A), t, smem); continue; }
    t -= T_W2A;
    if (t < T_W2G) { transpose_task(p.w2g, 128, 512, (u16*)(p.ws + WS_W2G), t, smem); continue; }
    t -= T_W2G;
    {
      int e = (t * 256 + threadIdx.x) * 4;
      float4 v = *(const float4*)(p.sub_keys + e);
      *(uint2*)((u16*)(p.ws + WS_SUBK) + e) = uint2{pack2bf(v.x, v.y), pack2bf(v.z, v.w)};
    }
  }
}

__device__ void phase1(const Params& p, char* smem) {
  const u16* hbuf = (const u16*)(p.ws + WS_B);
  const u16* wt = (const u16*)(p.ws + WS_WIN);
  u16* proj = (u16*)(p.ws + WS_C);
  constexpr int NT = 20, MT = MROWS / 128, TOT = MT * NT;
  const int G = gridDim.x, full = p.full1, ntask = full + 4 * (TOT - full);
  for (int task = xcd_vid(); task < ntask; task += G) {
    int mt, nt;
    if (task < full) {
      grouped_tile(task, MT, NT, mt, nt);
      u16* crow = proj + (size_t)mt * 128 * NIN + nt * 128;
      gemm_tile(hbuf + (size_t)mt * 128 * D, D, wt + (size_t)nt * 128 * D, D, D, smem,
                [&](int m, int r, int c, f32x4 v) { *(uint2*)(crow + (size_t)r * NIN + c) = uint2{pack2bf(v[0], v[1]), pack2bf(v[2], v[3])}; });
    } else {
      int rem = task - full, qd = rem & 3;
      grouped_tile(full + (rem >> 2), MT, NT, mt, nt);
      size_t r0 = (size_t)mt * 128 + qd * 32;
      u16* crow = proj + r0 * NIN + nt * 128;
      gemm_qtile(hbuf + r0 * D, D, wt + (size_t)nt * 128 * D, D, D, smem,
                 [&](int m, int r, int c, f32x4 v) { *(uint2*)(crow + (size_t)r * NIN + c) = uint2{pack2bf(v[0], v[1]), pack2bf(v[2], v[3])}; });
    }
  }
}

__device__ void prepass_task(const Params& p, int task) {
  const int wave = threadIdx.x >> 6, lane = threadIdx.x & 63;
  int row = task * 4 + wave;
  if (row >= TTOK) return;
  u16* proj = (u16*)(p.ws + WS_C);
  u16* act = (u16*)(p.ws + WS_E);
  bool isP = row < TP;
  int b, t, prow;
  float pos;
  if (isP) { b = row / LP; t = row % LP; prow = t > 0 ? row - 1 : -1; pos = (float)t; }
  else { int r = row - TP; b = r >> 2; t = r & 3; prow = t > 0 ? row - 1 : PREV0 + b; pos = (float)(PAST + t); }
  u16* pr = proj + (size_t)row * NIN;
  const u16* pp = prow >= 0 ? proj + (size_t)prow * NIN : nullptr;
  {
    int c = 1536 + lane * 4;
    uint2 a = *(const uint2*)(pr + c);
    uint2 bq = pp ? *(const uint2*)(pp + c) : uint2{0u, 0u};
    float4 mu = *(const float4*)(p.mu + c);
    float x[4] = {bflo(a.x), bfhi(a.x), bflo(a.y), bfhi(a.y)};
    float xp[4] = {bflo(bq.x), bfhi(bq.x), bflo(bq.y), bfhi(bq.y)};
    float mm[4] = {mu.x, mu.y, mu.z, mu.w};
    float o[4];
#pragma unroll
    for (int i = 0; i < 4; ++i) {
      float m = x[i] + (xp[i] - x[i]) * mm[i];
      float r;
      if (lane < 16) r = tanhf(m);
      else if (lane < 32) r = m;
      else r = sigmoidf_(m);
      o[i] = r;
    }
    *(uint2*)(act + (size_t)row * 256 + lane * 4) = uint2{pack2bf(o[0], o[1]), pack2bf(o[2], o[3])};
  }
  float* kwin = nullptr;
  float* vwin = nullptr;
  if (isP) {
    if (t >= LP - 128) {
      kwin = p.out + O_KWP + ((size_t)b * 128 + (t - (LP - 128))) * 128;
      vwin = p.out + O_VWP + ((size_t)b * 128 + (t - (LP - 128))) * 128;
    }
  } else {
    kwin = p.out + O_KWS + ((size_t)b * 128 + 124 + t) * 128;
    vwin = p.out + O_VWS + ((size_t)b * 128 + 124 + t) * 128;
  }
  for (int it = lane; it < 80; it += 64) {
    int hh = it >> 3, d = it & 7;
    int col = 1792 + hh * 64 + d;
    float x1 = bf2f(pr[col]), x2 = bf2f(pr[col + 8]);
    double rev = (double)pos * INVF[d] * 0.15915494309189535;
    float fr = (float)(rev - floor(rev));
    float sn = __builtin_amdgcn_sinf(fr), cs = __builtin_amdgcn_cosf(fr);
    float r1 = x1 * cs - x2 * sn, r2 = x2 * cs + x1 * sn;
    pr[col] = f2bf(r1);
    pr[col + 8] = f2bf(r2);
    if (hh >= 8 && kwin) {
      kwin[(hh - 8) * 64 + d] = r1;
      kwin[(hh - 8) * 64 + d + 8] = r2;
    }
  }
  if (kwin) {
#pragma unroll
    for (int i = 0; i < 2; ++i) {
      int idx = lane * 2 + i;
      if ((idx & 63) >= 16) kwin[idx] = bf2f(pr[2304 + idx]);
      vwin[idx] = bf2f(pr[2432 + idx]);
    }
  }
}

__device__ void phase2(const Params& p) {
  constexpr int N_PRE = TTOK / 4;
  constexpr int N_CP = 256;
  for (int task = blockIdx.x; task < N_PRE + N_CP; task += gridDim.x) {
    if (task < N_PRE) { prepass_task(p, task); continue; }
    int t = task - N_PRE;
    int which = t >> 7, b = t & 127;
    const float4* src = (const float4*)((which ? p.cache_v : p.cache_k) + (size_t)b * 16384 + 512);
    float4* dst = (float4*)(p.out + (which ? O_VWS : O_KWS) + (size_t)b * 16384);
    for (int i = threadIdx.x; i < 3968; i += 256) dst[i] = src[i];
  }
}

__device__ void phase3(const Params& p, char* smem) {
  const u16* act = (const u16*)(p.ws + WS_E);
  float* dec = (float*)(p.ws + WS_DEC);
  u16* ab = (u16*)(p.ws + WS_A);
  u16* gb = (u16*)(p.ws + WS_G);
  constexpr int MT = TPAD / 128;
  for (int tile = blockIdx.x; tile < MT * 12; tile += gridDim.x) {
    int which = tile % 3, rest = tile / 3;
    int nt = rest & 3, mt = rest >> 2;
    size_t r0 = (size_t)mt * 128;
    int c0 = nt * 128;
    if (which == 0) {
      gemm_tile(act + r0 * 256, 256, (const u16*)(p.ws + WS_W2W) + (size_t)c0 * 64, 64, 64, smem,
                [&](int m, int r, int c, f32x4 v) {
                  float4 w0v = *(const float4*)(p.w0 + c0 + c);
                  float w0a[4] = {w0v.x, w0v.y, w0v.z, w0v.w};
                  float o[4];
#pragma unroll
                  for (int e = 0; e < 4; ++e) {
                    float nx = -(w0a[e] + v[e]);
                    float sp = fmaxf(nx, 0.f) + __logf(1.f + __expf(-fabsf(nx)));
                    o[e] = __expf(-__expf(-sp - 0.5f));
                  }
                  *(float4*)(dec + (r0 + r) * 512 + c0 + c) = float4{o[0], o[1], o[2], o[3]};
                });
    } else if (which == 1) {
      gemm_tile(act + r0 * 256 + 64, 256, (const u16*)(p.ws + WS_W2A) + (size_t)c0 * 64, 64, 64, smem,
                [&](int m, int r, int c, f32x4 v) {
                  float4 a0v = *(const float4*)(p.a0 + c0 + c);
                  *(uint2*)(ab + (r0 + r) * 512 + c0 + c) = uint2{pack2bf(sigmoidf_(a0v.x + v[0]), sigmoidf_(a0v.y + v[1])), pack2bf(sigmoidf_(a0v.z + v[2]), sigmoidf_(a0v.w + v[3]))};
                });
    } else {
      gemm_tile(act + r0 * 256 + 128, 256, (const u16*)(p.ws + WS_W2G) + (size_t)c0 * 128, 128, 128, smem,
                [&](int m, int r, int c, f32x4 v) { *(uint2*)(gb + (r0 + r) * 512 + c0 + c) = uint2{pack2bf(v[0], v[1]), pack2bf(v[2], v[3])}; });
    }
  }
}

__device__ void convert_task(const Params& p, int task) {
  const int wave = threadIdx.x >> 6, lane = threadIdx.x & 63;
  int r = task * 4 + wave;
  const float* src = (r < 16384 ? p.eu + (size_t)r * 1024 : p.ev + (size_t)(r - 16384) * 1024) + lane * 16;
  float4 x[4];
  float am = 0.f;
#pragma unroll
  for (int i = 0; i < 4; ++i) {
    x[i] = ((const float4*)src)[i];
    am = fmaxf(am, fmaxf(fmaxf(fabsf(x[i].x), fabsf(x[i].y)), fmaxf(fabsf(x[i].z), fabsf(x[i].w))));
  }
  am = redmax16(am);
  am = fmaxf(fmaxf(rdlane(am, 0), rdlane(am, 16)), fmaxf(rdlane(am, 32), rdlane(am, 48)));
  float scale = am > 0.f ? 7.f / am : 1.f;
  float inv = am > 0.f ? am * (1.f / 7.f) : 1.f;
  float y[16];
#pragma unroll
  for (int i = 0; i < 4; ++i) {
    y[4 * i] = fminf(fmaxf(x[i].x * scale, -6.f), 6.f); y[4 * i + 1] = fminf(fmaxf(x[i].y * scale, -6.f), 6.f);
    y[4 * i + 2] = fminf(fmaxf(x[i].z * scale, -6.f), 6.f); y[4 * i + 3] = fminf(fmaxf(x[i].w * scale, -6.f), 6.f);
  }
  unsigned w0 = 0u, w1 = 0u;
  w0 = __builtin_amdgcn_cvt_scalef32_pk_fp4_f32(w0, y[0], y[1], 1.0f, 0);
  w0 = __builtin_amdgcn_cvt_scalef32_pk_fp4_f32(w0, y[2], y[3], 1.0f, 1);
  w0 = __builtin_amdgcn_cvt_scalef32_pk_fp4_f32(w0, y[4], y[5], 1.0f, 2);
  w0 = __builtin_amdgcn_cvt_scalef32_pk_fp4_f32(w0, y[6], y[7], 1.0f, 3);
  w1 = __builtin_amdgcn_cvt_scalef32_pk_fp4_f32(w1, y[8], y[9], 1.0f, 0);
  w1 = __builtin_amdgcn_cvt_scalef32_pk_fp4_f32(w1, y[10], y[11], 1.0f, 1);
  w1 = __builtin_amdgcn_cvt_scalef32_pk_fp4_f32(w1, y[12], y[13], 1.0f, 2);
  w1 = __builtin_amdgcn_cvt_scalef32_pk_fp4_f32(w1, y[14], y[15], 1.0f, 3);
  *(uint2*)((unsigned char*)(p.ws + WS_EU) + (size_t)r * 512 + lane * 8) = uint2{w0, w1};
  if (lane == 0) ((float*)(p.ws + WS_SCU))[r] = inv;
}

struct ScanRaw {
  uint2 rr, rk, rv, qr, qk, qv, av;
  float4 dc;
};
constexpr int SC_TOK = 332;

__device__ void scan_task(const Params& p, char* smem, int rowbase, int T, int prevrow, int h, int rg,
                          const float* __restrict__ s_in, float* __restrict__ s_out) {
  const int tid = threadIdx.x, wave = tid >> 6, lane = tid & 63, l16 = lane & 15;
  const bool scanner = wave < 2;
  const u16* proj = (const u16*)(p.ws + WS_C);
  const float* dec = (const float*)(p.ws + WS_DEC);
  const u16* ab = (const u16*)(p.ws + WS_A);
  float* yraw = p.out;
  float* bufs = (float*)smem;
  float* yparts = (float*)(smem + 42496);
  float* vkrs = (float*)(smem + 42496 + 16384);
  const int nchunk = (T + 15) >> 4;
  const int il = (wave & 1) * 4 + (lane >> 4), i = rg * 8 + il, j0 = l16 * 4;
  float2v S01 = {0.f, 0.f}, S23 = {0.f, 0.f};
  if (s_in && scanner) {
    float4 s = *(const float4*)(s_in + i * 64 + j0);
    S01 = float2v{s.x, s.y}; S23 = float2v{s.z, s.w};
  }
  const int ptid = tid & 127, cgp = ptid & 15, ttb = ptid >> 4, col = h * 64 + cgp * 4;
  const float4 mu_r = *(const float4*)(p.mu + col), mu_k = *(const float4*)(p.mu + 512 + col),
               mu_v = *(const float4*)(p.mu + 1024 + col);
  const float4 kkw = *(const float4*)(p.k_k + col), kaw = *(const float4*)(p.k_a + col);
  const u16* projc = proj + (size_t)rowbase * NIN + col;
  const float* decc = dec + (size_t)rowbase * 512 + col;
  const u16* abc = ab + (size_t)rowbase * 512 + col;
  const u16* prevp = prevrow >= 0 ? proj + (size_t)prevrow * NIN + col : nullptr;
  auto issue = [&](int c, int tt, ScanRaw& R) {
    int t = c * 16 + tt;
    if (t < T) {
      const size_t ro = (size_t)c * 16 + tt;
      const u16* pr = projc + ro * NIN;
      R.rr = *(const uint2*)(pr);
      R.rk = *(const uint2*)(pr + 512);
      R.rv = *(const uint2*)(pr + 1024);
      const u16* pq = t > 0 ? pr - NIN : prevp;
      if (pq) {
        R.qr = *(const uint2*)(pq);
        R.qk = *(const uint2*)(pq + 512);
        R.qv = *(const uint2*)(pq + 1024);
      } else {
        R.qr = uint2{0, 0}; R.qk = uint2{0, 0}; R.qv = uint2{0, 0};
      }
      R.dc = *(const float4*)(decc + ro * 512);
      R.av = *(const uint2*)(abc + ro * 512);
    }
  };
  auto prep_item = [&](const ScanRaw& R, int tt, float* buf, float* vkr) {
    float xr[4] = {bflo(R.rr.x), bfhi(R.rr.x), bflo(R.rr.y), bfhi(R.rr.y)};
    float xk[4] = {bflo(R.rk.x), bfhi(R.rk.x), bflo(R.rk.y), bfhi(R.rk.y)};
    float xv[4] = {bflo(R.rv.x), bfhi(R.rv.x), bflo(R.rv.y), bfhi(R.rv.y)};
    float pr_[4] = {bflo(R.qr.x), bfhi(R.qr.x), bflo(R.qr.y), bfhi(R.qr.y)};
    float pk_[4] = {bflo(R.qk.x), bfhi(R.qk.x), bflo(R.qk.y), bfhi(R.qk.y)};
    float pv_[4] = {bflo(R.qv.x), bfhi(R.qv.x), bflo(R.qv.y), bfhi(R.qv.y)};
    float aa[4] = {bflo(R.av.x), bfhi(R.av.x), bflo(R.av.y), bfhi(R.av.y)};
    float dcv[4] = {R.dc.x, R.dc.y, R.dc.z, R.dc.w};
    float mur[4] = {mu_r.x, mu_r.y, mu_r.z, mu_r.w}, muk[4] = {mu_k.x, mu_k.y, mu_k.z, mu_k.w},
          muv[4] = {mu_v.x, mu_v.y, mu_v.z, mu_v.w};
    float kw[4] = {kkw.x, kkw.y, kkw.z, kkw.w}, ka[4] = {kaw.x, kaw.y, kaw.z, kaw.w};
    float kkv[4], ss = 0.f;
#pragma unroll
    for (int e = 0; e < 4; ++e) {
      xr[e] = xr[e] + (pr_[e] - xr[e]) * mur[e];
      xk[e] = xk[e] + (pk_[e] - xk[e]) * muk[e];
      xv[e] = xv[e] + (pv_[e] - xv[e]) * muv[e];
      kkv[e] = xk[e] * kw[e];
      ss += kkv[e] * kkv[e];
    }
    ss = red16(ss);
    float inv = __builtin_amdgcn_rsqf(fmaxf(ss, 1e-24f));
    float nk[4], kb[4], km[4];
    float brs = 0.f, krs = 0.f;
#pragma unroll
    for (int e = 0; e < 4; ++e) {
      float kk = kkv[e] * inv;
      nk[e] = -kk;
      kb[e] = kk * aa[e];
      km[e] = xk[e] * (1.f + (aa[e] - 1.f) * ka[e]);
      brs += kb[e] * xr[e];
      krs += km[e] * xr[e];
    }
    brs = red16(brs);
    krs = red16(krs);
    float* bt = buf + tt * SC_TOK + cgp * 4;
    *(float4*)(bt) = float4{xr[0] * dcv[0] + brs * nk[0], xr[1] * dcv[1] + brs * nk[1], xr[2] * dcv[2] + brs * nk[2],
                            xr[3] * dcv[3] + brs * nk[3]};
    *(float4*)(bt + 64) = R.dc;
    *(float4*)(bt + 128) = float4{km[0], km[1], km[2], km[3]};
    *(float4*)(bt + 192) = float4{nk[0], nk[1], nk[2], nk[3]};
    *(float4*)(bt + 256) = float4{kb[0], kb[1], kb[2], kb[3]};
    if ((cgp >> 1) == rg) {
      *(float4*)(buf + tt * SC_TOK + 320 + (cgp & 1) * 4) = float4{xv[0], xv[1], xv[2], xv[3]};
      *(float4*)(vkr + tt * 8 + (cgp & 1) * 4) = float4{xv[0] * krs, xv[1] * krs, xv[2] * krs, xv[3] * krs};
    }
  };
  auto yreduce = [&](int c) {
    const int tt = ptid >> 3, row = ptid & 7;
    const float4* yp = (const float4*)(yparts + (c & 1) * 2048 + ptid * 16);
    float4 a = yp[0], b = yp[1], c4 = yp[2], d = yp[3];
    float y = ((a.x + a.y) + (a.z + a.w)) + ((b.x + b.y) + (b.z + b.w)) + ((c4.x + c4.y) + (c4.z + c4.w)) +
              ((d.x + d.y) + (d.z + d.w)) + vkrs[(c % 3) * 128 + ptid];
    int t = c * 16 + tt;
    if (t < T) yraw[(size_t)(rowbase + t) * 512 + h * 64 + rg * 8 + row] = y;
  };
  ScanRaw R0, R1;
  R0.rr = R0.rk = R0.rv = R0.qr = R0.qk = R0.qv = R0.av = uint2{0, 0}; R0.dc = float4{0, 0, 0, 0};
  R1 = R0;
  if (!scanner) {
    issue(0, ttb, R0);
    issue(0, ttb + 8, R1);
    prep_item(R0, ttb, bufs, vkrs);
    prep_item(R1, ttb + 8, bufs, vkrs);
    if (nchunk > 1) { issue(1, ttb, R0); issue(1, ttb + 8, R1); }
  }
  __syncthreads();
  for (int c = 0; c < nchunk; ++c) {
    if (scanner) {
      const float* buf = bufs + (c & 1) * (16 * SC_TOK);
      float* ypart = yparts + (c & 1) * 2048;
      const int ntok = min(16, T - c * 16);
      const float* bt0 = buf + j0;
      float4 r4 = *(const float4*)(bt0), w4 = *(const float4*)(bt0 + 64), k4 = *(const float4*)(bt0 + 128),
             a4 = *(const float4*)(bt0 + 192), b4 = *(const float4*)(bt0 + 256);
      float vi = buf[320 + il];
      for (int t2 = 0; t2 < ntok; ++t2) {
        int tn = min(t2 + 1, ntok - 1);
        const float* bn = buf + tn * SC_TOK + j0;
        float4 rn = *(const float4*)(bn), wn = *(const float4*)(bn + 64), kn = *(const float4*)(bn + 128),
               an = *(const float4*)(bn + 192), bnn = *(const float4*)(bn + 256);
        float vn = buf[tn * SC_TOK + 320 + il];
        float2v sa2 = S01 * float2v{a4.x, a4.y} + S23 * float2v{a4.z, a4.w};
        float2v q2 = S01 * float2v{r4.x, r4.y} + S23 * float2v{r4.z, r4.w};
        float2v vv = float2v{vi, vi};
        float2v t01 = S01 * float2v{w4.x, w4.y} + vv * float2v{k4.x, k4.y};
        float2v t23 = S23 * float2v{w4.z, w4.w} + vv * float2v{k4.z, k4.w};
        float sa = red16(sa2.x + sa2.y);
        float2v sv = float2v{sa, sa};
        S01 = t01 + sv * float2v{b4.x, b4.y};
        S23 = t23 + sv * float2v{b4.z, b4.w};
        ypart[t2 * 128 + (tid & 127)] = q2.x + q2.y;
        r4 = rn; w4 = wn; k4 = kn; a4 = an; b4 = bnn; vi = vn;
      }
    } else {
      if (c > 0) yreduce(c - 1);
      if (c + 1 < nchunk) {
        float* nb = bufs + ((c + 1) & 1) * (16 * SC_TOK);
        float* nv = vkrs + ((c + 1) % 3) * 128;
        prep_item(R0, ttb, nb, nv);
        prep_item(R1, ttb + 8, nb, nv);
        if (c + 2 < nchunk) { issue(c + 2, ttb, R0); issue(c + 2, ttb + 8, R1); }
      }
    }
    __syncthreads();
  }
  if (scanner) *(float4*)(s_out + i * 64 + j0) = float4{S01.x, S01.y, S23.x, S23.y};
  else yreduce(nchunk - 1);
  __syncthreads();
}

__device__ void attn_prompt_task(const Params& p, char* smem, int task) {
  const int tid = threadIdx.x, w = tid >> 6, lane = tid & 63, fr = lane & 15, fq = lane >> 4;
  int head = task & 7;
  int qt = (task >> 3) % 65;
  int b = task / (8 * 65);
  int kvh = head >> 2;
  u16* KV = (u16*)smem;
  u16* Ps = (u16*)(smem + 9216) + w * 16 * 200;
  const u16* projb = (const u16*)(p.ws + WS_C) + (size_t)b * LP * NIN;
  u16* mix = (u16*)(p.ws + WS_B);
  int q0 = qt * 64, kstart = q0 - 128;
  int qrow = min(q0 + w * 16 + fr, LP - 1);
  bf16x8 qa[2];
#pragma unroll
  for (int ks = 0; ks < 2; ++ks)
    qa[ks] = *(const bf16x8*)(projb + (size_t)qrow * NIN + 1792 + head * 64 + ks * 32 + fq * 8);
  f32x4 S[12];
#pragma unroll
  for (int i = 0; i < 12; ++i) S[i] = f32x4{0.f, 0.f, 0.f, 0.f};
#pragma unroll
  for (int kt = 0; kt < 3; ++kt) {
    {
      int key = tid >> 2, ch = tid & 3;
      int kp = min(max(kstart + kt * 64 + key, 0), LP - 1);
      const uint4* src = (const uint4*)(projb + (size_t)kp * NIN + 2304 + kvh * 64 + ch * 16);
      uint4 v0 = src[0], v1 = src[1];
      *(uint4*)(KV + key * 72 + ch * 16) = v0;
      *(uint4*)(KV + key * 72 + ch * 16 + 8) = v1;
    }
    __syncthreads();
#pragma unroll
    for (int n = 0; n < 4; ++n)
#pragma unroll
      for (int ks = 0; ks < 2; ++ks) {
        bf16x8 kb = *(const bf16x8*)(KV + (n * 16 + fr) * 72 + ks * 32 + fq * 8);
        S[kt * 4 + n] = mfma16(qa[ks], kb, S[kt * 4 + n]);
      }
    __syncthreads();
  }
  float sink = p.sinks[head];
#pragma unroll
  for (int j = 0; j < 4; ++j) {
    int qpos = q0 + w * 16 + fq * 4 + j;
    float mx = -1e30f;
#pragma unroll
    for (int T = 0; T < 12; ++T) {
      int kpos = kstart + T * 16 + fr;
      bool valid = (kpos >= 0) && (kpos <= qpos) && (qpos - kpos < 128);
      float s = valid ? S[T][j] * 0.125f : -1e30f;
      S[T][j] = s;
      mx = fmaxf(mx, s);
    }
    mx = redmax16(mx);
    mx = fmaxf(mx, sink);
    float sum = 0.f;
#pragma unroll
    for (int T = 0; T < 12; ++T) {
      float e = (S[T][j] > -1e29f) ? __expf(S[T][j] - mx) : 0.f;
      S[T][j] = e;
      sum += e;
    }
    sum = red16(sum) + __expf(sink - mx);
    float inv = 1.f / sum;
#pragma unroll
    for (int T = 0; T < 12; ++T) Ps[(fq * 4 + j) * 200 + T * 16 + fr] = f2bf(S[T][j] * inv);
  }
  f32x4 O[4];
#pragma unroll
  for (int i = 0; i < 4; ++i) O[i] = f32x4{0.f, 0.f, 0.f, 0.f};
#pragma unroll
  for (int kt = 0; kt < 3; ++kt) {
    {
      int key = tid >> 2, ch = tid & 3;
      int kp = min(max(kstart + kt * 64 + key, 0), LP - 1);
      const uint4* src = (const uint4*)(projb + (size_t)kp * NIN + 2432 + kvh * 64 + ch * 16);
      uint4 v0 = src[0], v1 = src[1];
      unsigned e[8] = {v0.x, v0.y, v0.z, v0.w, v1.x, v1.y, v1.z, v1.w};
#pragma unroll
      for (int i = 0; i < 8; ++i) {
        KV[(ch * 16 + 2 * i) * 72 + key] = (u16)(e[i] & 0xffffu);
        KV[(ch * 16 + 2 * i + 1) * 72 + key] = (u16)(e[i] >> 16);
      }
    }
    __syncthreads();
#pragma unroll
    for (int ks = 0; ks < 2; ++ks) {
      bf16x8 pa = *(const bf16x8*)(Ps + fr * 200 + kt * 64 + ks * 32 + fq * 8);
#pragma unroll
      for (int n = 0; n < 4; ++n) {
        bf16x8 vb = *(const bf16x8*)(KV + (n * 16 + fr) * 72 + ks * 32 + fq * 8);
        O[n] = mfma16(pa, vb, O[n]);
      }
    }
    __syncthreads();
  }
#pragma unroll
  for (int n = 0; n < 4; ++n)
#pragma unroll
    for (int j = 0; j < 4; ++j) {
      int q = q0 + w * 16 + fq * 4 + j;
      if (q < LP) mix[((size_t)(b * LP + q)) * 1024 + 512 + head * 64 + n * 16 + fr] = f2bf(O[n][j]);
    }
}

__device__ void attn_sample_task(const Params& p, char* smem, int task) {
  const int tid = threadIdx.x;
  int b = task >> 1, kvh = task & 1;
  const u16* proj = (const u16*)(p.ws + WS_C);
  u16* mix = (u16*)(p.ws + WS_B);
  float* Qs = (float*)smem;
  float* Sc = Qs + 1024;
  {
    int qr = tid >> 4, d4 = (tid & 15) * 4, g = qr >> 2, s = qr & 3;
    const u16* src = proj + (size_t)(TP + b * 4 + s) * NIN + 1792 + (kvh * 4 + g) * 64 + d4;
    uint2 v = *(const uint2*)src;
    *(float4*)(Qs + qr * 64 + d4) = float4{bflo(v.x) * 0.125f, bfhi(v.x) * 0.125f, bflo(v.y) * 0.125f, bfhi(v.y) * 0.125f};
  }
  __syncthreads();
  for (int idx = tid; idx < 132 * 16; idx += 256) {
    int kj = idx >> 4, qr = idx & 15, s = qr & 3;
    bool valid = (kj < 128) ? (kj > s) : (kj - 128 <= s);
    float acc = 0.f;
    const float* q = Qs + qr * 64;
    if (kj < 128) {
      const float4* kr = (const float4*)(p.cache_k + (((size_t)b * 128 + kj) * 2 + kvh) * 64);
#pragma unroll
      for (int d = 0; d < 16; ++d) {
        float4 kv = kr[d];
        acc += kv.x * q[d * 4] + kv.y * q[d * 4 + 1] + kv.z * q[d * 4 + 2] + kv.w * q[d * 4 + 3];
      }
    } else {
      const uint2* kr = (const uint2*)(proj + (size_t)(TP + b * 4 + kj - 128) * NIN + 2304 + kvh * 64);
#pragma unroll
      for (int d = 0; d < 16; ++d) {
        uint2 kv = kr[d];
        acc += bflo(kv.x) * q[d * 4] + bfhi(kv.x) * q[d * 4 + 1] + bflo(kv.y) * q[d * 4 + 2] + bfhi(kv.y) * q[d * 4 + 3];
      }
    }
    Sc[qr * 136 + kj] = valid ? acc : -1e30f;
  }
  __syncthreads();
  {
    int qr = tid >> 4, l = tid & 15, g = qr >> 2;
    float sink = p.sinks[kvh * 4 + g];
    float mx = -1e30f;
    for (int kj = l; kj < 132; kj += 16) mx = fmaxf(mx, Sc[qr * 136 + kj]);
    mx = redmax16(mx);
    mx = fmaxf(mx, sink);
    float sum = 0.f;
    for (int kj = l; kj < 132; kj += 16) {
      float s = Sc[qr * 136 + kj];
      float e = (s > -1e29f) ? __expf(s - mx) : 0.f;
      Sc[qr * 136 + kj] = e;
      sum += e;
    }
    sum = red16(sum) + __expf(sink - mx);
    float inv = 1.f / sum;
    for (int kj = l; kj < 132; kj += 16) Sc[qr * 136 + kj] *= inv;
  }
  __syncthreads();
  {
    int qr = tid >> 4, d4 = (tid & 15) * 4, g = qr >> 2, s = qr & 3;
    float4 o = {0.f, 0.f, 0.f, 0.f};
    for (int kj = 0; kj < 128; ++kj) {
      float pw = Sc[qr * 136 + kj];
      float4 v = *(const float4*)(p.cache_v + (((size_t)b * 128 + kj) * 2 + kvh) * 64 + d4);
      o.x += pw * v.x; o.y += pw * v.y; o.z += pw * v.z; o.w += pw * v.w;
    }
    for (int kj = 128; kj < 132; ++kj) {
      float pw = Sc[qr * 136 + kj];
      uint2 v = *(const uint2*)(proj + (size_t)(TP + b * 4 + kj - 128) * NIN + 2432 + kvh * 64 + d4);
      o.x += pw * bflo(v.x); o.y += pw * bfhi(v.x); o.z += pw * bflo(v.y); o.w += pw * bfhi(v.y);
    }
    *(uint2*)(mix + (size_t)(TP + b * 4 + s) * 1024 + 512 + (kvh * 4 + g) * 64 + d4) =
        uint2{pack2bf(o.x, o.y), pack2bf(o.z, o.w)};
  }
  __syncthreads();
}

__device__ void phase4(const Params& p, char* smem) {
  constexpr int N_PS = 256, N_SS = 8192, N_AP = NB * 65 * 8, N_AS = 256;
  constexpr int N_CV = 32768 / 4, T_WOUT = 16 * 16, T_WQ = 16 * 32;
  int first, stride;
  if (gridDim.x >= 2 * N_PS) {
    if ((int)blockIdx.x < N_PS) {
      int t = blockIdx.x;
      int seq = t >> 3, rg = t & 7, b = seq >> 3, h = seq & 7;
      scan_task(p, smem, b * LP, LP, -1, h, rg, nullptr, p.out + O_WKVP + (size_t)seq * 4096);
      return;
    }
    first = N_PS + (blockIdx.x - N_PS);
    stride = gridDim.x - N_PS;
  } else {
    first = blockIdx.x;
    stride = gridDim.x;
  }
  for (int task = first; task < N_PS + N_SS + N_AP + N_AS + N_CV + T_WOUT + T_WQ; task += stride) {
    int t = task;
    if (t < N_PS) {
      int seq = t >> 3, rg = t & 7, b = seq >> 3, h = seq & 7;
      scan_task(p, smem, b * LP, LP, -1, h, rg, nullptr, p.out + O_WKVP + (size_t)seq * 4096);
      continue;
    }
    t -= N_PS;
    if (t < N_SS) {
      int seq = t >> 3, rg = t & 7, b = seq >> 3, h = seq & 7;
      scan_task(p, smem, TP + b * 4, 4, PREV0 + b, h, rg, p.state_wkv + (size_t)seq * 4096,
                p.out + O_WKVS + (size_t)seq * 4096);
      continue;
    }
    t -= N_SS;
    if (t < N_AP) { attn_prompt_task(p, smem, t); continue; }
    t -= N_AP;
    if (t < N_AS) { attn_sample_task(p, smem, t); continue; }
    t -= N_AS;
    if (t < N_CV) { convert_task(p, t); continue; }
    t -= N_CV;
    if (t < T_WOUT) { transpose_task(p.w_out, 1024, 1024, (u16*)(p.ws + WS_WOUT), t, smem); continue; }
    t -= T_WOUT;
    transpose_task(p.w_query, 1024, 2048, (u16*)(p.ws + WS_WQ), t, smem, p.norm2_g);
  }
}

struct PostC { float mu[3][8], ka[8], rk[8], lw[8], lb[8]; };

__device__ __forceinline__ void post_task(const Params& p, int task, const PostC& C) {
  const int wave = threadIdx.x >> 6, lane = threadIdx.x & 63;
  int row = task * 4 + wave;
  if (row >= TTOK) return;
  const u16* proj = (const u16*)(p.ws + WS_C);
  const float* yraw = p.out;
  const u16* ab = (const u16*)(p.ws + WS_A);
  const u16* gb = (const u16*)(p.ws + WS_G);
  u16* mix = (u16*)(p.ws + WS_B);
  int prow;
  if (row < TP) { int t = row % LP; prow = t > 0 ? row - 1 : -1; }
  else { int r = row - TP; prow = (r & 3) ? row - 1 : PREV0 + (r >> 2); }
  int c0 = lane * 8;
  float y[8];
  {
    float4 a = *(const float4*)(yraw + (size_t)row * 512 + c0), bq = *(const float4*)(yraw + (size_t)row * 512 + c0 + 4);
    y[0] = a.x; y[1] = a.y; y[2] = a.z; y[3] = a.w; y[4] = bq.x; y[5] = bq.y; y[6] = bq.z; y[7] = bq.w;
  }
  float s = 0.f;
#pragma unroll
  for (int e = 0; e < 8; ++e) s += y[e];
  float mean = red8(s) * (1.f / 64.f);
  float vs = 0.f;
#pragma unroll
  for (int e = 0; e < 8; ++e) { float d = y[e] - mean; vs += d * d; }
  float rstd = rsqrtf(red8(vs) * (1.f / 64.f) + 64e-5f);
  float xr[8], xk[8], xv[8];
  auto ld8 = [&](int coff, int mi, float* o) {
    uint4 a = *(const uint4*)(proj + (size_t)row * NIN + coff + c0);
    uint4 q = prow >= 0 ? *(const uint4*)(proj + (size_t)prow * NIN + coff + c0) : uint4{0, 0, 0, 0};
    unsigned ua[4] = {a.x, a.y, a.z, a.w}, uq[4] = {q.x, q.y, q.z, q.w};
#pragma unroll
    for (int e = 0; e < 4; ++e) {
      float x0 = bflo(ua[e]), x1 = bfhi(ua[e]), p0 = bflo(uq[e]), p1 = bfhi(uq[e]);
      float m0 = C.mu[mi][2 * e], m1 = C.mu[mi][2 * e + 1];
      o[2 * e] = x0 + (p0 - x0) * m0;
      o[2 * e + 1] = x1 + (p1 - x1) * m1;
    }
  };
  ld8(0, 0, xr);
  ld8(512, 1, xk);
  ld8(1024, 2, xv);
  float aa[8], gg[8];
  {
    uint4 a = *(const uint4*)(ab + (size_t)row * 512 + c0), g = *(const uint4*)(gb + (size_t)row * 512 + c0);
    unsigned ua[4] = {a.x, a.y, a.z, a.w}, ug[4] = {g.x, g.y, g.z, g.w};
#pragma unroll
    for (int e = 0; e < 4; ++e) {
      aa[2 * e] = bflo(ua[e]); aa[2 * e + 1] = bfhi(ua[e]);
      gg[2 * e] = bflo(ug[e]); gg[2 * e + 1] = bfhi(ug[e]);
    }
  }
  float bs = 0.f;
#pragma unroll
  for (int e = 0; e < 8; ++e) {
    float km = xk[e] * (1.f + (aa[e] - 1.f) * C.ka[e]);
    bs += xr[e] * km * C.rk[e];
  }
  bs = red8(bs);
  unsigned o[4];
#pragma unroll
  for (int e = 0; e < 4; ++e) {
    float v0 = ((y[2 * e] - mean) * rstd * C.lw[2 * e] + C.lb[2 * e] + bs * xv[2 * e]) * gg[2 * e];
    float v1 = ((y[2 * e + 1] - mean) * rstd * C.lw[2 * e + 1] + C.lb[2 * e + 1] + bs * xv[2 * e + 1]) * gg[2 * e + 1];
    o[e] = pack2bf(v0, v1);
  }
  *(uint4*)(mix + (size_t)row * 1024 + c0) = uint4{o[0], o[1], o[2], o[3]};
}

__device__ void phase5(const Params& p) {
  const int lane = threadIdx.x & 63, c0 = lane * 8;
  PostC C;
  auto ld = [&](const float* src, float* dst) {
    float4 a = *(const float4*)(src + c0), b = *(const float4*)(src + c0 + 4);
    dst[0] = a.x; dst[1] = a.y; dst[2] = a.z; dst[3] = a.w; dst[4] = b.x; dst[5] = b.y; dst[6] = b.z; dst[7] = b.w;
  };
  ld(p.mu, C.mu[0]); ld(p.mu + 512, C.mu[1]); ld(p.mu + 1024, C.mu[2]);
  ld(p.k_a, C.ka); ld(p.r_k, C.rk); ld(p.lnx_w, C.lw); ld(p.lnx_b, C.lb);
  for (int task = blockIdx.x; task < TTOK / 4; task += gridDim.x) post_task(p, task, C);
}

__device__ void phase6(const Params& p, char* smem) {
  const u16* mix = (const u16*)(p.ws + WS_B);
  const u16* wt = (const u16*)(p.ws + WS_WOUT);
  constexpr int MT = NOUT / 128, NT = 8;
  constexpr int N_CV = 0;
  const int wave = threadIdx.x >> 6, lane = threadIdx.x & 63;
  for (int task = xcd_vid(); task < MT * NT + N_CV; task += gridDim.x) {
    if (task < MT * NT) {
      int mt, nt;
      grouped_tile(task, MT, NT, mt, nt);
      int o0 = mt * 128;
      int arow = o0 + (o0 < 16384 ? 16 * (o0 / 4096 + 1) : 64);
      const float* xin = (o0 < 16384 ? p.x_prompt + (size_t)o0 * D : p.x_sample + (size_t)(o0 - 16384) * D) + nt * 128;
      float* xo = p.out + (size_t)o0 * D + nt * 128;
      u16* xb = (u16*)(p.ws + WS_X1B) + (size_t)o0 * D + nt * 128;
      float rs[4] = {0.f, 0.f, 0.f, 0.f};
      gemm_tile(mix + (size_t)arow * 1024, 1024, wt + (size_t)nt * 128 * 1024, 1024, 1024, smem,
                [&](int m, int r, int c, f32x4 v) {
                  float4 xi = *(const float4*)(xin + (size_t)r * D + c);
                  float4 xv = float4{xi.x + v[0], xi.y + v[1], xi.z + v[2], xi.w + v[3]};
                  *(float4*)(xo + (size_t)r * D + c) = xv;
                  *(uint2*)(xb + (size_t)r * D + c) = uint2{pack2bf(xv.x, xv.y), pack2bf(xv.z, xv.w)};
                  rs[m] += xv.x * xv.x + xv.y * xv.y + xv.z * xv.z + xv.w * xv.w;
                });
      {
        const int lane_ = threadIdx.x & 63, wid_ = threadIdx.x >> 6, wr_ = wid_ >> 1, wc_ = wid_ & 1;
        float* ssq = (float*)(p.ws + WS_SSQ);
#pragma unroll
        for (int m = 0; m < 4; ++m) {
          float t = rs[m];
          t += __shfl_xor(t, 16, 64);
          t += __shfl_xor(t, 32, 64);
          if ((lane_ >> 4) == 0) ssq[(size_t)(o0 + wr_ * 64 + m * 16 + (lane_ & 15)) * 16 + nt * 2 + wc_] = t;
        }
      }
    }
  }
}

__device__ void phase8(const Params& p, char* smem) {
  const u16* xb = (const u16*)(p.ws + WS_X1B);
  const u16* wt = (const u16*)(p.ws + WS_WQ);
  const float* ssq = (const float*)(p.ws + WS_SSQ);
  u16* q = (u16*)(p.ws + WS_Q);
  constexpr int MT = NOUT / 128, NT = 16, TOT = MT * NT;
  const int lane = threadIdx.x & 63, wr = (threadIdx.x >> 6) >> 1, fr = lane & 15;
  const int G = gridDim.x, full = p.full8, ntask = full + 4 * (TOT - full);
  auto row_rstd = [&](size_t row) {
    const float4* sp = (const float4*)(ssq + row * 16);
    float4 a = sp[0], b = sp[1], c = sp[2], d = sp[3];
    float ss = ((a.x + a.y) + (a.z + a.w)) + ((b.x + b.y) + (b.z + b.w)) + ((c.x + c.y) + (c.z + c.w)) + ((d.x + d.y) + (d.z + d.w));
    return rsqrtf(ss * (1.f / 1024.f) + 1e-5f);
  };
  for (int task = xcd_vid(); task < ntask; task += G) {
    int mt, nt;
    if (task < full) {
      grouped_tile(task, MT, NT, mt, nt);
      u16* crow = q + (size_t)mt * 128 * 2048 + nt * 128;
      float rstd[4];
#pragma unroll
      for (int m = 0; m < 4; ++m) rstd[m] = row_rstd((size_t)mt * 128 + wr * 64 + m * 16 + fr);
      gemm_tile(xb + (size_t)mt * 128 * D, D, wt + (size_t)nt * 128 * D, D, D, smem,
                [&](int m, int r, int c, f32x4 v) {
                  float sc = rstd[m];
                  *(uint2*)(crow + (size_t)r * 2048 + c) = uint2{pack2bf(v[0] * sc, v[1] * sc), pack2bf(v[2] * sc, v[3] * sc)};
                });
    } else {
      int rem = task - full, qd = rem & 3;
      grouped_tile(full + (rem >> 2), MT, NT, mt, nt);
      size_t r0 = (size_t)mt * 128 + qd * 32;
      u16* crow = q + r0 * 2048 + nt * 128;
      float rstd[2];
#pragma unroll
      for (int m = 0; m < 2; ++m) rstd[m] = row_rstd(r0 + m * 16 + fr);
      gemm_qtile(xb + r0 * D, D, wt + (size_t)nt * 128 * D, D, D, smem,
                 [&](int m, int r, int c, f32x4 v) {
                   float sc = rstd[m];
                   *(uint2*)(crow + (size_t)r * 2048 + c) = uint2{pack2bf(v[0] * sc, v[1] * sc), pack2bf(v[2] * sc, v[3] * sc)};
                 });
    }
  }
}

__device__ __forceinline__ unsigned ford(float f) {
  unsigned u = __float_as_uint(f);
  return (u & 0x80000000u) ? ~u : (u | 0x80000000u);
}
__device__ __forceinline__ float fdeord(unsigned k) {
  unsigned u = (k & 0x80000000u) ? (k & 0x7fffffffu) : ~k;
  return __uint_as_float(u);
}
__device__ __forceinline__ unsigned umax_(unsigned a, unsigned b) { return a > b ? a : b; }
__device__ __forceinline__ unsigned umin_(unsigned a, unsigned b) { return a < b ? a : b; }

#define CE_DESC(a, b) { unsigned _x = umax_(a, b), _y = umin_(a, b); a = _x; b = _y; }
#define CE_ASC(a, b) { unsigned _x = umin_(a, b), _y = umax_(a, b); a = _x; b = _y; }

template <int N>
__device__ __forceinline__ void bitonic_sort_desc(unsigned (&k)[N]) {
#pragma unroll
  for (int sz = 2; sz <= N; sz <<= 1) {
#pragma unroll
    for (int st = sz >> 1; st > 0; st >>= 1) {
#pragma unroll
      for (int i = 0; i < N; ++i) {
        int l = i ^ st;
        if (l > i) {
          if ((i & sz) == 0) CE_DESC(k[i], k[l]) else CE_ASC(k[i], k[l])
        }
      }
    }
  }
}
template <int N>
__device__ __forceinline__ void bitonic_merge_desc(unsigned (&k)[N]) {
#pragma unroll
  for (int st = N >> 1; st > 0; st >>= 1) {
#pragma unroll
    for (int i = 0; i < N; ++i) {
      int l = i ^ st;
      if (l > i) CE_DESC(k[i], k[l])
    }
  }
}
__device__ __forceinline__ void cross_merge16(unsigned (&k)[16]) {
#pragma unroll
  for (int x = 16; x <= 32; x <<= 1) {
    unsigned o[16];
#pragma unroll
    for (int i = 0; i < 16; ++i) o[i] = (unsigned)__shfl_xor((int)k[i], x, 64);
#pragma unroll
    for (int i = 0; i < 16; ++i) k[i] = umax_(k[i], o[15 - i]);
    bitonic_merge_desc<16>(k);
  }
}

__device__ __forceinline__ unsigned sel16(const unsigned (&a)[16], int k) {
  unsigned r = a[0];
#pragma unroll
  for (int i = 1; i < 16; ++i) r = (k == i) ? a[i] : r;
  return r;
}

__device__ void topk_unit(const Params& p, const char* smem, int tg, int h) {
  const int tid = threadIdx.x, lane = tid & 63, fr = lane & 15, fq = lane >> 4;
  const u16* q = (const u16*)(p.ws + WS_Q);
  int* idxo = (int*)(p.ws + WS_IDX);
  float* gateo = (float*)(p.ws + WS_GATE);
  const int o0 = tg * 16;
  float v1[16], v2[16];
  unsigned pk1[4] = {0u, 0u, 0u, 0u}, pk2[4] = {0u, 0u, 0u, 0u};
#pragma unroll
  for (int c = 0; c < 2; ++c) {
    bf16x8 qb[4];
#pragma unroll
    for (int ks = 0; ks < 4; ++ks)
      qb[ks] = *(const bf16x8*)(q + (size_t)(o0 + fr) * 2048 + (h * 2 + c) * 128 + ks * 32 + fq * 8);
    f32x4 acc[8];
#pragma unroll
    for (int i = 0; i < 8; ++i) acc[i] = f32x4{0.f, 0.f, 0.f, 0.f};
#pragma unroll
    for (int ks = 0; ks < 4; ++ks) {
#pragma unroll
      for (int mt = 0; mt < 8; ++mt) {
        bf16x8 ka = *(const bf16x8*)(smem + (c * 128 + mt * 16 + fr) * 256 + (((ks * 4 + fq) ^ fr) << 4));
        acc[mt] = mfma16(ka, qb[ks], acc[mt]);
      }
      __builtin_amdgcn_sched_barrier(0);
    }
    unsigned lo[16], hi[16];
#pragma unroll
    for (int mt = 0; mt < 4; ++mt)
#pragma unroll
      for (int j = 0; j < 4; ++j) {
        lo[mt * 4 + j] = (ford(acc[mt][j]) & 0xffffff80u) | (unsigned)(127 - (mt * 16 + fq * 4 + j));
        hi[mt * 4 + j] = (ford(acc[mt + 4][j]) & 0xffffff80u) | (unsigned)(127 - ((mt + 4) * 16 + fq * 4 + j));
      }
    bitonic_sort_desc<16>(lo);
    bitonic_sort_desc<16>(hi);
#pragma unroll
    for (int i = 0; i < 16; ++i) lo[i] = umax_(lo[i], hi[15 - i]);
    bitonic_merge_desc<16>(lo);
    cross_merge16(lo);
#pragma unroll
    for (int i = 0; i < 16; ++i) {
      float val = fdeord(lo[i] & 0xffffff80u);
      unsigned ix = (127u - (lo[i] & 0x7fu)) << ((i & 3) * 8);
      if (c == 0) { v1[i] = val; pk1[i >> 2] |= ix; } else { v2[i] = val; pk2[i >> 2] |= ix; }
    }
  }
  unsigned ck[16];
#define CAND(i, j) ((ford(v1[i] + v2[j]) & 0xffffff00u) | (unsigned)((i) * 16 + (j)))
#define SEL4(slot, A, B, C, Dv) ck[slot] = (fq == 0) ? (A) : (fq == 1) ? (B) : (fq == 2) ? (C) : (Dv);
  SEL4(0, CAND(0, 0), CAND(1, 0), CAND(3, 3), CAND(14, 0))
  SEL4(1, CAND(0, 1), CAND(1, 1), CAND(4, 0), CAND(15, 0))
  SEL4(2, CAND(0, 2), CAND(1, 2), CAND(4, 1), 0u)
  SEL4(3, CAND(0, 3), CAND(1, 3), CAND(4, 2), 0u)
  SEL4(4, CAND(0, 4), CAND(1, 4), CAND(5, 0), 0u)
  SEL4(5, CAND(0, 5), CAND(1, 5), CAND(5, 1), 0u)
  SEL4(6, CAND(0, 6), CAND(1, 6), CAND(6, 0), 0u)
  SEL4(7, CAND(0, 7), CAND(1, 7), CAND(6, 1), 0u)
  SEL4(8, CAND(0, 8), CAND(2, 0), CAND(7, 0), 0u)
  SEL4(9, CAND(0, 9), CAND(2, 1), CAND(7, 1), 0u)
  SEL4(10, CAND(0, 10), CAND(2, 2), CAND(8, 0), 0u)
  SEL4(11, CAND(0, 11), CAND(2, 3), CAND(9, 0), 0u)
  SEL4(12, CAND(0, 12), CAND(2, 4), CAND(10, 0), 0u)
  SEL4(13, CAND(0, 13), CAND(3, 0), CAND(11, 0), 0u)
  SEL4(14, CAND(0, 14), CAND(3, 1), CAND(12, 0), 0u)
  SEL4(15, CAND(0, 15), CAND(3, 2), CAND(13, 0), 0u)
#undef SEL4
#undef CAND
  bitonic_sort_desc<16>(ck);
  cross_merge16(ck);
  float top[16], esum = 0.f;
#pragma unroll
  for (int i = 0; i < 16; ++i) top[i] = fdeord(ck[i] & 0xffffff00u);
  const float tmax = top[0];
#pragma unroll
  for (int i = 0; i < 16; ++i) top[i] = __expf(top[i] - tmax);
#pragma unroll
  for (int i = 0; i < 16; ++i) esum += top[i];
  float inv = 1.f / esum;
  int oi[4];
  float og[4];
#pragma unroll
  for (int jj = 0; jj < 4; ++jj) {
    unsigned kk = (fq == 0) ? ck[jj] : (fq == 1) ? ck[4 + jj] : (fq == 2) ? ck[8 + jj] : ck[12 + jj];
    float tv = (fq == 0) ? top[jj] : (fq == 1) ? top[4 + jj] : (fq == 2) ? top[8 + jj] : top[12 + jj];
    int code = (int)(kk & 0xffu);
    int ci = code >> 4, cj = code & 15;
    unsigned d1 = (ci < 8) ? ((ci < 4) ? pk1[0] : pk1[1]) : ((ci < 12) ? pk1[2] : pk1[3]);
    unsigned d2 = (cj < 8) ? ((cj < 4) ? pk2[0] : pk2[1]) : ((cj < 12) ? pk2[2] : pk2[3]);
    int i1 = (int)((d1 >> ((ci & 3) * 8)) & 0xffu), i2 = (int)((d2 >> ((cj & 3) * 8)) & 0xffu);
    oi[jj] = i1 * 128 + i2;
    og[jj] = tv * inv;
  }
  size_t ob = (size_t)(o0 + fr) * 128 + h * 16 + fq * 4;
  *(int4*)(idxo + ob) = int4{oi[0], oi[1], oi[2], oi[3]};
  *(float4*)(gateo + ob) = float4{og[0], og[1], og[2], og[3]};
}

__device__ void phase9(const Params& p, char* smem) {
  const int w = threadIdx.x >> 6;
  {
    const u16* subk = (const u16*)(p.ws + WS_SUBK);
    for (int i = threadIdx.x; i < 4096; i += 256) {
      int row = i >> 4, lc = i & 15;
      *(uint4*)(smem + row * 256 + ((lc ^ (row & 15)) << 4)) = *(const uint4*)(subk + row * 128 + lc * 8);
    }
    __syncthreads();
  }
  for (int task = blockIdx.x; task < (NOUT / 16) * 2; task += gridDim.x) {
    int tg = task >> 1, h = (task & 1) * 4 + w;
    topk_unit(p, smem, tg, h);
  }
  __syncthreads();
}

#define F4(w, b) __builtin_amdgcn_cvt_scalef32_pk_f32_fp4((w), 1.0f, (b))
__device__ __forceinline__ float dot16f8(const float* h, uint2 u, float acc) {
  const float2v* h2 = (const float2v*)h;
  float2v a2 = {acc, 0.f};
  unsigned w[2] = {u.x, u.y};
#pragma unroll
  for (int i = 0; i < 2; ++i) {
    a2 = __builtin_elementwise_fma(h2[4 * i], F4(w[i], 0), a2);
    a2 = __builtin_elementwise_fma(h2[4 * i + 1], F4(w[i], 1), a2);
    a2 = __builtin_elementwise_fma(h2[4 * i + 2], F4(w[i], 2), a2);
    a2 = __builtin_elementwise_fma(h2[4 * i + 3], F4(w[i], 3), a2);
  }
  return a2.x + a2.y;
}
__device__ __forceinline__ void axpy16f8(float a, uint2 v, float* acc) {
  float2v* c2 = (float2v*)acc;
  const float2v aa = {a, a};
  unsigned w[2] = {v.x, v.y};
#pragma unroll
  for (int i = 0; i < 2; ++i) {
    c2[4 * i] = __builtin_elementwise_fma(aa, F4(w[i], 0), c2[4 * i]);
    c2[4 * i + 1] = __builtin_elementwise_fma(aa, F4(w[i], 1), c2[4 * i + 1]);
    c2[4 * i + 2] = __builtin_elementwise_fma(aa, F4(w[i], 2), c2[4 * i + 2]);
    c2[4 * i + 3] = __builtin_elementwise_fma(aa, F4(w[i], 3), c2[4 * i + 3]);
  }
}
__device__ __forceinline__ float reduce4(float d0, float d1, float d2, float d3) {
  auto s1 = __builtin_amdgcn_permlane32_swap(__float_as_uint(d0), __float_as_uint(d1), false, false);
  float s01 = __uint_as_float(s1[0]) + __uint_as_float(s1[1]);
  auto s2 = __builtin_amdgcn_permlane32_swap(__float_as_uint(d2), __float_as_uint(d3), false, false);
  float s23 = __uint_as_float(s2[0]) + __uint_as_float(s2[1]);
  auto s3 = __builtin_amdgcn_permlane16_swap(__float_as_uint(s01), __float_as_uint(s23), false, false);
  float t = __uint_as_float(s3[0]) + __uint_as_float(s3[1]);
  return red16(t);
}

__device__ void gather_task(const Params& p, int task) {
  const int wave = threadIdx.x >> 6, lane = threadIdx.x & 63;
  int o = task * 4 + wave;
  const unsigned char* eu8 = (const unsigned char*)(p.ws + WS_EU) + lane * 8;
  const unsigned char* ev8 = (const unsigned char*)(p.ws + WS_EV) + lane * 8;
  const float* scu = (const float*)(p.ws + WS_SCU);
  const float* scv = (const float*)(p.ws + WS_SCV);
  const int* idx = (const int*)(p.ws + WS_IDX) + (size_t)o * 128;
  const float* gate = (const float*)(p.ws + WS_GATE) + (size_t)o * 128;
  float* xrow = p.out + (size_t)o * D + lane * 16;
  __attribute__((aligned(8))) float hf[16];
  {
    float x[16];
#pragma unroll
    for (int i = 0; i < 4; ++i) {
      float4 a = ((const float4*)xrow)[i];
      x[4 * i] = a.x; x[4 * i + 1] = a.y; x[4 * i + 2] = a.z; x[4 * i + 3] = a.w;
    }
    float ss2 = 0.f;
#pragma unroll
    for (int i = 0; i < 16; ++i) ss2 += x[i] * x[i];
    ss2 = wave_sum(ss2);
    float sc2 = rsqrtf(ss2 * (1.f / 1024.f) + 1e-5f);
    const float* g2 = p.norm2_g + lane * 16;
#pragma unroll
    for (int i = 0; i < 4; ++i) {
      float4 gg = ((const float4*)g2)[i];
      hf[4 * i] = x[4 * i] * sc2 * gg.x; hf[4 * i + 1] = x[4 * i + 1] * sc2 * gg.y;
      hf[4 * i + 2] = x[4 * i + 2] * sc2 * gg.z; hf[4 * i + 3] = x[4 * i + 3] * sc2 * gg.w;
    }
  }
  __attribute__((aligned(8))) float acc[16];
#pragma unroll
  for (int i = 0; i < 16; ++i) acc[i] = 0.f;
  const int rw = lane >> 4;
  const int kl = (lane & 3) * 4 + ((rw == 1) ? 2 : (rw == 2) ? 1 : rw);
  for (int kb = 0; kb < 8; ++kb) {
    int myidx = idx[kb * 16 + (lane & 15)];
    int myidx2 = idx[kb * 16 + kl];
    float mygate = gate[kb * 16 + kl];
    float su = scu[myidx2], sv = scv[myidx2];
    float mypre = 0.f;
    {
      uint2 ua[16];
#pragma unroll
      for (int e = 0; e < 16; ++e) {
        int ei = __builtin_amdgcn_readlane(myidx, e);
        ua[e] = *(const uint2*)(eu8 + (size_t)ei * 512);
      }
#pragma unroll
      for (int g = 0; g < 4; ++g) {
        float d0 = dot16f8(hf, ua[4 * g], 0.f), d1 = dot16f8(hf, ua[4 * g + 1], 0.f), d2 = dot16f8(hf, ua[4 * g + 2], 0.f),
              d3 = dot16f8(hf, ua[4 * g + 3], 0.f);
        float tot = reduce4(d0, d1, d2, d3);
        mypre = ((lane & 3) == g) ? tot : mypre;
      }
    }
    mypre *= su;
    float myact = 0.5f * mypre * (1.f + erff(mypre * 0.70710678118654752f)) * mygate * sv;
#pragma unroll
    for (int e8 = 0; e8 < 2; ++e8) {
      uint2 va[8];
      float a[8];
#pragma unroll
      for (int e = 0; e < 8; ++e) {
        int ei = __builtin_amdgcn_readlane(myidx, e8 * 8 + e);
        const int e3 = e & 3, e4 = e8 * 2 + (e >> 2);
        const int pr = (e3 == 1) ? 2 : (e3 == 2) ? 1 : e3;
        a[e] = rdlane(myact, pr * 16 + e4);
        va[e] = *(const uint2*)(ev8 + (size_t)ei * 512);
      }
#pragma unroll
      for (int e = 0; e < 8; ++e) axpy16f8(a[e], va[e], acc);
    }
  }
  float x[16];
#pragma unroll
  for (int i = 0; i < 4; ++i) {
    float4 a = ((const float4*)xrow)[i];
    x[4 * i] = a.x; x[4 * i + 1] = a.y; x[4 * i + 2] = a.z; x[4 * i + 3] = a.w;
  }
  float ss = 0.f;
#pragma unroll
  for (int i = 0; i < 16; ++i) { x[i] += acc[i]; ss += x[i] * x[i]; }
  ss = wave_sum(ss);
  float sc = rsqrtf(ss * (1.f / 1024.f) + 1e-5f);
  const float* g = p.final_g + lane * 16;
#pragma unroll
  for (int i = 0; i < 4; ++i) {
    float4 gg = ((const float4*)g)[i];
    ((float4*)xrow)[i] = float4{x[4 * i] * sc * gg.x, x[4 * i + 1] * sc * gg.y, x[4 * i + 2] * sc * gg.z, x[4 * i + 3] * sc * gg.w};
  }
}

__device__ void gather_task_block(const Params& p, char* smem, int o) {
  const int wave = threadIdx.x >> 6, lane = threadIdx.x & 63;
  const unsigned char* eu8 = (const unsigned char*)(p.ws + WS_EU) + lane * 8;
  const unsigned char* ev8 = (const unsigned char*)(p.ws + WS_EV) + lane * 8;
  const float* scu = (const float*)(p.ws + WS_SCU);
  const float* scv = (const float*)(p.ws + WS_SCV);
  const int* idx = (const int*)(p.ws + WS_IDX) + (size_t)o * 128;
  const float* gate = (const float*)(p.ws + WS_GATE) + (size_t)o * 128;
  float* orow = p.out + (size_t)o * D;
  __attribute__((aligned(8))) float hf[16];
  {
    const float* xrow = orow + lane * 16;
    float x[16];
#pragma unroll
    for (int i = 0; i < 4; ++i) {
      float4 a = ((const float4*)xrow)[i];
      x[4 * i] = a.x; x[4 * i + 1] = a.y; x[4 * i + 2] = a.z; x[4 * i + 3] = a.w;
    }
    float ss2 = 0.f;
#pragma unroll
    for (int i = 0; i < 16; ++i) ss2 += x[i] * x[i];
    ss2 = wave_sum(ss2);
    float sc2 = rsqrtf(ss2 * (1.f / 1024.f) + 1e-5f);
    const float* g2 = p.norm2_g + lane * 16;
#pragma unroll
    for (int i = 0; i < 4; ++i) {
      float4 gg = ((const float4*)g2)[i];
      hf[4 * i] = x[4 * i] * sc2 * gg.x; hf[4 * i + 1] = x[4 * i + 1] * sc2 * gg.y;
      hf[4 * i + 2] = x[4 * i + 2] * sc2 * gg.z; hf[4 * i + 3] = x[4 * i + 3] * sc2 * gg.w;
    }
  }
  __attribute__((aligned(8))) float acc[16];
#pragma unroll
  for (int i = 0; i < 16; ++i) acc[i] = 0.f;
  const int rw = lane >> 4;
  const int kl = (lane & 3) * 4 + ((rw == 1) ? 2 : (rw == 2) ? 1 : rw);
#pragma unroll
  for (int kq = 0; kq < 2; ++kq) {
    const int kb = wave * 2 + kq;
    int myidx = idx[kb * 16 + (lane & 15)];
    int myidx2 = idx[kb * 16 + kl];
    float mygate = gate[kb * 16 + kl];
    float su = scu[myidx2], sv = scv[myidx2];
    float mypre = 0.f;
#pragma unroll
    for (int e8 = 0; e8 < 2; ++e8) {
      uint2 ua[8];
#pragma unroll
      for (int e = 0; e < 8; ++e) {
        int ei = __builtin_amdgcn_readlane(myidx, e8 * 8 + e);
        ua[e] = *(const uint2*)(eu8 + (size_t)ei * 512);
      }
      float d[8];
#pragma unroll
      for (int e = 0; e < 8; ++e) d[e] = dot16f8(hf, ua[e], 0.f);
      float tot0 = reduce4(d[0], d[1], d[2], d[3]);
      float tot1 = reduce4(d[4], d[5], d[6], d[7]);
      mypre = ((lane & 3) == e8 * 2) ? tot0 : mypre;
      mypre = ((lane & 3) == e8 * 2 + 1) ? tot1 : mypre;
    }
    mypre *= su;
    float myact = 0.5f * mypre * (1.f + erff(mypre * 0.70710678118654752f)) * mygate * sv;
#pragma unroll
    for (int e8 = 0; e8 < 2; ++e8) {
      uint2 va[8];
      float a[8];
#pragma unroll
      for (int e = 0; e < 8; ++e) {
        int ei = __builtin_amdgcn_readlane(myidx, e8 * 8 + e);
        const int e3 = e & 3, e4 = e8 * 2 + (e >> 2);
        const int pr = (e3 == 1) ? 2 : (e3 == 2) ? 1 : e3;
        a[e] = rdlane(myact, pr * 16 + e4);
        va[e] = *(const uint2*)(ev8 + (size_t)ei * 512);
      }
#pragma unroll
      for (int e = 0; e < 8; ++e) axpy16f8(a[e], va[e], acc);
    }
  }
  float* part = (float*)smem;
  float* red = part + 4096;
#pragma unroll
  for (int i = 0; i < 4; ++i)
    *(float4*)(part + wave * 1024 + lane * 16 + 4 * i) = float4{acc[4 * i], acc[4 * i + 1], acc[4 * i + 2], acc[4 * i + 3]};
  __syncthreads();
  const int c = threadIdx.x * 4;
  float4 xv = *(const float4*)(orow + c);
#pragma unroll
  for (int k = 0; k < 4; ++k) {
    float4 pv = *(const float4*)(part + k * 1024 + c);
    xv.x += pv.x; xv.y += pv.y; xv.z += pv.z; xv.w += pv.w;
  }
  float ss = wave_sum(xv.x * xv.x + xv.y * xv.y + xv.z * xv.z + xv.w * xv.w);
  if (lane == 0) red[wave] = ss;
  __syncthreads();
  ss = (red[0] + red[1]) + (red[2] + red[3]);
  float sc = rsqrtf(ss * (1.f / 1024.f) + 1e-5f);
  float4 gg = *(const float4*)(p.final_g + c);
  *(float4*)(orow + c) = float4{xv.x * sc * gg.x, xv.y * sc * gg.y, xv.z * sc * gg.z, xv.w * sc * gg.w};
  __syncthreads();
}

__device__ void phase10(const Params& p, char* smem) {
  const int G = gridDim.x, full = p.full10;
  for (int task = blockIdx.x; task < full; task += G) gather_task(p, task);
  for (int o = full * 4 + blockIdx.x; o < NOUT; o += G) gather_task_block(p, smem, o);
}

#define XB_TMO      128
#define XB_XCNT(j)  (256  + 64 * (j))
#define XB_XSUB(j)  (1280 + 64 * (j))
#define XB_XGEN(j)  (2304 + 64 * (j))
#define XB_TOP      3328
#define XB_TOPGEN   3392
#define XCD_BAR_WORDS 3456
#define XB_SPIN_CAP (1u << 20)
__device__ __forceinline__ unsigned xb_ld(unsigned* p) { return __hip_atomic_load(p, __ATOMIC_RELAXED, __HIP_MEMORY_SCOPE_AGENT); }
__device__ __forceinline__ unsigned xb_add(unsigned* p, unsigned v) { return __hip_atomic_fetch_add(p, v, __ATOMIC_RELAXED, __HIP_MEMORY_SCOPE_AGENT); }
__device__ __forceinline__ unsigned xb_xcc_id() { return (unsigned)__builtin_amdgcn_s_getreg((3 << 11) | 20) & 0xFu; }
#define XB_SPIN(cond, bar) do { unsigned _sp = 0; while (cond) { __builtin_amdgcn_s_sleep(1); \
    if ((++_sp & 255u) == 0u) { if (xb_ld(&(bar)[XB_TMO])) break; if (_sp > XB_SPIN_CAP) { atomicAdd(&(bar)[XB_TMO], 1u); break; } } } } while (0)

struct GridBar { int dummy; };

__device__ __forceinline__ GridBar gb_init(unsigned* bar) {
  GridBar b;
  b.dummy = 0;
  if (threadIdx.x == 0) (void)xb_add(&bar[XB_XCNT(xb_xcc_id())], 1u);
  return b;
}
__device__ __forceinline__ void gb_census(unsigned* bar, unsigned x, unsigned& nloc, unsigned& nx) {
  const unsigned G = gridDim.x;
  unsigned sum, cnt, mine, sp = 0u;
  for (;;) {
    sum = 0u; cnt = 0u; mine = 0u;
#pragma unroll
    for (unsigned j = 0; j < 16; ++j) {
      const unsigned c = xb_ld(&bar[XB_XCNT(j)]);
      sum += c; cnt += (c > 0u) ? 1u : 0u; mine = (j == x) ? c : mine;
    }
    if (sum == G) break;
    __builtin_amdgcn_s_sleep(1);
    if ((++sp & 255u) == 0u) { if (xb_ld(&bar[XB_TMO])) break; if (sp > XB_SPIN_CAP) { atomicAdd(&bar[XB_TMO], 1u); break; } }
  }
  nloc = mine > 0u ? mine : 1u; nx = cnt > 0u ? cnt : 1u;
}
template <bool FIRST>
__device__ __forceinline__ void gb_sync(GridBar& b, unsigned* bar) {
  asm volatile("s_waitcnt vmcnt(0)" ::: "memory");
  __syncthreads();
  if (threadIdx.x == 0) {
    const unsigned x = xb_xcc_id();
    __builtin_amdgcn_s_waitcnt(0);
    unsigned* slot = bar + 4096 + 2 * blockIdx.x;
    unsigned nloc, nx;
    if (FIRST) { gb_census(bar, x, nloc, nx); slot[0] = nloc; slot[1] = nx; }
    else { nloc = __hip_atomic_load(&slot[0], __ATOMIC_RELAXED, __HIP_MEMORY_SCOPE_AGENT); nx = __hip_atomic_load(&slot[1], __ATOMIC_RELAXED, __HIP_MEMORY_SCOPE_AGENT); }
    const unsigned old = xb_add(&bar[XB_XSUB(x)], 1u);
    const unsigned gen = old / nloc;
    if (old + 1u == (gen + 1u) * nloc) {
      __builtin_amdgcn_fence(__ATOMIC_RELEASE, "agent");
      asm volatile("s_waitcnt vmcnt(0)" ::: "memory");
      const unsigned og = xb_add(&bar[XB_TOP], 1u);
      const unsigned tg = og / nx;
      if (og + 1u == (tg + 1u) * nx) xb_add(&bar[XB_TOPGEN], 1u);
      else XB_SPIN(xb_ld(&bar[XB_TOPGEN]) == tg, bar);
      __builtin_amdgcn_fence(__ATOMIC_ACQUIRE, "agent");
      xb_add(&bar[XB_XGEN(x)], 1u);
      asm volatile("s_waitcnt vmcnt(0)" ::: "memory");
    } else {
      XB_SPIN(xb_ld(&bar[XB_XGEN(x)]) == gen, bar);
      __builtin_amdgcn_fence(__ATOMIC_ACQUIRE, "agent");
      asm volatile("s_waitcnt vmcnt(0)" ::: "memory");
    }
  }
  __syncthreads();
}

template <int PH>
__device__ __forceinline__ void run_phase(const Params& p, char* smem) {
  if constexpr (PH == 0) phase0(p, smem);
  if constexpr (PH == 1) phase1(p, smem);
  if constexpr (PH == 2) phase2(p);
  if constexpr (PH == 3) phase3(p, smem);
  if constexpr (PH == 4) phase4(p, smem);
  if constexpr (PH == 5) phase5(p);
  if constexpr (PH == 6) phase6(p, smem);
  if constexpr (PH == 8) phase8(p, smem);
  if constexpr (PH == 9) phase9(p, smem);
  if constexpr (PH == 10) phase10(p, smem);
}

template <int LO, int HI>
__device__ __forceinline__ void run_range(const Params& p, char* smem, GridBar& gb) {
  if constexpr (LO < HI) {
    run_phase<LO>(p, smem);
    if constexpr (LO + 1 < HI) {
      if constexpr (LO != 7) gb_sync<LO == 0>(gb, (unsigned*)(p.ws + WS_BAR));
      run_range<LO + 1, HI>(p, smem, gb);
    }
  }
}

template <int LO, int HI>
__global__ void __launch_bounds__(256, 2) fwd_kernel(Params p) {
  __shared__ __attribute__((aligned(16))) char smem[SMEM_BYTES];
  if (p.ws == nullptr) cg::this_grid().sync();
  GridBar gb = gb_init((unsigned*)(p.ws + WS_BAR));
  run_range<LO, HI>(p, smem, gb);
}

template <int PH>
static void launch_one(const Params& p, int grid, hipStream_t stream) {
  fwd_kernel<PH, PH + 1><<<grid, 256, 0, stream>>>(p);
}

extern "C" void kernel_launch(void* const* d_in, const int* in_sizes, int n_in, void* d_out, int out_size, void* d_ws,
                              size_t ws_size, hipStream_t stream) {
  Params p{};
  const float** pp = (const float**)&p;
  for (int i = 0; i < 28; ++i) pp[i] = (const float*)d_in[i];
  p.out = (float*)d_out;
  p.ws = (char*)d_ws;
#if MULTI_LAUNCH
  const int grid = 1024;
  p.full1 = ((MROWS / 128) * 20 / grid) * grid; p.full8 = ((NOUT / 128) * 16 / grid) * grid; p.full10 = ((NOUT / 4) / grid) * grid; p.pad_ = 0;
  launch_one<0>(p, grid, stream);
  launch_one<1>(p, grid, stream);
  launch_one<2>(p, grid, stream);
  launch_one<3>(p, grid, stream);
  launch_one<4>(p, grid, stream);
  launch_one<5>(p, grid, stream);
  launch_one<6>(p, grid, stream);
  launch_one<7>(p, grid, stream);
  launch_one<8>(p, grid, stream);
  launch_one<9>(p, grid, stream);
  launch_one<10>(p, grid, stream);
#else
  static int grid_blocks = 0;
  if (!grid_blocks) {
    int dev = 0, cus = 0, per_cu = 0;
    (void)hipGetDevice(&dev);
    (void)hipDeviceGetAttribute(&cus, hipDeviceAttributeMultiprocessorCount, dev);
    (void)hipOccupancyMaxActiveBlocksPerMultiprocessor(&per_cu, fwd_kernel<0, NPH>, 256, 0);
    if (per_cu < 1) per_cu = 1;
    if (per_cu > 4) per_cu = 4;
    grid_blocks = cus * per_cu;
  }
  (void)hipMemsetAsync((char*)d_ws + WS_BAR, 0, XCD_BAR_WORDS * sizeof(unsigned), stream);
  p.full1 = ((MROWS / 128) * 20 / grid_blocks) * grid_blocks;
  p.full8 = ((NOUT / 128) * 16 / grid_blocks) * grid_blocks;
  p.full10 = ((NOUT / 4) / grid_blocks) * grid_blocks;
  p.pad_ = 0;
  void* args[] = {&p};
  hipError_t e = hipLaunchCooperativeKernel((void*)fwd_kernel<0, NPH>, dim3(grid_blocks), dim3(256), args, 0, stream);
  if (e != hipSuccess) fprintf(stderr, "cooperative launch failed: %s (grid %d)\n", hipGetErrorString(e), grid_blocks);
#endif
}
```

```cpp
#include <hip/hip_runtime.h>
#include <hip/hip_cooperative_groups.h>
#include <cstdio>
#include <cstdint>
namespace cg = cooperative_groups;

typedef unsigned short u16;
using bf16x8 = __attribute__((ext_vector_type(8))) short;
using f32x4 = __attribute__((ext_vector_type(4))) float;
using half2v = __attribute__((ext_vector_type(2))) _Float16;
using float2v = __attribute__((ext_vector_type(2))) float;

#ifndef MULTI_LAUNCH
#define MULTI_LAUNCH 0
#endif

constexpr int D = 1024, NIN = 2560;
constexpr int LP = 4112, NB = 4, TP = NB * LP;
constexpr int SB = 128, TS = 512;
constexpr int TTOK = TP + TS;
constexpr int PREV0 = TTOK;
constexpr int MROWS = 17152;
constexpr int TPAD = 17024;
constexpr int NOUT = 16896;
constexpr int PAST = 8192;
constexpr int NPH = 11;

constexpr size_t O_YP = 0;
constexpr size_t O_KWP = 17301504, O_VWP = 17367040, O_WKVP = 17432576, O_SHP = 17563648;
constexpr size_t O_KWS = 17567744, O_VWS = 19664896, O_WKVS = 21762048, O_SHS = 25956352;

constexpr size_t WS_WIN = 0;
constexpr size_t WS_WOUT = WS_WIN + 2560ull * 1024 * 2;
constexpr size_t WS_WQ = WS_WOUT + 1024ull * 1024 * 2;
constexpr size_t WS_SUBK = WS_WQ + 2048ull * 1024 * 2;
constexpr size_t WS_W2W = WS_SUBK + 2ull * 128 * 128 * 2;
constexpr size_t WS_W2A = WS_W2W + 512ull * 64 * 2;
constexpr size_t WS_W2G = WS_W2A + 512ull * 64 * 2;
constexpr size_t WS_B = WS_W2G + 512ull * 128 * 2;
constexpr size_t WS_C = WS_B + (size_t)MROWS * 1024 * 2;
constexpr size_t WS_D = WS_C + (size_t)MROWS * NIN * 2;
constexpr size_t WS_E = WS_D + (size_t)TPAD * 512 * 8;
constexpr size_t WS_END = WS_E + (size_t)TPAD * 512 * 4;
constexpr size_t WS_DEC = WS_D, WS_A = WS_D + (size_t)TPAD * 512 * 4, WS_G = WS_A + (size_t)TPAD * 512 * 2;
constexpr size_t WS_EU = WS_E, WS_EV = WS_E + 16384ull * 512, WS_SCU = WS_EV + 16384ull * 512, WS_SCV = WS_SCU + 65536;
constexpr size_t WS_X1B = WS_D, WS_SSQ = WS_D + 40ull * 1024 * 1024;
constexpr size_t WS_Q = WS_C, WS_IDX = WS_C + (size_t)NOUT * 2048 * 2, WS_GATE = WS_IDX + (size_t)NOUT * 128 * 4;
static_assert(WS_SCV + 65536 <= WS_END, "expert tables overflow region E");
static_assert(WS_X1B + (size_t)NOUT * 2048 <= WS_SSQ && WS_SSQ + (size_t)NOUT * 64 <= WS_E, "x1b/ssq overflow region D");
static_assert(WS_GATE + (size_t)NOUT * 128 * 4 <= WS_D, "idx/gate overflow region C");
constexpr size_t WS_BAR = WS_END;
static_assert(WS_BAR + 32768 <= 256ull * 1024 * 1024, "workspace too large");

constexpr int SMEM_BYTES = 65536;

struct Params {
  const float *x_prompt, *x_sample, *cache_k, *cache_v, *state_wkv, *state_shift, *meta, *norm1_g, *w_in, *mu, *w0,
      *w2w, *a0, *w2a, *w2g, *k_k, *k_a, *r_k, *lnx_w, *lnx_b, *sinks, *w_out, *norm2_g, *w_query, *sub_keys, *eu,
      *ev, *final_g;
  float* out;
  char* ws;
  int full1, full8, full10, pad_;
};

__constant__ double INVF[8] = {1.0, 0.19392274474868576, 0.03760603093086393, 0.007292664737217109,
                               0.001414213562373095, 0.0002742481756762073, 5.318295896944988e-05,
                               1.031338537721246e-05};

__device__ __forceinline__ u16 f2bf(float f) {
  unsigned u = __float_as_uint(f);
  u += 0x7fffu + ((u >> 16) & 1u);
  return (u16)(u >> 16);
}
__device__ __forceinline__ float bf2f(u16 h) { return __uint_as_float(((unsigned)h) << 16); }
__device__ __forceinline__ float bflo(unsigned u) { return __uint_as_float(u << 16); }
__device__ __forceinline__ float bfhi(unsigned u) { return __uint_as_float(u & 0xffff0000u); }
__device__ __forceinline__ unsigned pack2bf(float a, float b) { return (unsigned)f2bf(a) | ((unsigned)f2bf(b) << 16); }
__device__ __forceinline__ u16 f2h(float f) {
  _Float16 h = (_Float16)f;
  return __builtin_bit_cast(u16, h);
}

template <int CTRL>
__device__ __forceinline__ float dppf(float x) {
  return __int_as_float(__builtin_amdgcn_update_dpp(0, __float_as_int(x), CTRL, 0xF, 0xF, false));
}
__device__ __forceinline__ float red4(float x) {
  x += dppf<0xB1>(x);
  x += dppf<0x4E>(x);
  return x;
}
__device__ __forceinline__ float red8(float x) {
  x = red4(x);
  x += dppf<0x141>(x);
  return x;
}
__device__ __forceinline__ float red16(float x) {
  x = red8(x);
  x += dppf<0x140>(x);
  return x;
}
__device__ __forceinline__ float redmax16(float x) {
  x = fmaxf(x, dppf<0xB1>(x));
  x = fmaxf(x, dppf<0x4E>(x));
  x = fmaxf(x, dppf<0x141>(x));
  x = fmaxf(x, dppf<0x140>(x));
  return x;
}
__device__ __forceinline__ float rdlane(float x, int l) {
  return __int_as_float(__builtin_amdgcn_readlane(__float_as_int(x), l));
}
__device__ __forceinline__ float wave_sum(float x) {
  x = red16(x);
  return rdlane(x, 0) + rdlane(x, 16) + rdlane(x, 32) + rdlane(x, 48);
}
__device__ __forceinline__ f32x4 mfma16(bf16x8 a, bf16x8 b, f32x4 c) {
  return __builtin_amdgcn_mfma_f32_16x16x32_bf16(a, b, c, 0, 0, 0);
}
__device__ __forceinline__ float sigmoidf_(float x) { return __builtin_amdgcn_rcpf(1.f + __expf(-x)); }

template <class Epi>
__device__ __forceinline__ void gemm_tile(const u16* __restrict__ A, int lda, const u16* __restrict__ Bt, int ldb, int K,
                                          char* smem, Epi epi) {
  const int tid = threadIdx.x, wid = tid >> 6, lane = tid & 63, wr = wid >> 1, wc = wid & 1, fr = lane & 15,
            fq = lane >> 4;
  f32x4 acc[4][4];
#pragma unroll
  for (int m = 0; m < 4; ++m)
#pragma unroll
    for (int n = 0; n < 4; ++n) acc[m][n] = f32x4{0.f, 0.f, 0.f, 0.f};
  const int nk = K / 64;
  auto stage = [&](int buf, int kt) {
    char* SA = smem + buf * 32768;
    char* SB = SA + 16384;
#pragma unroll
    for (int i = 0; i < 4; ++i) {
      int b = tid * 16 + i * 4096, r = b >> 7, pc = (b >> 4) & 7;
      int c = kt * 64 + ((pc ^ ((r >> 1) & 7)) << 3);
      __builtin_amdgcn_global_load_lds((const unsigned*)(A + (size_t)r * lda + c),
                                       (__attribute__((address_space(3))) unsigned*)(SA + b), 16, 0, 0);
      __builtin_amdgcn_global_load_lds((const unsigned*)(Bt + (size_t)r * ldb + c),
                                       (__attribute__((address_space(3))) unsigned*)(SB + b), 16, 0, 0);
    }
  };
  stage(0, 0);
  asm volatile("s_waitcnt vmcnt(0)" ::: "memory");
  __syncthreads();
  for (int kt = 0; kt < nk; ++kt) {
    const int cur = kt & 1;
    if (kt + 1 < nk) stage(cur ^ 1, kt + 1);
    const char* SA = smem + cur * 32768;
    const char* SB = SA + 16384;
#pragma unroll
    for (int ks = 0; ks < 2; ++ks) {
      bf16x8 At[4], Bl[4];
#pragma unroll
      for (int m = 0; m < 4; ++m) {
        int r = wr * 64 + m * 16 + fr;
        At[m] = *(const bf16x8*)(SA + r * 128 + (((ks * 4 + fq) ^ ((r >> 1) & 7)) << 4));
      }
#pragma unroll
      for (int n = 0; n < 4; ++n) {
        int r = wc * 64 + n * 16 + fr;
        Bl[n] = *(const bf16x8*)(SB + r * 128 + (((ks * 4 + fq) ^ ((r >> 1) & 7)) << 4));
      }
      __builtin_amdgcn_s_setprio(1);
#pragma unroll
      for (int m = 0; m < 4; ++m)
#pragma unroll
        for (int n = 0; n < 4; ++n) acc[m][n] = mfma16(Bl[n], At[m], acc[m][n]);
      __builtin_amdgcn_s_setprio(0);
    }
    asm volatile("s_waitcnt vmcnt(0)" ::: "memory");
    __syncthreads();
  }
#pragma unroll
  for (int m = 0; m < 4; ++m)
#pragma unroll
    for (int n = 0; n < 4; ++n) epi(m, wr * 64 + m * 16 + fr, wc * 64 + n * 16 + fq * 4, acc[m][n]);
}

template <class Epi>
__device__ __forceinline__ void gemm_qtile(const u16* __restrict__ A, int lda, const u16* __restrict__ Bt, int ldb, int K,
                                           char* smem, Epi epi) {
  const int tid = threadIdx.x, wid = tid >> 6, lane = tid & 63, fr = lane & 15, fq = lane >> 4;
  f32x4 acc[2][2];
#pragma unroll
  for (int m = 0; m < 2; ++m)
#pragma unroll
    for (int n = 0; n < 2; ++n) acc[m][n] = f32x4{0.f, 0.f, 0.f, 0.f};
  const int nk = K / 64;
  auto stage = [&](int buf, int kt) {
    char* SA = smem + buf * 32768;
    char* SB = SA + 16384;
    {
      int b = tid * 16, r = b >> 7, pc = (b >> 4) & 7;
      int c = kt * 64 + ((pc ^ ((r >> 1) & 7)) << 3);
      __builtin_amdgcn_global_load_lds((const unsigned*)(A + (size_t)r * lda + c),
                                       (__attribute__((address_space(3))) unsigned*)(SA + b), 16, 0, 0);
    }
#pragma unroll
    for (int i = 0; i < 4; ++i) {
      int b = tid * 16 + i * 4096, r = b >> 7, pc = (b >> 4) & 7;
      int c = kt * 64 + ((pc ^ ((r >> 1) & 7)) << 3);
      __builtin_amdgcn_global_load_lds((const unsigned*)(Bt + (size_t)r * ldb + c),
                                       (__attribute__((address_space(3))) unsigned*)(SB + b), 16, 0, 0);
    }
  };
  stage(0, 0);
  asm volatile("s_waitcnt vmcnt(0)" ::: "memory");
  __syncthreads();
  for (int kt = 0; kt < nk; ++kt) {
    const int cur = kt & 1;
    if (kt + 1 < nk) stage(cur ^ 1, kt + 1);
    const char* SA = smem + cur * 32768;
    const char* SB = SA + 16384;
#pragma unroll
    for (int ks = 0; ks < 2; ++ks) {
      bf16x8 At[2], Bl[2];
#pragma unroll
      for (int m = 0; m < 2; ++m) {
        int r = m * 16 + fr;
        At[m] = *(const bf16x8*)(SA + r * 128 + (((ks * 4 + fq) ^ ((r >> 1) & 7)) << 4));
      }
#pragma unroll
      for (int n = 0; n < 2; ++n) {
        int r = wid * 32 + n * 16 + fr;
        Bl[n] = *(const bf16x8*)(SB + r * 128 + (((ks * 4 + fq) ^ ((r >> 1) & 7)) << 4));
      }
#pragma unroll
      for (int m = 0; m < 2; ++m)
#pragma unroll
        for (int n = 0; n < 2; ++n) acc[m][n] = mfma16(Bl[n], At[m], acc[m][n]);
    }
    asm volatile("s_waitcnt vmcnt(0)" ::: "memory");
    __syncthreads();
  }
#pragma unroll
  for (int m = 0; m < 2; ++m)
#pragma unroll
    for (int n = 0; n < 2; ++n) epi(m, m * 16 + fr, wid * 32 + n * 16 + fq * 4, acc[m][n]);
}

__device__ __forceinline__ int xcd_vid() { return (blockIdx.x & 7) * (gridDim.x >> 3) + (blockIdx.x >> 3); }
__device__ __forceinline__ void grouped_tile(int t, int MT, int NT, int& mt, int& nt) {
  const int GM = 8;
  int per = GM * NT, gid = t / per, rem = t - gid * per;
  int first = gid * GM, gsz = min(MT - first, GM);
  mt = first + rem % gsz;
  nt = rem / gsz;
}

__device__ void transpose_task(const float* __restrict__ src, int K, int N, u16* __restrict__ dst, int tile, char* smem,
                               const float* __restrict__ kscale = nullptr) {
  const int tid = threadIdx.x;
  int tn = N / 64;
  int k0 = (tile / tn) * 64, n0 = (tile % tn) * 64;
  float* t = (float*)smem;
#pragma unroll 4
  for (int it = 0; it < 16; ++it) {
    int k = it * 4 + (tid >> 6), n = tid & 63;
    t[n * 65 + k] = src[(size_t)(k0 + k) * N + n0 + n] * (kscale ? kscale[k0 + k] : 1.f);
  }
  __syncthreads();
#pragma unroll 4
  for (int it = 0; it < 16; ++it) {
    int n = it * 4 + (tid >> 6), k = tid & 63;
    dst[(size_t)(n0 + n) * K + k0 + k] = f2bf(t[n * 65 + k]);
  }
  __syncthreads();
}

__device__ void norm1_task(const Params& p, int task) {
  const int wave = threadIdx.x >> 6, lane = threadIdx.x & 63;
  int row = task * 4 + wave;
  u16* h = (u16*)(p.ws + WS_B) + (size_t)row * D;
  const float* src = nullptr;
  bool donorm = true;
  float* shout = nullptr;
  if (row < TP) {
    int b = row / LP, t = row % LP;
    src = (t < 16) ? p.meta + (size_t)t * D : p.x_prompt + ((size_t)b * 4096 + (t - 16)) * D;
    if (t == LP - 1) shout = p.out + O_SHP + (size_t)b * D;
  } else if (row < TTOK) {
    int r = row - TP;
    src = p.x_sample + (size_t)r * D;
    if ((r & 3) == 3) shout = p.out + O_SHS + (size_t)(r >> 2) * D;
  } else if (row < TTOK + SB) {
    src = p.state_shift + (size_t)(row - TTOK) * D;
    donorm = false;
  }
  if (!src) {
#pragma unroll
    for (int i = 0; i < 4; ++i) *(uint2*)(h + (i * 64 + lane) * 4) = uint2{0u, 0u};
    return;
  }
  float4 v[4];
  float ss = 0.f;
#pragma unroll
  for (int i = 0; i < 4; ++i) {
    v[i] = ((const float4*)src)[i * 64 + lane];
    ss += v[i].x * v[i].x + v[i].y * v[i].y + v[i].z * v[i].z + v[i].w * v[i].w;
  }
  float sc = 1.f;
  if (donorm) {
    ss = wave_sum(ss);
    sc = rsqrtf(ss * (1.f / 1024.f) + 1e-5f);
  }
#pragma unroll
  for (int i = 0; i < 4; ++i) {
    float4 y = v[i];
    if (donorm) {
      float4 g = ((const float4*)p.norm1_g)[i * 64 + lane];
      y.x *= sc * g.x; y.y *= sc * g.y; y.z *= sc * g.z; y.w *= sc * g.w;
    }
    *(uint2*)(h + (i * 64 + lane) * 4) = uint2{pack2bf(y.x, y.y), pack2bf(y.z, y.w)};
    if (shout) ((float4*)shout)[i * 64 + lane] = y;
  }
}

__device__ void phase0(const Params& p, char* smem) {
  constexpr int N_NORM = MROWS / 4;
  constexpr int T_WIN = 16 * 40, T_WOUT = 16 * 16, T_WQ = 16 * 32, T_W2W = 8, T_W2A = 8, T_W2G = 16, T_SUBK = 32;
  constexpr int TOT = N_NORM + T_WIN + T_W2W + T_W2A + T_W2G + T_SUBK;
  for (int task = blockIdx.x; task < TOT; task += gridDim.x) {
    int t = task;
    if (t < N_NORM) { norm1_task(p, t); continue; }
    t -= N_NORM;
    if (t < T_WIN) { transpose_task(p.w_in, 1024, 2560, (u16*)(p.ws + WS_WIN), t, smem); continue; }
    t -= T_WIN;
    if (t < T_W2W) { transpose_task(p.w2w, 64, 512, (u16*)(p.ws + WS_W2W), t, smem); continue; }
    t -= T_W2W;
    if (t < T_W2A) { transpose_task(p.w2a, 64, 512, (u16*)(p.ws + WS_W2A), t, smem); continue; }
    t -= T_W2A;
    if (t < T_W2G) { transpose_task(p.w2g, 128, 512, (u16*)(p.ws + WS_W2G), t, smem); continue; }
    t -= T_W2G;
    {
      int e = (t * 256 + threadIdx.x) * 4;
      float4 v = *(const float4*)(p.sub_keys + e);
      *(uint2*)((u16*)(p.ws + WS_SUBK) + e) = uint2{pack2bf(v.x, v.y), pack2bf(v.z, v.w)};
    }
  }
}

__device__ void phase1(const Params& p, char* smem) {
  const u16* hbuf = (const u16*)(p.ws + WS_B);
  const u16* wt = (const u16*)(p.ws + WS_WIN);
  u16* proj = (u16*)(p.ws + WS_C);
  constexpr int NT = 20, MT = MROWS / 128, TOT = MT * NT;
  const int G = gridDim.x, full = p.full1, ntask = full + 4 * (TOT - full);
  for (int task = xcd_vid(); task < ntask; task += G) {
    int mt, nt;
    if (task < full) {
      grouped_tile(task, MT, NT, mt, nt);
      u16* crow = proj + (size_t)mt * 128 * NIN + nt * 128;
      gemm_tile(hbuf + (size_t)mt * 128 * D, D, wt + (size_t)nt * 128 * D, D, D, smem,
                [&](int m, int r, int c, f32x4 v) { *(uint2*)(crow + (size_t)r * NIN + c) = uint2{pack2bf(v[0], v[1]), pack2bf(v[2], v[3])}; });
    } else {
      int rem = task - full, qd = rem & 3;
      grouped_tile(full + (rem >> 2), MT, NT, mt, nt);
      size_t r0 = (size_t)mt * 128 + qd * 32;
      u16* crow = proj + r0 * NIN + nt * 128;
      gemm_qtile(hbuf + r0 * D, D, wt + (size_t)nt * 128 * D, D, D, smem,
                 [&](int m, int r, int c, f32x4 v) { *(uint2*)(crow + (size_t)r * NIN + c) = uint2{pack2bf(v[0], v[1]), pack2bf(v[2], v[3])}; });
    }
  }
}

__device__ void prepass_task(const Params& p, int task) {
  const int wave = threadIdx.x >> 6, lane = threadIdx.x & 63;
  int row = task * 4 + wave;
  if (row >= TTOK) return;
  u16* proj = (u16*)(p.ws + WS_C);
  u16* act = (u16*)(p.ws + WS_E);
  bool isP = row < TP;
  int b, t, prow;
  float pos;
  if (isP) { b = row / LP; t = row % LP; prow = t > 0 ? row - 1 : -1; pos = (float)t; }
  else { int r = row - TP; b = r >> 2; t = r & 3; prow = t > 0 ? row - 1 : PREV0 + b; pos = (float)(PAST + t); }
  u16* pr = proj + (size_t)row * NIN;
  const u16* pp = prow >= 0 ? proj + (size_t)prow * NIN : nullptr;
  {
    int c = 1536 + lane * 4;
    uint2 a = *(const uint2*)(pr + c);
    uint2 bq = pp ? *(const uint2*)(pp + c) : uint2{0u, 0u};
    float4 mu = *(const float4*)(p.mu + c);
    float x[4] = {bflo(a.x), bfhi(a.x), bflo(a.y), bfhi(a.y)};
    float xp[4] = {bflo(bq.x), bfhi(bq.x), bflo(bq.y), bfhi(bq.y)};
    float mm[4] = {mu.x, mu.y, mu.z, mu.w};
    float o[4];
#pragma unroll
    for (int i = 0; i < 4; ++i) {
      float m = x[i] + (xp[i] - x[i]) * mm[i];
      float r;
      if (lane < 16) r = tanhf(m);
      else if (lane < 32) r = m;
      else r = sigmoidf_(m);
      o[i] = r;
    }
    *(uint2*)(act + (size_t)row * 256 + lane * 4) = uint2{pack2bf(o[0], o[1]), pack2bf(o[2], o[3])};
  }
  float* kwin = nullptr;
  float* vwin = nullptr;
  if (isP) {
    if (t >= LP - 128) {
      kwin = p.out + O_KWP + ((size_t)b * 128 + (t - (LP - 128))) * 128;
      vwin = p.out + O_VWP + ((size_t)b * 128 + (t - (LP - 128))) * 128;
    }
  } else {
    kwin = p.out + O_KWS + ((size_t)b * 128 + 124 + t) * 128;
    vwin = p.out + O_VWS + ((size_t)b * 128 + 124 + t) * 128;
  }
  for (int it = lane; it < 80; it += 64) {
    int hh = it >> 3, d = it & 7;
    int col = 1792 + hh * 64 + d;
    float x1 = bf2f(pr[col]), x2 = bf2f(pr[col + 8]);
    double rev = (double)pos * INVF[d] * 0.15915494309189535;
    float fr = (float)(rev - floor(rev));
    float sn = __builtin_amdgcn_sinf(fr), cs = __builtin_amdgcn_cosf(fr);
    float r1 = x1 * cs - x2 * sn, r2 = x2 * cs + x1 * sn;
    pr[col] = f2bf(r1);
    pr[col + 8] = f2bf(r2);
    if (hh >= 8 && kwin) {
      kwin[(hh - 8) * 64 + d] = r1;
      kwin[(hh - 8) * 64 + d + 8] = r2;
    }
  }
  if (kwin) {
#pragma unroll
    for (int i = 0; i < 2; ++i) {
      int idx = lane * 2 + i;
      if ((idx & 63) >= 16) kwin[idx] = bf2f(pr[2304 + idx]);
      vwin[idx] = bf2f(pr[2432 + idx]);
    }
  }
}

__device__ void phase2(const Params& p) {
  constexpr int N_PRE = TTOK / 4;
  constexpr int N_CP = 256;
  for (int task = blockIdx.x; task < N_PRE + N_CP; task += gridDim.x) {
    if (task < N_PRE) { prepass_task(p, task); continue; }
    int t = task - N_PRE;
    int which = t >> 7, b = t & 127;
    const float4* src = (const float4*)((which ? p.cache_v : p.cache_k) + (size_t)b * 16384 + 512);
    float4* dst = (float4*)(p.out + (which ? O_VWS : O_KWS) + (size_t)b * 16384);
    for (int i = threadIdx.x; i < 3968; i += 256) dst[i] = src[i];
  }
}

__device__ void phase3(const Params& p, char* smem) {
  const u16* act = (const u16*)(p.ws + WS_E);
  float* dec = (float*)(p.ws + WS_DEC);
  u16* ab = (u16*)(p.ws + WS_A);
  u16* gb = (u16*)(p.ws + WS_G);
  constexpr int MT = TPAD / 128;
  for (int tile = blockIdx.x; tile < MT * 12; tile += gridDim.x) {
    int which = tile % 3, rest = tile / 3;
    int nt = rest & 3, mt = rest >> 2;
    size_t r0 = (size_t)mt * 128;
    int c0 = nt * 128;
    if (which == 0) {
      gemm_tile(act + r0 * 256, 256, (const u16*)(p.ws + WS_W2W) + (size_t)c0 * 64, 64, 64, smem,
                [&](int m, int r, int c, f32x4 v) {
                  float4 w0v = *(const float4*)(p.w0 + c0 + c);
                  float w0a[4] = {w0v.x, w0v.y, w0v.z, w0v.w};
                  float o[4];
#pragma unroll
                  for (int e = 0; e < 4; ++e) {
                    float nx = -(w0a[e] + v[e]);
                    float sp = fmaxf(nx, 0.f) + __logf(1.f + __expf(-fabsf(nx)));
                    o[e] = __expf(-__expf(-sp - 0.5f));
                  }
                  *(float4*)(dec + (r0 + r) * 512 + c0 + c) = float4{o[0], o[1], o[2], o[3]};
                });
    } else if (which == 1) {
      gemm_tile(act + r0 * 256 + 64, 256, (const u16*)(p.ws + WS_W2A) + (size_t)c0 * 64, 64, 64, smem,
                [&](int m, int r, int c, f32x4 v) {
                  float4 a0v = *(const float4*)(p.a0 + c0 + c);
                  *(uint2*)(ab + (r0 + r) * 512 + c0 + c) = uint2{pack2bf(sigmoidf_(a0v.x + v[0]), sigmoidf_(a0v.y + v[1])), pack2bf(sigmoidf_(a0v.z + v[2]), sigmoidf_(a0v.w + v[3]))};
                });
    } else {
      gemm_tile(act + r0 * 256 + 128, 256, (const u16*)(p.ws + WS_W2G) + (size_t)c0 * 128, 128, 128, smem,
                [&](int m, int r, int c, f32x4 v) { *(uint2*)(gb + (r0 + r) * 512 + c0 + c) = uint2{pack2bf(v[0], v[1]), pack2bf(v[2], v[3])}; });
    }
  }
}

__device__ void convert_task(const Params& p, int task) {
  const int wave = threadIdx.x >> 6, lane = threadIdx.x & 63;
  int r = task * 4 + wave;
  const float* src = (r < 16384 ? p.eu + (size_t)r * 1024 : p.ev + (size_t)(r - 16384) * 1024) + lane * 16;
  float4 x[4];
  float am = 0.f;
#pragma unroll
  for (int i = 0; i < 4; ++i) {
    x[i] = ((const float4*)src)[i];
    am = fmaxf(am, fmaxf(fmaxf(fabsf(x[i].x), fabsf(x[i].y)), fmaxf(fabsf(x[i].z), fabsf(x[i].w))));
  }
  am = redmax16(am);
  am = fmaxf(fmaxf(rdlane(am, 0), rdlane(am, 16)), fmaxf(rdlane(am, 32), rdlane(am, 48)));
  float scale = am > 0.f ? 7.f / am : 1.f;
  float inv = am > 0.f ? am * (1.f / 7.f) : 1.f;
  float y[16];
#pragma unroll
  for (int i = 0; i < 4; ++i) {
    y[4 * i] = fminf(fmaxf(x[i].x * scale, -6.f), 6.f); y[4 * i + 1] = fminf(fmaxf(x[i].y * scale, -6.f), 6.f);
    y[4 * i + 2] = fminf(fmaxf(x[i].z * scale, -6.f), 6.f); y[4 * i + 3] = fminf(fmaxf(x[i].w * scale, -6.f), 6.f);
  }
  unsigned w0 = 0u, w1 = 0u;
  w0 = __builtin_amdgcn_cvt_scalef32_pk_fp4_f32(w0, y[0], y[1], 1.0f, 0);
  w0 = __builtin_amdgcn_cvt_scalef32_pk_fp4_f32(w0, y[2], y[3], 1.0f, 1);
  w0 = __builtin_amdgcn_cvt_scalef32_pk_fp4_f32(w0, y[4], y[5], 1.0f, 2);
  w0 = __builtin_amdgcn_cvt_scalef32_pk_fp4_f32(w0, y[6], y[7], 1.0f, 3);
  w1 = __builtin_amdgcn_cvt_scalef32_pk_fp4_f32(w1, y[8], y[9], 1.0f, 0);
  w1 = __builtin_amdgcn_cvt_scalef32_pk_fp4_f32(w1, y[10], y[11], 1.0f, 1);
  w1 = __builtin_amdgcn_cvt_scalef32_pk_fp4_f32(w1, y[12], y[13], 1.0f, 2);
  w1 = __builtin_amdgcn_cvt_scalef32_pk_fp4_f32(w1, y[14], y[15], 1.0f, 3);
  *(uint2*)((unsigned char*)(p.ws + WS_EU) + (size_t)r * 512 + lane * 8) = uint2{w0, w1};
  if (lane == 0) ((float*)(p.ws + WS_SCU))[r] = inv;
}

struct ScanRaw {
  uint2 rr, rk, rv, qr, qk, qv, av;
  float4 dc;
};
constexpr int SC_TOK = 332;

__device__ void scan_task(const Params& p, char* smem, int rowbase, int T, int prevrow, int h, int rg,
                          const float* __restrict__ s_in, float* __restrict__ s_out) {
  const int tid = threadIdx.x, wave = tid >> 6, lane = tid & 63, l16 = lane & 15;
  const bool scanner = wave < 2;
  const u16* proj = (const u16*)(p.ws + WS_C);
  const float* dec = (const float*)(p.ws + WS_DEC);
  const u16* ab = (const u16*)(p.ws + WS_A);
  float* yraw = p.out;
  float* bufs = (float*)smem;
  float* yparts = (float*)(smem + 42496);
  float* vkrs = (float*)(smem + 42496 + 16384);
  const int nchunk = (T + 15) >> 4;
  const int il = (wave & 1) * 4 + (lane >> 4), i = rg * 8 + il, j0 = l16 * 4;
  float2v S01 = {0.f, 0.f}, S23 = {0.f, 0.f};
  if (s_in && scanner) {
    float4 s = *(const float4*)(s_in + i * 64 + j0);
    S01 = float2v{s.x, s.y}; S23 = float2v{s.z, s.w};
  }
  const int ptid = tid & 127, cgp = ptid & 15, ttb = ptid >> 4, col = h * 64 + cgp * 4;
  const float4 mu_r = *(const float4*)(p.mu + col), mu_k = *(const float4*)(p.mu + 512 + col),
               mu_v = *(const float4*)(p.mu + 1024 + col);
  const float4 kkw = *(const float4*)(p.k_k + col), kaw = *(const float4*)(p.k_a + col);
  const u16* projc = proj + (size_t)rowbase * NIN + col;
  const float* decc = dec + (size_t)rowbase * 512 + col;
  const u16* abc = ab + (size_t)rowbase * 512 + col;
  const u16* prevp = prevrow >= 0 ? proj + (size_t)prevrow * NIN + col : nullptr;
  auto issue = [&](int c, int tt, ScanRaw& R) {
    int t = c * 16 + tt;
    if (t < T) {
      const size_t ro = (size_t)c * 16 + tt;
      const u16* pr = projc + ro * NIN;
      R.rr = *(const uint2*)(pr);
      R.rk = *(const uint2*)(pr + 512);
      R.rv = *(const uint2*)(pr + 1024);
      const u16* pq = t > 0 ? pr - NIN : prevp;
      if (pq) {
        R.qr = *(const uint2*)(pq);
        R.qk = *(const uint2*)(pq + 512);
        R.qv = *(const uint2*)(pq + 1024);
      } else {
        R.qr = uint2{0, 0}; R.qk = uint2{0, 0}; R.qv = uint2{0, 0};
      }
      R.dc = *(const float4*)(decc + ro * 512);
      R.av = *(const uint2*)(abc + ro * 512);
    }
  };
  auto prep_item = [&](const ScanRaw& R, int tt, float* buf, float* vkr) {
    float xr[4] = {bflo(R.rr.x), bfhi(R.rr.x), bflo(R.rr.y), bfhi(R.rr.y)};
    float xk[4] = {bflo(R.rk.x), bfhi(R.rk.x), bflo(R.rk.y), bfhi(R.rk.y)};
    float xv[4] = {bflo(R.rv.x), bfhi(R.rv.x), bflo(R.rv.y), bfhi(R.rv.y)};
    float pr_[4] = {bflo(R.qr.x), bfhi(R.qr.x), bflo(R.qr.y), bfhi(R.qr.y)};
    float pk_[4] = {bflo(R.qk.x), bfhi(R.qk.x), bflo(R.qk.y), bfhi(R.qk.y)};
    float pv_[4] = {bflo(R.qv.x), bfhi(R.qv.x), bflo(R.qv.y), bfhi(R.qv.y)};
    float aa[4] = {bflo(R.av.x), bfhi(R.av.x), bflo(R.av.y), bfhi(R.av.y)};
    float dcv[4] = {R.dc.x, R.dc.y, R.dc.z, R.dc.w};
    float mur[4] = {mu_r.x, mu_r.y, mu_r.z, mu_r.w}, muk[4] = {mu_k.x, mu_k.y, mu_k.z, mu_k.w},
          muv[4] = {mu_v.x, mu_v.y, mu_v.z, mu_v.w};
    float kw[4] = {kkw.x, kkw.y, kkw.z, kkw.w}, ka[4] = {kaw.x, kaw.y, kaw.z, kaw.w};
    float kkv[4], ss = 0.f;
#pragma unroll
    for (int e = 0; e < 4; ++e) {
      xr[e] = xr[e] + (pr_[e] - xr[e]) * mur[e];
      xk[e] = xk[e] + (pk_[e] - xk[e]) * muk[e];
      xv[e] = xv[e] + (pv_[e] - xv[e]) * muv[e];
      kkv[e] = xk[e] * kw[e];
      ss += kkv[e] * kkv[e];
    }
    ss = red16(ss);
    float inv = __builtin_amdgcn_rsqf(fmaxf(ss, 1e-24f));
    float nk[4], kb[4], km[4];
    float brs = 0.f, krs = 0.f;
#pragma unroll
    for (int e = 0; e < 4; ++e) {
      float kk = kkv[e] * inv;
      nk[e] = -kk;
      kb[e] = kk * aa[e];
      km[e] = xk[e] * (1.f + (aa[e] - 1.f) * ka[e]);
      brs += kb[e] * xr[e];
      krs += km[e] * xr[e];
    }
    brs = red16(brs);
    krs = red16(krs);
    float* bt = buf + tt * SC_TOK + cgp * 4;
    *(float4*)(bt) = float4{xr[0] * dcv[0] + brs * nk[0], xr[1] * dcv[1] + brs * nk[1], xr[2] * dcv[2] + brs * nk[2],
                            xr[3] * dcv[3] + brs * nk[3]};
    *(float4*)(bt + 64) = R.dc;
    *(float4*)(bt + 128) = float4{km[0], km[1], km[2], km[3]};
    *(float4*)(bt + 192) = float4{nk[0], nk[1], nk[2], nk[3]};
    *(float4*)(bt + 256) = float4{kb[0], kb[1], kb[2], kb[3]};
    if ((cgp >> 1) == rg) {
      *(float4*)(buf + tt * SC_TOK + 320 + (cgp & 1) * 4) = float4{xv[0], xv[1], xv[2], xv[3]};
      *(float4*)(vkr + tt * 8 + (cgp & 1) * 4) = float4{xv[0] * krs, xv[1] * krs, xv[2] * krs, xv[3] * krs};
    }
  };
  auto yreduce = [&](int c) {
    const int tt = ptid >> 3, row = ptid & 7;
    const float4* yp = (const float4*)(yparts + (c & 1) * 2048 + ptid * 16);
    float4 a = yp[0], b = yp[1], c4 = yp[2], d = yp[3];
    float y = ((a.x + a.y) + (a.z + a.w)) + ((b.x + b.y) + (b.z + b.w)) + ((c4.x + c4.y) + (c4.z + c4.w)) +
              ((d.x + d.y) + (d.z + d.w)) + vkrs[(c % 3) * 128 + ptid];
    int t = c * 16 + tt;
    if (t < T) yraw[(size_t)(rowbase + t) * 512 + h * 64 + rg * 8 + row] = y;
  };
  ScanRaw R0, R1;
  R0.rr = R0.rk = R0.rv = R0.qr = R0.qk = R0.qv = R0.av = uint2{0, 0}; R0.dc = float4{0, 0, 0, 0};
  R1 = R0;
  if (!scanner) {
    issue(0, ttb, R0);
    issue(0, ttb + 8, R1);
    prep_item(R0, ttb, bufs, vkrs);
    prep_item(R1, ttb + 8, bufs, vkrs);
    if (nchunk > 1) { issue(1, ttb, R0); issue(1, ttb + 8, R1); }
  }
  __syncthreads();
  for (int c = 0; c < nchunk; ++c) {
    if (scanner) {
      const float* buf = bufs + (c & 1) * (16 * SC_TOK);
      float* ypart = yparts + (c & 1) * 2048;
      const int ntok = min(16, T - c * 16);
      const float* bt0 = buf + j0;
      float4 r4 = *(const float4*)(bt0), w4 = *(const float4*)(bt0 + 64), k4 = *(const float4*)(bt0 + 128),
             a4 = *(const float4*)(bt0 + 192), b4 = *(const float4*)(bt0 + 256);
      float vi = buf[320 + il];
      for (int t2 = 0; t2 < ntok; ++t2) {
        int tn = min(t2 + 1, ntok - 1);
        const float* bn = buf + tn * SC_TOK + j0;
        float4 rn = *(const float4*)(bn), wn = *(const float4*)(bn + 64), kn = *(const float4*)(bn + 128),
               an = *(const float4*)(bn + 192), bnn = *(const float4*)(bn + 256);
        float vn = buf[tn * SC_TOK + 320 + il];
        float2v sa2 = S01 * float2v{a4.x, a4.y} + S23 * float2v{a4.z, a4.w};
        float2v q2 = S01 * float2v{r4.x, r4.y} + S23 * float2v{r4.z, r4.w};
        float2v vv = float2v{vi, vi};
        float2v t01 = S01 * float2v{w4.x, w4.y} + vv * float2v{k4.x, k4.y};
        float2v t23 = S23 * float2v{w4.z, w4.w} + vv * float2v{k4.z, k4.w};
        float sa = red16(sa2.x + sa2.y);
        float2v sv = float2v{sa, sa};
        S01 = t01 + sv * float2v{b4.x, b4.y};
        S23 = t23 + sv * float2v{b4.z, b4.w};
        ypart[t2 * 128 + (tid & 127)] = q2.x + q2.y;
        r4 = rn; w4 = wn; k4 = kn; a4 = an; b4 = bnn; vi = vn;
      }
    } else {
      if (c > 0) yreduce(c - 1);
      if (c + 1 < nchunk) {
        float* nb = bufs + ((c + 1) & 1) * (16 * SC_TOK);
        float* nv = vkrs + ((c + 1) % 3) * 128;
        prep_item(R0, ttb, nb, nv);
        prep_item(R1, ttb + 8, nb, nv);
        if (c + 2 < nchunk) { issue(c + 2, ttb, R0); issue(c + 2, ttb + 8, R1); }
      }
    }
    __syncthreads();
  }
  if (scanner) *(float4*)(s_out + i * 64 + j0) = float4{S01.x, S01.y, S23.x, S23.y};
  else yreduce(nchunk - 1);
  __syncthreads();
}

__device__ void attn_prompt_task(const Params& p, char* smem, int task) {
  const int tid = threadIdx.x, w = tid >> 6, lane = tid & 63, fr = lane & 15, fq = lane >> 4;
  int head = task & 7;
  int qt = (task >> 3) % 65;
  int b = task / (8 * 65);
  int kvh = head >> 2;
  u16* KV = (u16*)smem;
  u16* Ps = (u16*)(smem + 9216) + w * 16 * 200;
  const u16* projb = (const u16*)(p.ws + WS_C) + (size_t)b * LP * NIN;
  u16* mix = (u16*)(p.ws + WS_B);
  int q0 = qt * 64, kstart = q0 - 128;
  int qrow = min(q0 + w * 16 + fr, LP - 1);
  bf16x8 qa[2];
#pragma unroll
  for (int ks = 0; ks < 2; ++ks)
    qa[ks] = *(const bf16x8*)(projb + (size_t)qrow * NIN + 1792 + head * 64 + ks * 32 + fq * 8);
  f32x4 S[12];
#pragma unroll
  for (int i = 0; i < 12; ++i) S[i] = f32x4{0.f, 0.f, 0.f, 0.f};
#pragma unroll
  for (int kt = 0; kt < 3; ++kt) {
    {
      int key = tid >> 2, ch = tid & 3;
      int kp = min(max(kstart + kt * 64 + key, 0), LP - 1);
      const uint4* src = (const uint4*)(projb + (size_t)kp * NIN + 2304 + kvh * 64 + ch * 16);
      uint4 v0 = src[0], v1 = src[1];
      *(uint4*)(KV + key * 72 + ch * 16) = v0;
      *(uint4*)(KV + key * 72 + ch * 16 + 8) = v1;
    }
    __syncthreads();
#pragma unroll
    for (int n = 0; n < 4; ++n)
#pragma unroll
      for (int ks = 0; ks < 2; ++ks) {
        bf16x8 kb = *(const bf16x8*)(KV + (n * 16 + fr) * 72 + ks * 32 + fq * 8);
        S[kt * 4 + n] = mfma16(qa[ks], kb, S[kt * 4 + n]);
      }
    __syncthreads();
  }
  float sink = p.sinks[head];
#pragma unroll
  for (int j = 0; j < 4; ++j) {
    int qpos = q0 + w * 16 + fq * 4 + j;
    float mx = -1e30f;
#pragma unroll
    for (int T = 0; T < 12; ++T) {
      int kpos = kstart + T * 16 + fr;
      bool valid = (kpos >= 0) && (kpos <= qpos) && (qpos - kpos < 128);
      float s = valid ? S[T][j] * 0.125f : -1e30f;
      S[T][j] = s;
      mx = fmaxf(mx, s);
    }
    mx = redmax16(mx);
    mx = fmaxf(mx, sink);
    float sum = 0.f;
#pragma unroll
    for (int T = 0; T < 12; ++T) {
      float e = (S[T][j] > -1e29f) ? __expf(S[T][j] - mx) : 0.f;
      S[T][j] = e;
      sum += e;
    }
    sum = red16(sum) + __expf(sink - mx);
    float inv = 1.f / sum;
#pragma unroll
    for (int T = 0; T < 12; ++T) Ps[(fq * 4 + j) * 200 + T * 16 + fr] = f2bf(S[T][j] * inv);
  }
  f32x4 O[4];
#pragma unroll
  for (int i = 0; i < 4; ++i) O[i] = f32x4{0.f, 0.f, 0.f, 0.f};
#pragma unroll
  for (int kt = 0; kt < 3; ++kt) {
    {
      int key = tid >> 2, ch = tid & 3;
      int kp = min(max(kstart + kt * 64 + key, 0), LP - 1);
      const uint4* src = (const uint4*)(projb + (size_t)kp * NIN + 2432 + kvh * 64 + ch * 16);
      uint4 v0 = src[0], v1 = src[1];
      unsigned e[8] = {v0.x, v0.y, v0.z, v0.w, v1.x, v1.y, v1.z, v1.w};
#pragma unroll
      for (int i = 0; i < 8; ++i) {
        KV[(ch * 16 + 2 * i) * 72 + key] = (u16)(e[i] & 0xffffu);
        KV[(ch * 16 + 2 * i + 1) * 72 + key] = (u16)(e[i] >> 16);
      }
    }
    __syncthreads();
#pragma unroll
    for (int ks = 0; ks < 2; ++ks) {
      bf16x8 pa = *(const bf16x8*)(Ps + fr * 200 + kt * 64 + ks * 32 + fq * 8);
#pragma unroll
      for (int n = 0; n < 4; ++n) {
        bf16x8 vb = *(const bf16x8*)(KV + (n * 16 + fr) * 72 + ks * 32 + fq * 8);
        O[n] = mfma16(pa, vb, O[n]);
      }
    }
    __syncthreads();
  }
#pragma unroll
  for (int n = 0; n < 4; ++n)
#pragma unroll
    for (int j = 0; j < 4; ++j) {
      int q = q0 + w * 16 + fq * 4 + j;
      if (q < LP) mix[((size_t)(b * LP + q)) * 1024 + 512 + head * 64 + n * 16 + fr] = f2bf(O[n][j]);
    }
}

__device__ void attn_sample_task(const Params& p, char* smem, int task) {
  const int tid = threadIdx.x;
  int b = task >> 1, kvh = task & 1;
  const u16* proj = (const u16*)(p.ws + WS_C);
  u16* mix = (u16*)(p.ws + WS_B);
  float* Qs = (float*)smem;
  float* Sc = Qs + 1024;
  {
    int qr = tid >> 4, d4 = (tid & 15) * 4, g = qr >> 2, s = qr & 3;
    const u16* src = proj + (size_t)(TP + b * 4 + s) * NIN + 1792 + (kvh * 4 + g) * 64 + d4;
    uint2 v = *(const uint2*)src;
    *(float4*)(Qs + qr * 64 + d4) = float4{bflo(v.x) * 0.125f, bfhi(v.x) * 0.125f, bflo(v.y) * 0.125f, bfhi(v.y) * 0.125f};
  }
  __syncthreads();
  for (int idx = tid; idx < 132 * 16; idx += 256) {
    int kj = idx >> 4, qr = idx & 15, s = qr & 3;
    bool valid = (kj < 128) ? (kj > s) : (kj - 128 <= s);
    float acc = 0.f;
    const float* q = Qs + qr * 64;
    if (kj < 128) {
      const float4* kr = (const float4*)(p.cache_k + (((size_t)b * 128 + kj) * 2 + kvh) * 64);
#pragma unroll
      for (int d = 0; d < 16; ++d) {
        float4 kv = kr[d];
        acc += kv.x * q[d * 4] + kv.y * q[d * 4 + 1] + kv.z * q[d * 4 + 2] + kv.w * q[d * 4 + 3];
      }
    } else {
      const uint2* kr = (const uint2*)(proj + (size_t)(TP + b * 4 + kj - 128) * NIN + 2304 + kvh * 64);
#pragma unroll
      for (int d = 0; d < 16; ++d) {
        uint2 kv = kr[d];
        acc += bflo(kv.x) * q[d * 4] + bfhi(kv.x) * q[d * 4 + 1] + bflo(kv.y) * q[d * 4 + 2] + bfhi(kv.y) * q[d * 4 + 3];
      }
    }
    Sc[qr * 136 + kj] = valid ? acc : -1e30f;
  }
  __syncthreads();
  {
    int qr = tid >> 4, l = tid & 15, g = qr >> 2;
    float sink = p.sinks[kvh * 4 + g];
    float mx = -1e30f;
    for (int kj = l; kj < 132; kj += 16) mx = fmaxf(mx, Sc[qr * 136 + kj]);
    mx = redmax16(mx);
    mx = fmaxf(mx, sink);
    float sum = 0.f;
    for (int kj = l; kj < 132; kj += 16) {
      float s = Sc[qr * 136 + kj];
      float e = (s > -1e29f) ? __expf(s - mx) : 0.f;
      Sc[qr * 136 + kj] = e;
      sum += e;
    }
    sum = red16(sum) + __expf(sink - mx);
    float inv = 1.f / sum;
    for (int kj = l; kj < 132; kj += 16) Sc[qr * 136 + kj] *= inv;
  }
  __syncthreads();
  {
    int qr = tid >> 4, d4 = (tid & 15) * 4, g = qr >> 2, s = qr & 3;
    float4 o = {0.f, 0.f, 0.f, 0.f};
    for (int kj = 0; kj < 128; ++kj) {
      float pw = Sc[qr * 136 + kj];
      float4 v = *(const float4*)(p.cache_v + (((size_t)b * 128 + kj) * 2 + kvh) * 64 + d4);
      o.x += pw * v.x; o.y += pw * v.y; o.z += pw * v.z; o.w += pw * v.w;
    }
    for (int kj = 128; kj < 132; ++kj) {
      float pw = Sc[qr * 136 + kj];
      uint2 v = *(const uint2*)(proj + (size_t)(TP + b * 4 + kj - 128) * NIN + 2432 + kvh * 64 + d4);
      o.x += pw * bflo(v.x); o.y += pw * bfhi(v.x); o.z += pw * bflo(v.y); o.w += pw * bfhi(v.y);
    }
    *(uint2*)(mix + (size_t)(TP + b * 4 + s) * 1024 + 512 + (kvh * 4 + g) * 64 + d4) =
        uint2{pack2bf(o.x, o.y), pack2bf(o.z, o.w)};
  }
  __syncthreads();
}

__device__ void phase4(const Params& p, char* smem) {
  constexpr int N_PS = 256, N_SS = 8192, N_AP = NB * 65 * 8, N_AS = 256;
  constexpr int N_CV = 32768 / 4, T_WOUT = 16 * 16, T_WQ = 16 * 32;
  int first, stride;
  if (gridDim.x >= 2 * N_PS) {
    if ((int)blockIdx.x < N_PS) {
      int t = blockIdx.x;
      int seq = t >> 3, rg = t & 7, b = seq >> 3, h = seq & 7;
      scan_task(p, smem, b * LP, LP, -1, h, rg, nullptr, p.out + O_WKVP + (size_t)seq * 4096);
      return;
    }
    first = N_PS + (blockIdx.x - N_PS);
    stride = gridDim.x - N_PS;
  } else {
    first = blockIdx.x;
    stride = gridDim.x;
  }
  for (int task = first; task < N_PS + N_SS + N_AP + N_AS + N_CV + T_WOUT + T_WQ; task += stride) {
    int t = task;
    if (t < N_PS) {
      int seq = t >> 3, rg = t & 7, b = seq >> 3, h = seq & 7;
      scan_task(p, smem, b * LP, LP, -1, h, rg, nullptr, p.out + O_WKVP + (size_t)seq * 4096);
      continue;
    }
    t -= N_PS;
    if (t < N_SS) {
      int seq = t >> 3, rg = t & 7, b = seq >> 3, h = seq & 7;
      scan_task(p, smem, TP + b * 4, 4, PREV0 + b, h, rg, p.state_wkv + (size_t)seq * 4096,
                p.out + O_WKVS + (size_t)seq * 4096);
      continue;
    }
    t -= N_SS;
    if (t < N_AP) { attn_prompt_task(p, smem, t); continue; }
    t -= N_AP;
    if (t < N_AS) { attn_sample_task(p, smem, t); continue; }
    t -= N_AS;
    if (t < N_CV) { convert_task(p, t); continue; }
    t -= N_CV;
    if (t < T_WOUT) { transpose_task(p.w_out, 1024, 1024, (u16*)(p.ws + WS_WOUT), t, smem); continue; }
    t -= T_WOUT;
    transpose_task(p.w_query, 1024, 2048, (u16*)(p.ws + WS_WQ), t, smem, p.norm2_g);
  }
}

struct PostC { float mu[3][8], ka[8], rk[8], lw[8], lb[8]; };

__device__ __forceinline__ void post_task(const Params& p, int task, const PostC& C) {
  const int wave = threadIdx.x >> 6, lane = threadIdx.x & 63;
  int row = task * 4 + wave;
  if (row >= TTOK) return;
  const u16* proj = (const u16*)(p.ws + WS_C);
  const float* yraw = p.out;
  const u16* ab = (const u16*)(p.ws + WS_A);
  const u16* gb = (const u16*)(p.ws + WS_G);
  u16* mix = (u16*)(p.ws + WS_B);
  int prow;
  if (row < TP) { int t = row % LP; prow = t > 0 ? row - 1 : -1; }
  else { int r = row - TP; prow = (r & 3) ? row - 1 : PREV0 + (r >> 2); }
  int c0 = lane * 8;
  float y[8];
  {
    float4 a = *(const float4*)(yraw + (size_t)row * 512 + c0), bq = *(const float4*)(yraw + (size_t)row * 512 + c0 + 4);
    y[0] = a.x; y[1] = a.y; y[2] = a.z; y[3] = a.w; y[4] = bq.x; y[5] = bq.y; y[6] = bq.z; y[7] = bq.w;
  }
  float s = 0.f;
#pragma unroll
  for (int e = 0; e < 8; ++e) s += y[e];
  float mean = red8(s) * (1.f / 64.f);
  float vs = 0.f;
#pragma unroll
  for (int e = 0; e < 8; ++e) { float d = y[e] - mean; vs += d * d; }
  float rstd = rsqrtf(red8(vs) * (1.f / 64.f) + 64e-5f);
  float xr[8], xk[8], xv[8];
  auto ld8 = [&](int coff, int mi, float* o) {
    uint4 a = *(const uint4*)(proj + (size_t)row * NIN + coff + c0);
    uint4 q = prow >= 0 ? *(const uint4*)(proj + (size_t)prow * NIN + coff + c0) : uint4{0, 0, 0, 0};
    unsigned ua[4] = {a.x, a.y, a.z, a.w}, uq[4] = {q.x, q.y, q.z, q.w};
#pragma unroll
    for (int e = 0; e < 4; ++e) {
      float x0 = bflo(ua[e]), x1 = bfhi(ua[e]), p0 = bflo(uq[e]), p1 = bfhi(uq[e]);
      float m0 = C.mu[mi][2 * e], m1 = C.mu[mi][2 * e + 1];
      o[2 * e] = x0 + (p0 - x0) * m0;
      o[2 * e + 1] = x1 + (p1 - x1) * m1;
    }
  };
  ld8(0, 0, xr);
  ld8(512, 1, xk);
  ld8(1024, 2, xv);
  float aa[8], gg[8];
  {
    uint4 a = *(const uint4*)(ab + (size_t)row * 512 + c0), g = *(const uint4*)(gb + (size_t)row * 512 + c0);
    unsigned ua[4] = {a.x, a.y, a.z, a.w}, ug[4] = {g.x, g.y, g.z, g.w};
#pragma unroll
    for (int e = 0; e < 4; ++e) {
      aa[2 * e] = bflo(ua[e]); aa[2 * e + 1] = bfhi(ua[e]);
      gg[2 * e] = bflo(ug[e]); gg[2 * e + 1] = bfhi(ug[e]);
    }
  }
  float bs = 0.f;
#pragma unroll
  for (int e = 0; e < 8; ++e) {
    float km = xk[e] * (1.f + (aa[e] - 1.f) * C.ka[e]);
    bs += xr[e] * km * C.rk[e];
  }
  bs = red8(bs);
  unsigned o[4];
#pragma unroll
  for (int e = 0; e < 4; ++e) {
    float v0 = ((y[2 * e] - mean) * rstd * C.lw[2 * e] + C.lb[2 * e] + bs * xv[2 * e]) * gg[2 * e];
    float v1 = ((y[2 * e + 1] - mean) * rstd * C.lw[2 * e + 1] + C.lb[2 * e + 1] + bs * xv[2 * e + 1]) * gg[2 * e + 1];
    o[e] = pack2bf(v0, v1);
  }
  *(uint4*)(mix + (size_t)row * 1024 + c0) = uint4{o[0], o[1], o[2], o[3]};
}

__device__ void phase5(const Params& p) {
  const int lane = threadIdx.x & 63, c0 = lane * 8;
  PostC C;
  auto ld = [&](const float* src, float* dst) {
    float4 a = *(const float4*)(src + c0), b = *(const float4*)(src + c0 + 4);
    dst[0] = a.x; dst[1] = a.y; dst[2] = a.z; dst[3] = a.w; dst[4] = b.x; dst[5] = b.y; dst[6] = b.z; dst[7] = b.w;
  };
  ld(p.mu, C.mu[0]); ld(p.mu + 512, C.mu[1]); ld(p.mu + 1024, C.mu[2]);
  ld(p.k_a, C.ka); ld(p.r_k, C.rk); ld(p.lnx_w, C.lw); ld(p.lnx_b, C.lb);
  for (int task = blockIdx.x; task < TTOK / 4; task += gridDim.x) post_task(p, task, C);
}

__device__ void phase6(const Params& p, char* smem) {
  const u16* mix = (const u16*)(p.ws + WS_B);
  const u16* wt = (const u16*)(p.ws + WS_WOUT);
  constexpr int MT = NOUT / 128, NT = 8;
  constexpr int N_CV = 0;
  const int wave = threadIdx.x >> 6, lane = threadIdx.x & 63;
  for (int task = xcd_vid(); task < MT * NT + N_CV; task += gridDim.x) {
    if (task < MT * NT) {
      int mt, nt;
      grouped_tile(task, MT, NT, mt, nt);
      int o0 = mt * 128;
      int arow = o0 + (o0 < 16384 ? 16 * (o0 / 4096 + 1) : 64);
      const float* xin = (o0 < 16384 ? p.x_prompt + (size_t)o0 * D : p.x_sample + (size_t)(o0 - 16384) * D) + nt * 128;
      float* xo = p.out + (size_t)o0 * D + nt * 128;
      u16* xb = (u16*)(p.ws + WS_X1B) + (size_t)o0 * D + nt * 128;
      float rs[4] = {0.f, 0.f, 0.f, 0.f};
      gemm_tile(mix + (size_t)arow * 1024, 1024, wt + (size_t)nt * 128 * 1024, 1024, 1024, smem,
                [&](int m, int r, int c, f32x4 v) {
                  float4 xi = *(const float4*)(xin + (size_t)r * D + c);
                  float4 xv = float4{xi.x + v[0], xi.y + v[1], xi.z + v[2], xi.w + v[3]};
                  *(float4*)(xo + (size_t)r * D + c) = xv;
                  *(uint2*)(xb + (size_t)r * D + c) = uint2{pack2bf(xv.x, xv.y), pack2bf(xv.z, xv.w)};
                  rs[m] += xv.x * xv.x + xv.y * xv.y + xv.z * xv.z + xv.w * xv.w;
                });
      {
        const int lane_ = threadIdx.x & 63, wid_ = threadIdx.x >> 6, wr_ = wid_ >> 1, wc_ = wid_ & 1;
        float* ssq = (float*)(p.ws + WS_SSQ);
#pragma unroll
        for (int m = 0; m < 4; ++m) {
          float t = rs[m];
          t += __shfl_xor(t, 16, 64);
          t += __shfl_xor(t, 32, 64);
          if ((lane_ >> 4) == 0) ssq[(size_t)(o0 + wr_ * 64 + m * 16 + (lane_ & 15)) * 16 + nt * 2 + wc_] = t;
        }
      }
    }
  }
}

__device__ void phase8(const Params& p, char* smem) {
  const u16* xb = (const u16*)(p.ws + WS_X1B);
  const u16* wt = (const u16*)(p.ws + WS_WQ);
  const float* ssq = (const float*)(p.ws + WS_SSQ);
  u16* q = (u16*)(p.ws + WS_Q);
  constexpr int MT = NOUT / 128, NT = 16, TOT = MT * NT;
  const int lane = threadIdx.x & 63, wr = (threadIdx.x >> 6) >> 1, fr = lane & 15;
  const int G = gridDim.x, full = p.full8, ntask = full + 4 * (TOT - full);
  auto row_rstd = [&](size_t row) {
    const float4* sp = (const float4*)(ssq + row * 16);
    float4 a = sp[0], b = sp[1], c = sp[2], d = sp[3];
    float ss = ((a.x + a.y) + (a.z + a.w)) + ((b.x + b.y) + (b.z + b.w)) + ((c.x + c.y) + (c.z + c.w)) + ((d.x + d.y) + (d.z + d.w));
    return rsqrtf(ss * (1.f / 1024.f) + 1e-5f);
  };
  for (int task = xcd_vid(); task < ntask; task += G) {
    int mt, nt;
    if (task < full) {
      grouped_tile(task, MT, NT, mt, nt);
      u16* crow = q + (size_t)mt * 128 * 2048 + nt * 128;
      float rstd[4];
#pragma unroll
      for (int m = 0; m < 4; ++m) rstd[m] = row_rstd((size_t)mt * 128 + wr * 64 + m * 16 + fr);
      gemm_tile(xb + (size_t)mt * 128 * D, D, wt + (size_t)nt * 128 * D, D, D, smem,
                [&](int m, int r, int c, f32x4 v) {
                  float sc = rstd[m];
                  *(uint2*)(crow + (size_t)r * 2048 + c) = uint2{pack2bf(v[0] * sc, v[1] * sc), pack2bf(v[2] * sc, v[3] * sc)};
                });
    } else {
      int rem = task - full, qd = rem & 3;
      grouped_tile(full + (rem >> 2), MT, NT, mt, nt);
      size_t r0 = (size_t)mt * 128 + qd * 32;
      u16* crow = q + r0 * 2048 + nt * 128;
      float rstd[2];
#pragma unroll
      for (int m = 0; m < 2; ++m) rstd[m] = row_rstd(r0 + m * 16 + fr);
      gemm_qtile(xb + r0 * D, D, wt + (size_t)nt * 128 * D, D, D, smem,
                 [&](int m, int r, int c, f32x4 v) {
                   float sc = rstd[m];
                   *(uint2*)(crow + (size_t)r * 2048 + c) = uint2{pack2bf(v[0] * sc, v[1] * sc), pack2bf(v[2] * sc, v[3] * sc)};
                 });
    }
  }
}

__device__ __forceinline__ unsigned ford(float f) {
  unsigned u = __float_as_uint(f);
  return (u & 0x80000000u) ? ~u : (u | 0x80000000u);
}
__device__ __forceinline__ float fdeord(unsigned k) {
  unsigned u = (k & 0x80000000u) ? (k & 0x7fffffffu) : ~k;
  return __uint_as_float(u);
}
__device__ __forceinline__ unsigned umax_(unsigned a, unsigned b) { return a > b ? a : b; }
__device__ __forceinline__ unsigned umin_(unsigned a, unsigned b) { return a < b ? a : b; }

#define CE_DESC(a, b) { unsigned _x = umax_(a, b), _y = umin_(a, b); a = _x; b = _y; }
#define CE_ASC(a, b) { unsigned _x = umin_(a, b), _y = umax_(a, b); a = _x; b = _y; }

template <int N>
__device__ __forceinline__ void bitonic_sort_desc(unsigned (&k)[N]) {
#pragma unroll
  for (int sz = 2; sz <= N; sz <<= 1) {
#pragma unroll
    for (int st = sz >> 1; st > 0; st >>= 1) {
#pragma unroll
      for (int i = 0; i < N; ++i) {
        int l = i ^ st;
        if (l > i) {
          if ((i & sz) == 0) CE_DESC(k[i], k[l]) else CE_ASC(k[i], k[l])
        }
      }
    }
  }
}
template <int N>
__device__ __forceinline__ void bitonic_merge_desc(unsigned (&k)[N]) {
#pragma unroll
  for (int st = N >> 1; st > 0; st >>= 1) {
#pragma unroll
    for (int i = 0; i < N; ++i) {
      int l = i ^ st;
      if (l > i) CE_DESC(k[i], k[l])
    }
  }
}
__device__ __forceinline__ void cross_merge16(unsigned (&k)[16]) {
#pragma unroll
  for (int x = 16; x <= 32; x <<= 1) {
    unsigned o[16];
#pragma unroll
    for (int i = 0; i < 16; ++i) o[i] = (unsigned)__shfl_xor((int)k[i], x, 64);
#pragma unroll
    for (int i = 0; i < 16; ++i) k[i] = umax_(k[i], o[15 - i]);
    bitonic_merge_desc<16>(k);
  }
}

__device__ __forceinline__ unsigned sel16(const unsigned (&a)[16], int k) {
  unsigned r = a[0];
#pragma unroll
  for (int i = 1; i < 16; ++i) r = (k == i) ? a[i] : r;
  return r;
}

__device__ void topk_unit(const Params& p, const char* smem, int tg, int h) {
  const int tid = threadIdx.x, lane = tid & 63, fr = lane & 15, fq = lane >> 4;
  const u16* q = (const u16*)(p.ws + WS_Q);
  int* idxo = (int*)(p.ws + WS_IDX);
  float* gateo = (float*)(p.ws + WS_GATE);
  const int o0 = tg * 16;
  float v1[16], v2[16];
  unsigned pk1[4] = {0u, 0u, 0u, 0u}, pk2[4] = {0u, 0u, 0u, 0u};
#pragma unroll
  for (int c = 0; c < 2; ++c) {
    bf16x8 qb[4];
#pragma unroll
    for (int ks = 0; ks < 4; ++ks)
      qb[ks] = *(const bf16x8*)(q + (size_t)(o0 + fr) * 2048 + (h * 2 + c) * 128 + ks * 32 + fq * 8);
    f32x4 acc[8];
#pragma unroll
    for (int i = 0; i < 8; ++i) acc[i] = f32x4{0.f, 0.f, 0.f, 0.f};
#pragma unroll
    for (int ks = 0; ks < 4; ++ks) {
#pragma unroll
      for (int mt = 0; mt < 8; ++mt) {
        bf16x8 ka = *(const bf16x8*)(smem + (c * 128 + mt * 16 + fr) * 256 + (((ks * 4 + fq) ^ fr) << 4));
        acc[mt] = mfma16(ka, qb[ks], acc[mt]);
      }
      __builtin_amdgcn_sched_barrier(0);
    }
    unsigned lo[16], hi[16];
#pragma unroll
    for (int mt = 0; mt < 4; ++mt)
#pragma unroll
      for (int j = 0; j < 4; ++j) {
        lo[mt * 4 + j] = (ford(acc[mt][j]) & 0xffffff80u) | (unsigned)(127 - (mt * 16 + fq * 4 + j));
        hi[mt * 4 + j] = (ford(acc[mt + 4][j]) & 0xffffff80u) | (unsigned)(127 - ((mt + 4) * 16 + fq * 4 + j));
      }
    bitonic_sort_desc<16>(lo);
    bitonic_sort_desc<16>(hi);
#pragma unroll
    for (int i = 0; i < 16; ++i) lo[i] = umax_(lo[i], hi[15 - i]);
    bitonic_merge_desc<16>(lo);
    cross_merge16(lo);
#pragma unroll
    for (int i = 0; i < 16; ++i) {
      float val = fdeord(lo[i] & 0xffffff80u);
      unsigned ix = (127u - (lo[i] & 0x7fu)) << ((i & 3) * 8);
      if (c == 0) { v1[i] = val; pk1[i >> 2] |= ix; } else { v2[i] = val; pk2[i >> 2] |= ix; }
    }
  }
  unsigned ck[16];
#define CAND(i, j) ((ford(v1[i] + v2[j]) & 0xffffff00u) | (unsigned)((i) * 16 + (j)))
#define SEL4(slot, A, B, C, Dv) ck[slot] = (fq == 0) ? (A) : (fq == 1) ? (B) : (fq == 2) ? (C) : (Dv);
  SEL4(0, CAND(0, 0), CAND(1, 0), CAND(3, 3), CAND(14, 0))
  SEL4(1, CAND(0, 1), CAND(1, 1), CAND(4, 0), CAND(15, 0))
  SEL4(2, CAND(0, 2), CAND(1, 2), CAND(4, 1), 0u)
  SEL4(3, CAND(0, 3), CAND(1, 3), CAND(4, 2), 0u)
  SEL4(4, CAND(0, 4), CAND(1, 4), CAND(5, 0), 0u)
  SEL4(5, CAND(0, 5), CAND(1, 5), CAND(5, 1), 0u)
  SEL4(6, CAND(0, 6), CAND(1, 6), CAND(6, 0), 0u)
  SEL4(7, CAND(0, 7), CAND(1, 7), CAND(6, 1), 0u)
  SEL4(8, CAND(0, 8), CAND(2, 0), CAND(7, 0), 0u)
  SEL4(9, CAND(0, 9), CAND(2, 1), CAND(7, 1), 0u)
  SEL4(10, CAND(0, 10), CAND(2, 2), CAND(8, 0), 0u)
  SEL4(11, CAND(0, 11), CAND(2, 3), CAND(9, 0), 0u)
  SEL4(12, CAND(0, 12), CAND(2, 4), CAND(10, 0), 0u)
  SEL4(13, CAND(0, 13), CAND(3, 0), CAND(11, 0), 0u)
  SEL4(14, CAND(0, 14), CAND(3, 1), CAND(12, 0), 0u)
  SEL4(15, CAND(0, 15), CAND(3, 2), CAND(13, 0), 0u)
#undef SEL4
#undef CAND
  bitonic_sort_desc<16>(ck);
  cross_merge16(ck);
  float top[16], esum = 0.f;
#pragma unroll
  for (int i = 0; i < 16; ++i) top[i] = fdeord(ck[i] & 0xffffff00u);
  const float tmax = top[0];
#pragma unroll
  for (int i = 0; i < 16; ++i) top[i] = __expf(top[i] - tmax);
#pragma unroll
  for (int i = 0; i < 16; ++i) esum += top[i];
  float inv = 1.f / esum;
  int oi[4];
  float og[4];
#pragma unroll
  for (int jj = 0; jj < 4; ++jj) {
    unsigned kk = (fq == 0) ? ck[jj] : (fq == 1) ? ck[4 + jj] : (fq == 2) ? ck[8 + jj] : ck[12 + jj];
    float tv = (fq == 0) ? top[jj] : (fq == 1) ? top[4 + jj] : (fq == 2) ? top[8 + jj] : top[12 + jj];
    int code = (int)(kk & 0xffu);
    int ci = code >> 4, cj = code & 15;
    unsigned d1 = (ci < 8) ? ((ci < 4) ? pk1[0] : pk1[1]) : ((ci < 12) ? pk1[2] : pk1[3]);
    unsigned d2 = (cj < 8) ? ((cj < 4) ? pk2[0] : pk2[1]) : ((cj < 12) ? pk2[2] : pk2[3]);
    int i1 = (int)((d1 >> ((ci & 3) * 8)) & 0xffu), i2 = (int)((d2 >> ((cj & 3) * 8)) & 0xffu);
    oi[jj] = i1 * 128 + i2;
    og[jj] = tv * inv;
  }
  size_t ob = (size_t)(o0 + fr) * 128 + h * 16 + fq * 4;
  *(int4*)(idxo + ob) = int4{oi[0], oi[1], oi[2], oi[3]};
  *(float4*)(gateo + ob) = float4{og[0], og[1], og[2], og[3]};
}

__device__ void phase9(const Params& p, char* smem) {
  const int w = threadIdx.x >> 6;
  {
    const u16* subk = (const u16*)(p.ws + WS_SUBK);
    for (int i = threadIdx.x; i < 4096; i += 256) {
      int row = i >> 4, lc = i & 15;
      *(uint4*)(smem + row * 256 + ((lc ^ (row & 15)) << 4)) = *(const uint4*)(subk + row * 128 + lc * 8);
    }
    __syncthreads();
  }
  for (int task = blockIdx.x; task < (NOUT / 16) * 2; task += gridDim.x) {
    int tg = task >> 1, h = (task & 1) * 4 + w;
    topk_unit(p, smem, tg, h);
  }
  __syncthreads();
}

#define F4(w, b) __builtin_amdgcn_cvt_scalef32_pk_f32_fp4((w), 1.0f, (b))
__device__ __forceinline__ float dot16f8(const float* h, uint2 u, float acc) {
  const float2v* h2 = (const float2v*)h;
  float2v a2 = {acc, 0.f};
  unsigned w[2] = {u.x, u.y};
#pragma unroll
  for (int i = 0; i < 2; ++i) {
    a2 = __builtin_elementwise_fma(h2[4 * i], F4(w[i], 0), a2);
    a2 = __builtin_elementwise_fma(h2[4 * i + 1], F4(w[i], 1), a2);
    a2 = __builtin_elementwise_fma(h2[4 * i + 2], F4(w[i], 2), a2);
    a2 = __builtin_elementwise_fma(h2[4 * i + 3], F4(w[i], 3), a2);
  }
  return a2.x + a2.y;
}
__device__ __forceinline__ void axpy16f8(float a, uint2 v, float* acc) {
  float2v* c2 = (float2v*)acc;
  const float2v aa = {a, a};
  unsigned w[2] = {v.x, v.y};
#pragma unroll
  for (int i = 0; i < 2; ++i) {
    c2[4 * i] = __builtin_elementwise_fma(aa, F4(w[i], 0), c2[4 * i]);
    c2[4 * i + 1] = __builtin_elementwise_fma(aa, F4(w[i], 1), c2[4 * i + 1]);
    c2[4 * i + 2] = __builtin_elementwise_fma(aa, F4(w[i], 2), c2[4 * i + 2]);
    c2[4 * i + 3] = __builtin_elementwise_fma(aa, F4(w[i], 3), c2[4 * i + 3]);
  }
}
__device__ __forceinline__ float reduce4(float d0, float d1, float d2, float d3) {
  auto s1 = __builtin_amdgcn_permlane32_swap(__float_as_uint(d0), __float_as_uint(d1), false, false);
  float s01 = __uint_as_float(s1[0]) + __uint_as_float(s1[1]);
  auto s2 = __builtin_amdgcn_permlane32_swap(__float_as_uint(d2), __float_as_uint(d3), false, false);
  float s23 = __uint_as_float(s2[0]) + __uint_as_float(s2[1]);
  auto s3 = __builtin_amdgcn_permlane16_swap(__float_as_uint(s01), __float_as_uint(s23), false, false);
  float t = __uint_as_float(s3[0]) + __uint_as_float(s3[1]);
  return red16(t);
}

__device__ void gather_task(const Params& p, int task) {
  const int wave = threadIdx.x >> 6, lane = threadIdx.x & 63;
  int o = task * 4 + wave;
  const unsigned char* eu8 = (const unsigned char*)(p.ws + WS_EU) + lane * 8;
  const unsigned char* ev8 = (const unsigned char*)(p.ws + WS_EV) + lane * 8;
  const float* scu = (const float*)(p.ws + WS_SCU);
  const float* scv = (const float*)(p.ws + WS_SCV);
  const int* idx = (const int*)(p.ws + WS_IDX) + (size_t)o * 128;
  const float* gate = (const float*)(p.ws + WS_GATE) + (size_t)o * 128;
  float* xrow = p.out + (size_t)o * D + lane * 16;
  __attribute__((aligned(8))) float hf[16];
  {
    float x[16];
#pragma unroll
    for (int i = 0; i < 4; ++i) {
      float4 a = ((const float4*)xrow)[i];
      x[4 * i] = a.x; x[4 * i + 1] = a.y; x[4 * i + 2] = a.z; x[4 * i + 3] = a.w;
    }
    float ss2 = 0.f;
#pragma unroll
    for (int i = 0; i < 16; ++i) ss2 += x[i] * x[i];
    ss2 = wave_sum(ss2);
    float sc2 = rsqrtf(ss2 * (1.f / 1024.f) + 1e-5f);
    const float* g2 = p.norm2_g + lane * 16;
#pragma unroll
    for (int i = 0; i < 4; ++i) {
      float4 gg = ((const float4*)g2)[i];
      hf[4 * i] = x[4 * i] * sc2 * gg.x; hf[4 * i + 1] = x[4 * i + 1] * sc2 * gg.y;
      hf[4 * i + 2] = x[4 * i + 2] * sc2 * gg.z; hf[4 * i + 3] = x[4 * i + 3] * sc2 * gg.w;
    }
  }
  __attribute__((aligned(8))) float acc[16];
#pragma unroll
  for (int i = 0; i < 16; ++i) acc[i] = 0.f;
  const int rw = lane >> 4;
  const int kl = (lane & 3) * 4 + ((rw == 1) ? 2 : (rw == 2) ? 1 : rw);
  const int i0 = idx[lane], i1 = idx[64 + lane];
  const float su0 = scu[i0], su1 = scu[i1];
  const float fv0 = gate[lane] * scv[i0], fv1 = gate[64 + lane] * scv[i1];
  for (int kb = 0; kb < 8; ++kb) {
    const int myidx = (kb < 4) ? i0 : i1;
    const int lb = (kb & 3) * 16;
    const float su = __shfl((kb < 4) ? su0 : su1, lb + kl, 64);
    const float fv = __shfl((kb < 4) ? fv0 : fv1, lb + kl, 64);
    float mypre = 0.f;
    {
      uint2 ua[16];
#pragma unroll
      for (int e = 0; e < 16; ++e) {
        int ei = __builtin_amdgcn_readlane(myidx, lb + e);
        ua[e] = *(const uint2*)(eu8 + (size_t)ei * 512);
      }
#pragma unroll
      for (int g = 0; g < 4; ++g) {
        float d0 = dot16f8(hf, ua[4 * g], 0.f), d1 = dot16f8(hf, ua[4 * g + 1], 0.f), d2 = dot16f8(hf, ua[4 * g + 2], 0.f),
              d3 = dot16f8(hf, ua[4 * g + 3], 0.f);
        float tot = reduce4(d0, d1, d2, d3);
        mypre = ((lane & 3) == g) ? tot : mypre;
      }
    }
    mypre *= su;
    float myact = 0.5f * mypre * (1.f + erff(mypre * 0.70710678118654752f)) * fv;
#pragma unroll
    for (int e8 = 0; e8 < 2; ++e8) {
      uint2 va[8];
      float a[8];
#pragma unroll
      for (int e = 0; e < 8; ++e) {
        int ei = __builtin_amdgcn_readlane(myidx, lb + e8 * 8 + e);
        const int e3 = e & 3, e4 = e8 * 2 + (e >> 2);
        const int pr = (e3 == 1) ? 2 : (e3 == 2) ? 1 : e3;
        a[e] = rdlane(myact, pr * 16 + e4);
        va[e] = *(const uint2*)(ev8 + (size_t)ei * 512);
      }
#pragma unroll
      for (int e = 0; e < 8; ++e) axpy16f8(a[e], va[e], acc);
    }
  }
  float x[16];
#pragma unroll
  for (int i = 0; i < 4; ++i) {
    float4 a = ((const float4*)xrow)[i];
    x[4 * i] = a.x; x[4 * i + 1] = a.y; x[4 * i + 2] = a.z; x[4 * i + 3] = a.w;
  }
  float ss = 0.f;
#pragma unroll
  for (int i = 0; i < 16; ++i) { x[i] += acc[i]; ss += x[i] * x[i]; }
  ss = wave_sum(ss);
  float sc = rsqrtf(ss * (1.f / 1024.f) + 1e-5f);
  const float* g = p.final_g + lane * 16;
#pragma unroll
  for (int i = 0; i < 4; ++i) {
    float4 gg = ((const float4*)g)[i];
    ((float4*)xrow)[i] = float4{x[4 * i] * sc * gg.x, x[4 * i + 1] * sc * gg.y, x[4 * i + 2] * sc * gg.z, x[4 * i + 3] * sc * gg.w};
  }
}

__device__ void gather_task_block(const Params& p, char* smem, int o) {
  const int wave = threadIdx.x >> 6, lane = threadIdx.x & 63;
  const unsigned char* eu8 = (const unsigned char*)(p.ws + WS_EU) + lane * 8;
  const unsigned char* ev8 = (const unsigned char*)(p.ws + WS_EV) + lane * 8;
  const float* scu = (const float*)(p.ws + WS_SCU);
  const float* scv = (const float*)(p.ws + WS_SCV);
  const int* idx = (const int*)(p.ws + WS_IDX) + (size_t)o * 128;
  const float* gate = (const float*)(p.ws + WS_GATE) + (size_t)o * 128;
  float* orow = p.out + (size_t)o * D;
  __attribute__((aligned(8))) float hf[16];
  {
    const float* xrow = orow + lane * 16;
    float x[16];
#pragma unroll
    for (int i = 0; i < 4; ++i) {
      float4 a = ((const float4*)xrow)[i];
      x[4 * i] = a.x; x[4 * i + 1] = a.y; x[4 * i + 2] = a.z; x[4 * i + 3] = a.w;
    }
    float ss2 = 0.f;
#pragma unroll
    for (int i = 0; i < 16; ++i) ss2 += x[i] * x[i];
    ss2 = wave_sum(ss2);
    float sc2 = rsqrtf(ss2 * (1.f / 1024.f) + 1e-5f);
    const float* g2 = p.norm2_g + lane * 16;
#pragma unroll
    for (int i = 0; i < 4; ++i) {
      float4 gg = ((const float4*)g2)[i];
      hf[4 * i] = x[4 * i] * sc2 * gg.x; hf[4 * i + 1] = x[4 * i + 1] * sc2 * gg.y;
      hf[4 * i + 2] = x[4 * i + 2] * sc2 * gg.z; hf[4 * i + 3] = x[4 * i + 3] * sc2 * gg.w;
    }
  }
  __attribute__((aligned(8))) float acc[16];
#pragma unroll
  for (int i = 0; i < 16; ++i) acc[i] = 0.f;
  const int rw = lane >> 4;
  const int kl = (lane & 3) * 4 + ((rw == 1) ? 2 : (rw == 2) ? 1 : rw);
#pragma unroll
  for (int kq = 0; kq < 2; ++kq) {
    const int kb = wave * 2 + kq;
    int myidx = idx[kb * 16 + (lane & 15)];
    int myidx2 = idx[kb * 16 + kl];
    float mygate = gate[kb * 16 + kl];
    float su = scu[myidx2], sv = scv[myidx2];
    float mypre = 0.f;
#pragma unroll
    for (int e8 = 0; e8 < 2; ++e8) {
      uint2 ua[8];
#pragma unroll
      for (int e = 0; e < 8; ++e) {
        int ei = __builtin_amdgcn_readlane(myidx, e8 * 8 + e);
        ua[e] = *(const uint2*)(eu8 + (size_t)ei * 512);
      }
      float d[8];
#pragma unroll
      for (int e = 0; e < 8; ++e) d[e] = dot16f8(hf, ua[e], 0.f);
      float tot0 = reduce4(d[0], d[1], d[2], d[3]);
      float tot1 = reduce4(d[4], d[5], d[6], d[7]);
      mypre = ((lane & 3) == e8 * 2) ? tot0 : mypre;
      mypre = ((lane & 3) == e8 * 2 + 1) ? tot1 : mypre;
    }
    mypre *= su;
    float myact = 0.5f * mypre * (1.f + erff(mypre * 0.70710678118654752f)) * mygate * sv;
#pragma unroll
    for (int e8 = 0; e8 < 2; ++e8) {
      uint2 va[8];
      float a[8];
#pragma unroll
      for (int e = 0; e < 8; ++e) {
        int ei = __builtin_amdgcn_readlane(myidx, e8 * 8 + e);
        const int e3 = e & 3, e4 = e8 * 2 + (e >> 2);
        const int pr = (e3 == 1) ? 2 : (e3 == 2) ? 1 : e3;
        a[e] = rdlane(myact, pr * 16 + e4);
        va[e] = *(const uint2*)(ev8 + (size_t)ei * 512);
      }
#pragma unroll
      for (int e = 0; e < 8; ++e) axpy16f8(a[e], va[e], acc);
    }
  }
  float* part = (float*)smem;
  float* red = part + 4096;
#pragma unroll
  for (int i = 0; i < 4; ++i)
    *(float4*)(part + wave * 1024 + lane * 16 + 4 * i) = float4{acc[4 * i], acc[4 * i + 1], acc[4 * i + 2], acc[4 * i + 3]};
  __syncthreads();
  const int c = threadIdx.x * 4;
  float4 xv = *(const float4*)(orow + c);
#pragma unroll
  for (int k = 0; k < 4; ++k) {
    float4 pv = *(const float4*)(part + k * 1024 + c);
    xv.x += pv.x; xv.y += pv.y; xv.z += pv.z; xv.w += pv.w;
  }
  float ss = wave_sum(xv.x * xv.x + xv.y * xv.y + xv.z * xv.z + xv.w * xv.w);
  if (lane == 0) red[wave] = ss;
  __syncthreads();
  ss = (red[0] + red[1]) + (red[2] + red[3]);
  float sc = rsqrtf(ss * (1.f / 1024.f) + 1e-5f);
  float4 gg = *(const float4*)(p.final_g + c);
  *(float4*)(orow + c) = float4{xv.x * sc * gg.x, xv.y * sc * gg.y, xv.z * sc * gg.z, xv.w * sc * gg.w};
  __syncthreads();
}

__device__ void phase10(const Params& p, char* smem) {
  const int G = gridDim.x, full = p.full10;
  for (int task = blockIdx.x; task < full; task += G) gather_task(p, task);
  for (int o = full * 4 + blockIdx.x; o < NOUT; o += G) gather_task_block(p, smem, o);
}

#define XB_TMO      128
#define XB_XCNT(j)  (256  + 64 * (j))
#define XB_XSUB(j)  (1280 + 64 * (j))
#define XB_XGEN(j)  (2304 + 64 * (j))
#define XB_TOP      3328
#define XB_TOPGEN   3392
#define XCD_BAR_WORDS 3456
#define XB_SPIN_CAP (1u << 20)
__device__ __forceinline__ unsigned xb_ld(unsigned* p) { return __hip_atomic_load(p, __ATOMIC_RELAXED, __HIP_MEMORY_SCOPE_AGENT); }
__device__ __forceinline__ unsigned xb_add(unsigned* p, unsigned v) { return __hip_atomic_fetch_add(p, v, __ATOMIC_RELAXED, __HIP_MEMORY_SCOPE_AGENT); }
__device__ __forceinline__ unsigned xb_xcc_id() { return (unsigned)__builtin_amdgcn_s_getreg((3 << 11) | 20) & 0xFu; }
#define XB_SPIN(cond, bar) do { unsigned _sp = 0; while (cond) { __builtin_amdgcn_s_sleep(1); \
    if ((++_sp & 255u) == 0u) { if (xb_ld(&(bar)[XB_TMO])) break; if (_sp > XB_SPIN_CAP) { atomicAdd(&(bar)[XB_TMO], 1u); break; } } } } while (0)

struct GridBar { int dummy; };

__device__ __forceinline__ GridBar gb_init(unsigned* bar) {
  GridBar b;
  b.dummy = 0;
  if (threadIdx.x == 0) (void)xb_add(&bar[XB_XCNT(xb_xcc_id())], 1u);
  return b;
}
__device__ __forceinline__ void gb_census(unsigned* bar, unsigned x, unsigned& nloc, unsigned& nx) {
  const unsigned G = gridDim.x;
  unsigned sum, cnt, mine, sp = 0u;
  for (;;) {
    sum = 0u; cnt = 0u; mine = 0u;
#pragma unroll
    for (unsigned j = 0; j < 16; ++j) {
      const unsigned c = xb_ld(&bar[XB_XCNT(j)]);
      sum += c; cnt += (c > 0u) ? 1u : 0u; mine = (j == x) ? c : mine;
    }
    if (sum == G) break;
    __builtin_amdgcn_s_sleep(1);
    if ((++sp & 255u) == 0u) { if (xb_ld(&bar[XB_TMO])) break; if (sp > XB_SPIN_CAP) { atomicAdd(&bar[XB_TMO], 1u); break; } }
  }
  nloc = mine > 0u ? mine : 1u; nx = cnt > 0u ? cnt : 1u;
}
template <bool FIRST>
__device__ __forceinline__ void gb_sync(GridBar& b, unsigned* bar) {
  asm volatile("s_waitcnt vmcnt(0)" ::: "memory");
  __syncthreads();
  if (threadIdx.x == 0) {
    const unsigned x = xb_xcc_id();
    __builtin_amdgcn_s_waitcnt(0);
    unsigned* slot = bar + 4096 + 2 * blockIdx.x;
    unsigned nloc, nx;
    if (FIRST) { gb_census(bar, x, nloc, nx); slot[0] = nloc; slot[1] = nx; }
    else { nloc = __hip_atomic_load(&slot[0], __ATOMIC_RELAXED, __HIP_MEMORY_SCOPE_AGENT); nx = __hip_atomic_load(&slot[1], __ATOMIC_RELAXED, __HIP_MEMORY_SCOPE_AGENT); }
    const unsigned old = xb_add(&bar[XB_XSUB(x)], 1u);
    const unsigned gen = old / nloc;
    if (old + 1u == (gen + 1u) * nloc) {
      __builtin_amdgcn_fence(__ATOMIC_RELEASE, "agent");
      asm volatile("s_waitcnt vmcnt(0)" ::: "memory");
      const unsigned og = xb_add(&bar[XB_TOP], 1u);
      const unsigned tg = og / nx;
      if (og + 1u == (tg + 1u) * nx) xb_add(&bar[XB_TOPGEN], 1u);
      else XB_SPIN(xb_ld(&bar[XB_TOPGEN]) == tg, bar);
      __builtin_amdgcn_fence(__ATOMIC_ACQUIRE, "agent");
      xb_add(&bar[XB_XGEN(x)], 1u);
      asm volatile("s_waitcnt vmcnt(0)" ::: "memory");
    } else {
      XB_SPIN(xb_ld(&bar[XB_XGEN(x)]) == gen, bar);
      __builtin_amdgcn_fence(__ATOMIC_ACQUIRE, "agent");
      asm volatile("s_waitcnt vmcnt(0)" ::: "memory");
    }
  }
  __syncthreads();
}

template <int PH>
__device__ __forceinline__ void run_phase(const Params& p, char* smem) {
  if constexpr (PH == 0) phase0(p, smem);
  if constexpr (PH == 1) phase1(p, smem);
  if constexpr (PH == 2) phase2(p);
  if constexpr (PH == 3) phase3(p, smem);
  if constexpr (PH == 4) phase4(p, smem);
  if constexpr (PH == 5) phase5(p);
  if constexpr (PH == 6) phase6(p, smem);
  if constexpr (PH == 8) phase8(p, smem);
  if constexpr (PH == 9) phase9(p, smem);
  if constexpr (PH == 10) phase10(p, smem);
}

template <int LO, int HI>
__device__ __forceinline__ void run_range(const Params& p, char* smem, GridBar& gb) {
  if constexpr (LO < HI) {
    run_phase<LO>(p, smem);
    if constexpr (LO + 1 < HI) {
      if constexpr (LO != 7) gb_sync<LO == 0>(gb, (unsigned*)(p.ws + WS_BAR));
      run_range<LO + 1, HI>(p, smem, gb);
    }
  }
}

template <int LO, int HI>
__global__ void __launch_bounds__(256, 2) fwd_kernel(Params p) {
  __shared__ __attribute__((aligned(16))) char smem[SMEM_BYTES];
  if (p.ws == nullptr) cg::this_grid().sync();
  GridBar gb = gb_init((unsigned*)(p.ws + WS_BAR));
  run_range<LO, HI>(p, smem, gb);
}

template <int PH>
static void launch_one(const Params& p, int grid, hipStream_t stream) {
  fwd_kernel<PH, PH + 1><<<grid, 256, 0, stream>>>(p);
}

extern "C" void kernel_launch(void* const* d_in, const int* in_sizes, int n_in, void* d_out, int out_size, void* d_ws,
                              size_t ws_size, hipStream_t stream) {
  Params p{};
  const float** pp = (const float**)&p;
  for (int i = 0; i < 28; ++i) pp[i] = (const float*)d_in[i];
  p.out = (float*)d_out;
  p.ws = (char*)d_ws;
#if MULTI_LAUNCH
  const int grid = 1024;
  p.full1 = ((MROWS / 128) * 20 / grid) * grid; p.full8 = ((NOUT / 128) * 16 / grid) * grid; p.full10 = ((NOUT / 4) / grid) * grid; p.pad_ = 0;
  launch_one<0>(p, grid, stream);
  launch_one<1>(p, grid, stream);
  launch_one<2>(p, grid, stream);
  launch_one<3>(p, grid, stream);
  launch_one<4>(p, grid, stream);
  launch_one<5>(p, grid, stream);
  launch_one<6>(p, grid, stream);
  launch_one<7>(p, grid, stream);
  launch_one<8>(p, grid, stream);
  launch_one<9>(p, grid, stream);
  launch_one<10>(p, grid, stream);
#else
  static int grid_blocks = 0;
  if (!grid_blocks) {
    int dev = 0, cus = 0, per_cu = 0;
    (void)hipGetDevice(&dev);
    (void)hipDeviceGetAttribute(&cus, hipDeviceAttributeMultiprocessorCount, dev);
    (void)hipOccupancyMaxActiveBlocksPerMultiprocessor(&per_cu, fwd_kernel<0, NPH>, 256, 0);
    if (per_cu < 1) per_cu = 1;
    if (per_cu > 4) per_cu = 4;
    grid_blocks = cus * per_cu;
  }
  (void)hipMemsetAsync((char*)d_ws + WS_BAR, 0, XCD_BAR_WORDS * sizeof(unsigned), stream);
  p.full1 = ((MROWS / 128) * 20 / grid_blocks) * grid_blocks;
  p.full8 = ((NOUT / 128) * 16 / grid_blocks) * grid_blocks;
  p.full10 = ((NOUT / 4) / grid_blocks) * grid_blocks;
  p.pad_ = 0;
  void* args[] = {&p};
  hipError_t e = hipLaunchCooperativeKernel((void*)fwd_kernel<0, NPH>, dim3(grid_blocks), dim3(256), args, 0, stream);
  if (e != hipSuccess) fprintf(stderr, "cooperative launch failed: %s (grid %d)\n", hipGetErrorString(e), grid_blocks);
#endif
}
```

```cpp
#include <hip/hip_runtime.h>
#include <hip/hip_cooperative_groups.h>
#include <cstdio>
#include <cstdint>
namespace cg = cooperative_groups;

typedef unsigned short u16;
using bf16x8 = __attribute__((ext_vector_type(8))) short;
using f32x4 = __attribute__((ext_vector_type(4))) float;
using half2v = __attribute__((ext_vector_type(2))) _Float16;
using float2v = __attribute__((ext_vector_type(2))) float;

#ifndef MULTI_LAUNCH
#define MULTI_LAUNCH 0
#endif

constexpr int D = 1024, NIN = 2560;
constexpr int LP = 4112, NB = 4, TP = NB * LP;
constexpr int SB = 128, TS = 512;
constexpr int TTOK = TP + TS;
constexpr int PREV0 = TTOK;
constexpr int MROWS = 17152;
constexpr int TPAD = 17024;
constexpr int NOUT = 16896;
constexpr int PAST = 8192;
constexpr int NPH = 11;

constexpr size_t O_YP = 0;
constexpr size_t O_KWP = 17301504, O_VWP = 17367040, O_WKVP = 17432576, O_SHP = 17563648;
constexpr size_t O_KWS = 17567744, O_VWS = 19664896, O_WKVS = 21762048, O_SHS = 25956352;

constexpr size_t WS_WIN = 0;
constexpr size_t WS_WOUT = WS_WIN + 2560ull * 1024 * 2;
constexpr size_t WS_WQ = WS_WOUT + 1024ull * 1024 * 2;
constexpr size_t WS_SUBK = WS_WQ + 2048ull * 1024 * 2;
constexpr size_t WS_W2W = WS_SUBK + 2ull * 128 * 128 * 2;
constexpr size_t WS_W2A = WS_W2W + 512ull * 64 * 2;
constexpr size_t WS_W2G = WS_W2A + 512ull * 64 * 2;
constexpr size_t WS_B = WS_W2G + 512ull * 128 * 2;
constexpr size_t WS_C = WS_B + (size_t)MROWS * 1024 * 2;
constexpr size_t WS_D = WS_C + (size_t)MROWS * NIN * 2;
constexpr size_t WS_E = WS_D + (size_t)TPAD * 512 * 8;
constexpr size_t WS_END = WS_E + (size_t)TPAD * 512 * 4;
constexpr size_t WS_DEC = WS_D, WS_A = WS_D + (size_t)TPAD * 512 * 4, WS_G = WS_A + (size_t)TPAD * 512 * 2;
constexpr size_t WS_EU = WS_E, WS_EV = WS_E + 16384ull * 512, WS_SCU = WS_EV + 16384ull * 512, WS_SCV = WS_SCU + 65536;
constexpr size_t WS_X1B = WS_D, WS_SSQ = WS_D + 40ull * 1024 * 1024;
constexpr size_t WS_Q = WS_C, WS_IDX = WS_C + (size_t)NOUT * 2048 * 2, WS_GATE = WS_IDX + (size_t)NOUT * 128 * 4;
static_assert(WS_SCV + 65536 <= WS_END, "expert tables overflow region E");
static_assert(WS_X1B + (size_t)NOUT * 2048 <= WS_SSQ && WS_SSQ + (size_t)NOUT * 64 <= WS_E, "x1b/ssq overflow region D");
static_assert(WS_GATE + (size_t)NOUT * 128 * 4 <= WS_D, "idx/gate overflow region C");
constexpr size_t WS_BAR = WS_END;
static_assert(WS_BAR + 32768 <= 256ull * 1024 * 1024, "workspace too large");

constexpr int SMEM_BYTES = 65536;

struct Params {
  const float *x_prompt, *x_sample, *cache_k, *cache_v, *state_wkv, *state_shift, *meta, *norm1_g, *w_in, *mu, *w0,
      *w2w, *a0, *w2a, *w2g, *k_k, *k_a, *r_k, *lnx_w, *lnx_b, *sinks, *w_out, *norm2_g, *w_query, *sub_keys, *eu,
      *ev, *final_g;
  float* out;
  char* ws;
  int full1, full8, full10, pad_;
};

__constant__ double INVF[8] = {1.0, 0.19392274474868576, 0.03760603093086393, 0.007292664737217109,
                               0.001414213562373095, 0.0002742481756762073, 5.318295896944988e-05,
                               1.031338537721246e-05};

__device__ __forceinline__ u16 f2bf(float f) {
  unsigned u = __float_as_uint(f);
  u += 0x7fffu + ((u >> 16) & 1u);
  return (u16)(u >> 16);
}
__device__ __forceinline__ float bf2f(u16 h) { return __uint_as_float(((unsigned)h) << 16); }
__device__ __forceinline__ float bflo(unsigned u) { return __uint_as_float(u << 16); }
__device__ __forceinline__ float bfhi(unsigned u) { return __uint_as_float(u & 0xffff0000u); }
__device__ __forceinline__ unsigned pack2bf(float a, float b) { return (unsigned)f2bf(a) | ((unsigned)f2bf(b) << 16); }
__device__ __forceinline__ u16 f2h(float f) {
  _Float16 h = (_Float16)f;
  return __builtin_bit_cast(u16, h);
}

template <int CTRL>
__device__ __forceinline__ float dppf(float x) {
  return __int_as_float(__builtin_amdgcn_update_dpp(0, __float_as_int(x), CTRL, 0xF, 0xF, false));
}
__device__ __forceinline__ float red4(float x) {
  x += dppf<0xB1>(x);
  x += dppf<0x4E>(x);
  return x;
}
__device__ __forceinline__ float red8(float x) {
  x = red4(x);
  x += dppf<0x141>(x);
  return x;
}
__device__ __forceinline__ float red16(float x) {
  x = red8(x);
  x += dppf<0x140>(x);
  return x;
}
__device__ __forceinline__ float redmax16(float x) {
  x = fmaxf(x, dppf<0xB1>(x));
  x = fmaxf(x, dppf<0x4E>(x));
  x = fmaxf(x, dppf<0x141>(x));
  x = fmaxf(x, dppf<0x140>(x));
  return x;
}
__device__ __forceinline__ float rdlane(float x, int l) {
  return __int_as_float(__builtin_amdgcn_readlane(__float_as_int(x), l));
}
__device__ __forceinline__ float wave_sum(float x) {
  x = red16(x);
  return rdlane(x, 0) + rdlane(x, 16) + rdlane(x, 32) + rdlane(x, 48);
}
__device__ __forceinline__ f32x4 mfma16(bf16x8 a, bf16x8 b, f32x4 c) {
  return __builtin_amdgcn_mfma_f32_16x16x32_bf16(a, b, c, 0, 0, 0);
}
__device__ __forceinline__ float sigmoidf_(float x) { return __builtin_amdgcn_rcpf(1.f + __expf(-x)); }

template <class Epi>
__device__ __forceinline__ void gemm_tile(const u16* __restrict__ A, int lda, const u16* __restrict__ Bt, int ldb, int K,
                                          char* smem, Epi epi) {
  const int tid = threadIdx.x, wid = tid >> 6, lane = tid & 63, wr = wid >> 1, wc = wid & 1, fr = lane & 15,
            fq = lane >> 4;
  f32x4 acc[4][4];
#pragma unroll
  for (int m = 0; m < 4; ++m)
#pragma unroll
    for (int n = 0; n < 4; ++n) acc[m][n] = f32x4{0.f, 0.f, 0.f, 0.f};
  const int nk = K / 64;
  auto stage = [&](int buf, int kt) {
    char* SA = smem + buf * 32768;
    char* SB = SA + 16384;
#pragma unroll
    for (int i = 0; i < 4; ++i) {
      int b = tid * 16 + i * 4096, r = b >> 7, pc = (b >> 4) & 7;
      int c = kt * 64 + ((pc ^ ((r >> 1) & 7)) << 3);
      __builtin_amdgcn_global_load_lds((const unsigned*)(A + (size_t)r * lda + c),
                                       (__attribute__((address_space(3))) unsigned*)(SA + b), 16, 0, 0);
      __builtin_amdgcn_global_load_lds((const unsigned*)(Bt + (size_t)r * ldb + c),
                                       (__attribute__((address_space(3))) unsigned*)(SB + b), 16, 0, 0);
    }
  };
  stage(0, 0);
  asm volatile("s_waitcnt vmcnt(0)" ::: "memory");
  __syncthreads();
  for (int kt = 0; kt < nk; ++kt) {
    const int cur = kt & 1;
    if (kt + 1 < nk) stage(cur ^ 1, kt + 1);
    const char* SA = smem + cur * 32768;
    const char* SB = SA + 16384;
#pragma unroll
    for (int ks = 0; ks < 2; ++ks) {
      bf16x8 At[4], Bl[4];
#pragma unroll
      for (int m = 0; m < 4; ++m) {
        int r = wr * 64 + m * 16 + fr;
        At[m] = *(const bf16x8*)(SA + r * 128 + (((ks * 4 + fq) ^ ((r >> 1) & 7)) << 4));
      }
#pragma unroll
      for (int n = 0; n < 4; ++n) {
        int r = wc * 64 + n * 16 + fr;
        Bl[n] = *(const bf16x8*)(SB + r * 128 + (((ks * 4 + fq) ^ ((r >> 1) & 7)) << 4));
      }
      __builtin_amdgcn_s_setprio(1);
#pragma unroll
      for (int m = 0; m < 4; ++m)
#pragma unroll
        for (int n = 0; n < 4; ++n) acc[m][n] = mfma16(Bl[n], At[m], acc[m][n]);
      __builtin_amdgcn_s_setprio(0);
    }
    asm volatile("s_waitcnt vmcnt(0)" ::: "memory");
    __syncthreads();
  }
#pragma unroll
  for (int m = 0; m < 4; ++m)
#pragma unroll
    for (int n = 0; n < 4; ++n) epi(m, wr * 64 + m * 16 + fr, wc * 64 + n * 16 + fq * 4, acc[m][n]);
}

template <class Epi>
__device__ __forceinline__ void gemm_qtile(const u16* __restrict__ A, int lda, const u16* __restrict__ Bt, int ldb, int K,
                                           char* smem, Epi epi) {
  const int tid = threadIdx.x, wid = tid >> 6, lane = tid & 63, fr = lane & 15, fq = lane >> 4;
  f32x4 acc[2][2];
#pragma unroll
  for (int m = 0; m < 2; ++m)
#pragma unroll
    for (int n = 0; n < 2; ++n) acc[m][n] = f32x4{0.f, 0.f, 0.f, 0.f};
  const int nk = K / 64;
  auto stage = [&](int buf, int kt) {
    char* SA = smem + buf * 32768;
    char* SB = SA + 16384;
    {
      int b = tid * 16, r = b >> 7, pc = (b >> 4) & 7;
      int c = kt * 64 + ((pc ^ ((r >> 1) & 7)) << 3);
      __builtin_amdgcn_global_load_lds((const unsigned*)(A + (size_t)r * lda + c),
                                       (__attribute__((address_space(3))) unsigned*)(SA + b), 16, 0, 0);
    }
#pragma unroll
    for (int i = 0; i < 4; ++i) {
      int b = tid * 16 + i * 4096, r = b >> 7, pc = (b >> 4) & 7;
      int c = kt * 64 + ((pc ^ ((r >> 1) & 7)) << 3);
      __builtin_amdgcn_global_load_lds((const unsigned*)(Bt + (size_t)r * ldb + c),
                                       (__attribute__((address_space(3))) unsigned*)(SB + b), 16, 0, 0);
    }
  };
  stage(0, 0);
  asm volatile("s_waitcnt vmcnt(0)" ::: "memory");
  __syncthreads();
  for (int kt = 0; kt < nk; ++kt) {
    const int cur = kt & 1;
    if (kt + 1 < nk) stage(cur ^ 1, kt + 1);
    const char* SA = smem + cur * 32768;
    const char* SB = SA + 16384;
#pragma unroll
    for (int ks = 0; ks < 2; ++ks) {
      bf16x8 At[2], Bl[2];
#pragma unroll
      for (int m = 0; m < 2; ++m) {
        int r = m * 16 + fr;
        At[m] = *(const bf16x8*)(SA + r * 128 + (((ks * 4 + fq) ^ ((r >> 1) & 7)) << 4));
      }
#pragma unroll
      for (int n = 0; n < 2; ++n) {
        int r = wid * 32 + n * 16 + fr;
        Bl[n] = *(const bf16x8*)(SB + r * 128 + (((ks * 4 + fq) ^ ((r >> 1) & 7)) << 4));
      }
#pragma unroll
      for (int m = 0; m < 2; ++m)
#pragma unroll
        for (int n = 0; n < 2; ++n) acc[m][n] = mfma16(Bl[n], At[m], acc[m][n]);
    }
    asm volatile("s_waitcnt vmcnt(0)" ::: "memory");
    __syncthreads();
  }
#pragma unroll
  for (int m = 0; m < 2; ++m)
#pragma unroll
    for (int n = 0; n < 2; ++n) epi(m, m * 16 + fr, wid * 32 + n * 16 + fq * 4, acc[m][n]);
}

__device__ __forceinline__ int xcd_vid() { return (blockIdx.x & 7) * (gridDim.x >> 3) + (blockIdx.x >> 3); }
__device__ __forceinline__ void grouped_tile(int t, int MT, int NT, int& mt, int& nt) {
  const int GM = 8;
  int per = GM * NT, gid = t / per, rem = t - gid * per;
  int first = gid * GM, gsz = min(MT - first, GM);
  mt = first + rem % gsz;
  nt = rem / gsz;
}

__device__ void transpose_task(const float* __restrict__ src, int K, int N, u16* __restrict__ dst, int tile, char* smem,
                               const float* __restrict__ kscale = nullptr) {
  const int tid = threadIdx.x;
  int tn = N / 64;
  int k0 = (tile / tn) * 64, n0 = (tile % tn) * 64;
  float* t = (float*)smem;
#pragma unroll 4
  for (int it = 0; it < 16; ++it) {
    int k = it * 4 + (tid >> 6), n = tid & 63;
    t[n * 65 + k] = src[(size_t)(k0 + k) * N + n0 + n] * (kscale ? kscale[k0 + k] : 1.f);
  }
  __syncthreads();
#pragma unroll 4
  for (int it = 0; it < 16; ++it) {
    int n = it * 4 + (tid >> 6), k = tid & 63;
    dst[(size_t)(n0 + n) * K + k0 + k] = f2bf(t[n * 65 + k]);
  }
  __syncthreads();
}

__device__ void norm1_task(const Params& p, int task) {
  const int wave = threadIdx.x >> 6, lane = threadIdx.x & 63;
  int row = task * 4 + wave;
  u16* h = (u16*)(p.ws + WS_B) + (size_t)row * D;
  const float* src = nullptr;
  bool donorm = true;
  float* shout = nullptr;
  if (row < TP) {
    int b = row / LP, t = row % LP;
    src = (t < 16) ? p.meta + (size_t)t * D : p.x_prompt + ((size_t)b * 4096 + (t - 16)) * D;
    if (t == LP - 1) shout = p.out + O_SHP + (size_t)b * D;
  } else if (row < TTOK) {
    int r = row - TP;
    src = p.x_sample + (size_t)r * D;
    if ((r & 3) == 3) shout = p.out + O_SHS + (size_t)(r >> 2) * D;
  } else if (row < TTOK + SB) {
    src = p.state_shift + (size_t)(row - TTOK) * D;
    donorm = false;
  }
  if (!src) {
#pragma unroll
    for (int i = 0; i < 4; ++i) *(uint2*)(h + (i * 64 + lane) * 4) = uint2{0u, 0u};
    return;
  }
  float4 v[4];
  float ss = 0.f;
#pragma unroll
  for (int i = 0; i < 4; ++i) {
    v[i] = ((const float4*)src)[i * 64 + lane];
    ss += v[i].x * v[i].x + v[i].y * v[i].y + v[i].z * v[i].z + v[i].w * v[i].w;
  }
  float sc = 1.f;
  if (donorm) {
    ss = wave_sum(ss);
    sc = rsqrtf(ss * (1.f / 1024.f) + 1e-5f);
  }
#pragma unroll
  for (int i = 0; i < 4; ++i) {
    float4 y = v[i];
    if (donorm) {
      float4 g = ((const float4*)p.norm1_g)[i * 64 + lane];
      y.x *= sc * g.x; y.y *= sc * g.y; y.z *= sc * g.z; y.w *= sc * g.w;
    }
    *(uint2*)(h + (i * 64 + lane) * 4) = uint2{pack2bf(y.x, y.y), pack2bf(y.z, y.w)};
    if (shout) ((float4*)shout)[i * 64 + lane] = y;
  }
}

__device__ void phase0(const Params& p, char* smem) {
  constexpr int N_NORM = MROWS / 4;
  constexpr int T_WIN = 16 * 40, T_WOUT = 16 * 16, T_WQ = 16 * 32, T_W2W = 8, T_W2A = 8, T_W2G = 16, T_SUBK = 32;
  constexpr int TOT = N_NORM + T_WIN + T_W2W + T_W2A + T_W2G + T_SUBK;
  for (int task = blockIdx.x; task < TOT; task += gridDim.x) {
    int t = task;
    if (t < N_NORM) { norm1_task(p, t); continue; }
    t -= N_NORM;
    if (t < T_WIN) { transpose_task(p.w_in, 1024, 2560, (u16*)(p.ws + WS_WIN), t, smem); continue; }
    t -= T_WIN;
    if (t < T_W2W) { transpose_task(p.w2w, 64, 512, (u16*)(p.ws + WS_W2W), t, smem); continue; }
    t -= T_W2W;
    if (t < T_W2A) { transpose_task(p.w2a, 64, 512, (u16*)(p.ws + WS_W2A), t, smem); continue; }
    t -= T_W2A;
    if (t < T_W2G) { transpose_task(p.w2g, 128, 512, (u16*)(p.ws + WS_W2G), t, smem); continue; }
    t -= T_W2G;
    {
      int e = (t * 256 + threadIdx.x) * 4;
      float4 v = *(const float4*)(p.sub_keys + e);
      *(uint2*)((u16*)(p.ws + WS_SUBK) + e) = uint2{pack2bf(v.x, v.y), pack2bf(v.z, v.w)};
    }
  }
}

__device__ void phase1(const Params& p, char* smem) {
  const u16* hbuf = (const u16*)(p.ws + WS_B);
  const u16* wt = (const u16*)(p.ws + WS_WIN);
  u16* proj = (u16*)(p.ws + WS_C);
  constexpr int NT = 20, MT = MROWS / 128, TOT = MT * NT;
  const int G = gridDim.x, full = p.full1, ntask = full + 4 * (TOT - full);
  for (int task = xcd_vid(); task < ntask; task += G) {
    int mt, nt;
    if (task < full) {
      grouped_tile(task, MT, NT, mt, nt);
      u16* crow = proj + (size_t)mt * 128 * NIN + nt * 128;
      gemm_tile(hbuf + (size_t)mt * 128 * D, D, wt + (size_t)nt * 128 * D, D, D, smem,
                [&](int m, int r, int c, f32x4 v) { *(uint2*)(crow + (size_t)r * NIN + c) = uint2{pack2bf(v[0], v[1]), pack2bf(v[2], v[3])}; });
    } else {
      int rem = task - full, qd = rem & 3;
      grouped_tile(full + (rem >> 2), MT, NT, mt, nt);
      size_t r0 = (size_t)mt * 128 + qd * 32;
      u16* crow = proj + r0 * NIN + nt * 128;
      gemm_qtile(hbuf + r0 * D, D, wt + (size_t)nt * 128 * D, D, D, smem,
                 [&](int m, int r, int c, f32x4 v) { *(uint2*)(crow + (size_t)r * NIN + c) = uint2{pack2bf(v[0], v[1]), pack2bf(v[2], v[3])}; });
    }
  }
}

__device__ void prepass_task(const Params& p, int task) {
  const int wave = threadIdx.x >> 6, lane = threadIdx.x & 63;
  int row = task * 4 + wave;
  if (row >= TTOK) return;
  u16* proj = (u16*)(p.ws + WS_C);
  u16* act = (u16*)(p.ws + WS_E);
  bool isP = row < TP;
  int b, t, prow;
  float pos;
  if (isP) { b = row / LP; t = row % LP; prow = t > 0 ? row - 1 : -1; pos = (float)t; }
  else { int r = row - TP; b = r >> 2; t = r & 3; prow = t > 0 ? row - 1 : PREV0 + b; pos = (float)(PAST + t); }
  u16* pr = proj + (size_t)row * NIN;
  const u16* pp = prow >= 0 ? proj + (size_t)prow * NIN : nullptr;
  {
    int c = 1536 + lane * 4;
    uint2 a = *(const uint2*)(pr + c);
    uint2 bq = pp ? *(const uint2*)(pp + c) : uint2{0u, 0u};
    float4 mu = *(const float4*)(p.mu + c);
    float x[4] = {bflo(a.x), bfhi(a.x), bflo(a.y), bfhi(a.y)};
    float xp[4] = {bflo(bq.x), bfhi(bq.x), bflo(bq.y), bfhi(bq.y)};
    float mm[4] = {mu.x, mu.y, mu.z, mu.w};
    float o[4];
#pragma unroll
    for (int i = 0; i < 4; ++i) {
      float m = x[i] + (xp[i] - x[i]) * mm[i];
      float r;
      if (lane < 16) r = tanhf(m);
      else if (lane < 32) r = m;
      else r = sigmoidf_(m);
      o[i] = r;
    }
    *(uint2*)(act + (size_t)row * 256 + lane * 4) = uint2{pack2bf(o[0], o[1]), pack2bf(o[2], o[3])};
  }
  float* kwin = nullptr;
  float* vwin = nullptr;
  if (isP) {
    if (t >= LP - 128) {
      kwin = p.out + O_KWP + ((size_t)b * 128 + (t - (LP - 128))) * 128;
      vwin = p.out + O_VWP + ((size_t)b * 128 + (t - (LP - 128))) * 128;
    }
  } else {
    kwin = p.out + O_KWS + ((size_t)b * 128 + 124 + t) * 128;
    vwin = p.out + O_VWS + ((size_t)b * 128 + 124 + t) * 128;
  }
  for (int it = lane; it < 80; it += 64) {
    int hh = it >> 3, d = it & 7;
    int col = 1792 + hh * 64 + d;
    float x1 = bf2f(pr[col]), x2 = bf2f(pr[col + 8]);
    double rev = (double)pos * INVF[d] * 0.15915494309189535;
    float fr = (float)(rev - floor(rev));
    float sn = __builtin_amdgcn_sinf(fr), cs = __builtin_amdgcn_cosf(fr);
    float r1 = x1 * cs - x2 * sn, r2 = x2 * cs + x1 * sn;
    pr[col] = f2bf(r1);
    pr[col + 8] = f2bf(r2);
    if (hh >= 8 && kwin) {
      kwin[(hh - 8) * 64 + d] = r1;
      kwin[(hh - 8) * 64 + d + 8] = r2;
    }
  }
  if (kwin) {
#pragma unroll
    for (int i = 0; i < 2; ++i) {
      int idx = lane * 2 + i;
      if ((idx & 63) >= 16) kwin[idx] = bf2f(pr[2304 + idx]);
      vwin[idx] = bf2f(pr[2432 + idx]);
    }
  }
}

__device__ void phase2(const Params& p) {
  constexpr int N_PRE = TTOK / 4;
  constexpr int N_CP = 256;
  for (int task = blockIdx.x; task < N_PRE + N_CP; task += gridDim.x) {
    if (task < N_PRE) { prepass_task(p, task); continue; }
    int t = task - N_PRE;
    int which = t >> 7, b = t & 127;
    const float4* src = (const float4*)((which ? p.cache_v : p.cache_k) + (size_t)b * 16384 + 512);
    float4* dst = (float4*)(p.out + (which ? O_VWS : O_KWS) + (size_t)b * 16384);
    for (int i = threadIdx.x; i < 3968; i += 256) dst[i] = src[i];
  }
}

__device__ void phase3(const Params& p, char* smem) {
  const u16* act = (const u16*)(p.ws + WS_E);
  float* dec = (float*)(p.ws + WS_DEC);
  u16* ab = (u16*)(p.ws + WS_A);
  u16* gb = (u16*)(p.ws + WS_G);
  constexpr int MT = TPAD / 128;
  for (int tile = blockIdx.x; tile < MT * 12; tile += gridDim.x) {
    int which = tile % 3, rest = tile / 3;
    int nt = rest & 3, mt = rest >> 2;
    size_t r0 = (size_t)mt * 128;
    int c0 = nt * 128;
    if (which == 0) {
      gemm_tile(act + r0 * 256, 256, (const u16*)(p.ws + WS_W2W) + (size_t)c0 * 64, 64, 64, smem,
                [&](int m, int r, int c, f32x4 v) {
                  float4 w0v = *(const float4*)(p.w0 + c0 + c);
                  float w0a[4] = {w0v.x, w0v.y, w0v.z, w0v.w};
                  float o[4];
#pragma unroll
                  for (int e = 0; e < 4; ++e) {
                    float nx = -(w0a[e] + v[e]);
                    float sp = fmaxf(nx, 0.f) + __logf(1.f + __expf(-fabsf(nx)));
                    o[e] = __expf(-__expf(-sp - 0.5f));
                  }
                  *(float4*)(dec + (r0 + r) * 512 + c0 + c) = float4{o[0], o[1], o[2], o[3]};
                });
    } else if (which == 1) {
      gemm_tile(act + r0 * 256 + 64, 256, (const u16*)(p.ws + WS_W2A) + (size_t)c0 * 64, 64, 64, smem,
                [&](int m, int r, int c, f32x4 v) {
                  float4 a0v = *(const float4*)(p.a0 + c0 + c);
                  *(uint2*)(ab + (r0 + r) * 512 + c0 + c) = uint2{pack2bf(sigmoidf_(a0v.x + v[0]), sigmoidf_(a0v.y + v[1])), pack2bf(sigmoidf_(a0v.z + v[2]), sigmoidf_(a0v.w + v[3]))};
                });
    } else {
      gemm_tile(act + r0 * 256 + 128, 256, (const u16*)(p.ws + WS_W2G) + (size_t)c0 * 128, 128, 128, smem,
                [&](int m, int r, int c, f32x4 v) { *(uint2*)(gb + (r0 + r) * 512 + c0 + c) = uint2{pack2bf(v[0], v[1]), pack2bf(v[2], v[3])}; });
    }
  }
}

__device__ void convert_task(const Params& p, int task) {
  const int wave = threadIdx.x >> 6, lane = threadIdx.x & 63;
  int r = task * 4 + wave;
  const float* src = (r < 16384 ? p.eu + (size_t)r * 1024 : p.ev + (size_t)(r - 16384) * 1024) + lane * 16;
  float4 x[4];
  float am = 0.f;
#pragma unroll
  for (int i = 0; i < 4; ++i) {
    x[i] = ((const float4*)src)[i];
    am = fmaxf(am, fmaxf(fmaxf(fabsf(x[i].x), fabsf(x[i].y)), fmaxf(fabsf(x[i].z), fabsf(x[i].w))));
  }
  am = redmax16(am);
  am = fmaxf(fmaxf(rdlane(am, 0), rdlane(am, 16)), fmaxf(rdlane(am, 32), rdlane(am, 48)));
  float scale = am > 0.f ? 7.f / am : 1.f;
  float inv = am > 0.f ? am * (1.f / 7.f) : 1.f;
  float y[16];
#pragma unroll
  for (int i = 0; i < 4; ++i) {
    y[4 * i] = fminf(fmaxf(x[i].x * scale, -6.f), 6.f); y[4 * i + 1] = fminf(fmaxf(x[i].y * scale, -6.f), 6.f);
    y[4 * i + 2] = fminf(fmaxf(x[i].z * scale, -6.f), 6.f); y[4 * i + 3] = fminf(fmaxf(x[i].w * scale, -6.f), 6.f);
  }
  unsigned w0 = 0u, w1 = 0u;
  w0 = __builtin_amdgcn_cvt_scalef32_pk_fp4_f32(w0, y[0], y[1], 1.0f, 0);
  w0 = __builtin_amdgcn_cvt_scalef32_pk_fp4_f32(w0, y[2], y[3], 1.0f, 1);
  w0 = __builtin_amdgcn_cvt_scalef32_pk_fp4_f32(w0, y[4], y[5], 1.0f, 2);
  w0 = __builtin_amdgcn_cvt_scalef32_pk_fp4_f32(w0, y[6], y[7], 1.0f, 3);
  w1 = __builtin_amdgcn_cvt_scalef32_pk_fp4_f32(w1, y[8], y[9], 1.0f, 0);
  w1 = __builtin_amdgcn_cvt_scalef32_pk_fp4_f32(w1, y[10], y[11], 1.0f, 1);
  w1 = __builtin_amdgcn_cvt_scalef32_pk_fp4_f32(w1, y[12], y[13], 1.0f, 2);
  w1 = __builtin_amdgcn_cvt_scalef32_pk_fp4_f32(w1, y[14], y[15], 1.0f, 3);
  *(uint2*)((unsigned char*)(p.ws + WS_EU) + (size_t)r * 512 + lane * 8) = uint2{w0, w1};
  if (lane == 0) ((float*)(p.ws + WS_SCU))[r] = inv;
}

struct ScanRaw {
  uint2 rr, rk, rv, qr, qk, qv, av;
  float4 dc;
};
constexpr int SC_TOK = 332;

__device__ void scan_task(const Params& p, char* smem, int rowbase, int T, int prevrow, int h, int rg,
                          const float* __restrict__ s_in, float* __restrict__ s_out) {
  const int tid = threadIdx.x, wave = tid >> 6, lane = tid & 63, l16 = lane & 15;
  const bool scanner = wave < 2;
  const u16* proj = (const u16*)(p.ws + WS_C);
  const float* dec = (const float*)(p.ws + WS_DEC);
  const u16* ab = (const u16*)(p.ws + WS_A);
  float* yraw = p.out;
  float* bufs = (float*)smem;
  float* yparts = (float*)(smem + 42496);
  float* vkrs = (float*)(smem + 42496 + 16384);
  const int nchunk = (T + 15) >> 4;
  const int il = (wave & 1) * 4 + (lane >> 4), i = rg * 8 + il, j0 = l16 * 4;
  float2v S01 = {0.f, 0.f}, S23 = {0.f, 0.f};
  if (s_in && scanner) {
    float4 s = *(const float4*)(s_in + i * 64 + j0);
    S01 = float2v{s.x, s.y}; S23 = float2v{s.z, s.w};
  }
  const int ptid = tid & 127, cgp = ptid & 15, ttb = ptid >> 4, col = h * 64 + cgp * 4;
  const float4 mu_r = *(const float4*)(p.mu + col), mu_k = *(const float4*)(p.mu + 512 + col),
               mu_v = *(const float4*)(p.mu + 1024 + col);
  const float4 kkw = *(const float4*)(p.k_k + col), kaw = *(const float4*)(p.k_a + col);
  const u16* projc = proj + (size_t)rowbase * NIN + col;
  const float* decc = dec + (size_t)rowbase * 512 + col;
  const u16* abc = ab + (size_t)rowbase * 512 + col;
  const u16* prevp = prevrow >= 0 ? proj + (size_t)prevrow * NIN + col : nullptr;
  auto issue = [&](int c, int tt, ScanRaw& R) {
    int t = c * 16 + tt;
    if (t < T) {
      const size_t ro = (size_t)c * 16 + tt;
      const u16* pr = projc + ro * NIN;
      R.rr = *(const uint2*)(pr);
      R.rk = *(const uint2*)(pr + 512);
      R.rv = *(const uint2*)(pr + 1024);
      const u16* pq = t > 0 ? pr - NIN : prevp;
      if (pq) {
        R.qr = *(const uint2*)(pq);
        R.qk = *(const uint2*)(pq + 512);
        R.qv = *(const uint2*)(pq + 1024);
      } else {
        R.qr = uint2{0, 0}; R.qk = uint2{0, 0}; R.qv = uint2{0, 0};
      }
      R.dc = *(const float4*)(decc + ro * 512);
      R.av = *(const uint2*)(abc + ro * 512);
    }
  };
  auto prep_item = [&](const ScanRaw& R, int tt, float* buf, float* vkr) {
    float xr[4] = {bflo(R.rr.x), bfhi(R.rr.x), bflo(R.rr.y), bfhi(R.rr.y)};
    float xk[4] = {bflo(R.rk.x), bfhi(R.rk.x), bflo(R.rk.y), bfhi(R.rk.y)};
    float xv[4] = {bflo(R.rv.x), bfhi(R.rv.x), bflo(R.rv.y), bfhi(R.rv.y)};
    float pr_[4] = {bflo(R.qr.x), bfhi(R.qr.x), bflo(R.qr.y), bfhi(R.qr.y)};
    float pk_[4] = {bflo(R.qk.x), bfhi(R.qk.x), bflo(R.qk.y), bfhi(R.qk.y)};
    float pv_[4] = {bflo(R.qv.x), bfhi(R.qv.x), bflo(R.qv.y), bfhi(R.qv.y)};
    float aa[4] = {bflo(R.av.x), bfhi(R.av.x), bflo(R.av.y), bfhi(R.av.y)};
    float dcv[4] = {R.dc.x, R.dc.y, R.dc.z, R.dc.w};
    float mur[4] = {mu_r.x, mu_r.y, mu_r.z, mu_r.w}, muk[4] = {mu_k.x, mu_k.y, mu_k.z, mu_k.w},
          muv[4] = {mu_v.x, mu_v.y, mu_v.z, mu_v.w};
    float kw[4] = {kkw.x, kkw.y, kkw.z, kkw.w}, ka[4] = {kaw.x, kaw.y, kaw.z, kaw.w};
    float kkv[4], ss = 0.f;
#pragma unroll
    for (int e = 0; e < 4; ++e) {
      xr[e] = xr[e] + (pr_[e] - xr[e]) * mur[e];
      xk[e] = xk[e] + (pk_[e] - xk[e]) * muk[e];
      xv[e] = xv[e] + (pv_[e] - xv[e]) * muv[e];
      kkv[e] = xk[e] * kw[e];
      ss += kkv[e] * kkv[e];
    }
    ss = red16(ss);
    float inv = __builtin_amdgcn_rsqf(fmaxf(ss, 1e-24f));
    float nk[4], kb[4], km[4];
    float brs = 0.f, krs = 0.f;
#pragma unroll
    for (int e = 0; e < 4; ++e) {
      float kk = kkv[e] * inv;
      nk[e] = -kk;
      kb[e] = kk * aa[e];
      km[e] = xk[e] * (1.f + (aa[e] - 1.f) * ka[e]);
      brs += kb[e] * xr[e];
      krs += km[e] * xr[e];
    }
    brs = red16(brs);
    krs = red16(krs);
    float* bt = buf + tt * SC_TOK + cgp * 4;
    *(float4*)(bt) = float4{xr[0] * dcv[0] + brs * nk[0], xr[1] * dcv[1] + brs * nk[1], xr[2] * dcv[2] + brs * nk[2],
                            xr[3] * dcv[3] + brs * nk[3]};
    *(float4*)(bt + 64) = R.dc;
    *(float4*)(bt + 128) = float4{km[0], km[1], km[2], km[3]};
    *(float4*)(bt + 192) = float4{nk[0], nk[1], nk[2], nk[3]};
    *(float4*)(bt + 256) = float4{kb[0], kb[1], kb[2], kb[3]};
    if ((cgp >> 1) == rg) {
      *(float4*)(buf + tt * SC_TOK + 320 + (cgp & 1) * 4) = float4{xv[0], xv[1], xv[2], xv[3]};
      *(float4*)(vkr + tt * 8 + (cgp & 1) * 4) = float4{xv[0] * krs, xv[1] * krs, xv[2] * krs, xv[3] * krs};
    }
  };
  auto yreduce = [&](int c) {
    const int tt = ptid >> 3, row = ptid & 7;
    const float4* yp = (const float4*)(yparts + (c & 1) * 2048 + ptid * 16);
    float4 a = yp[0], b = yp[1], c4 = yp[2], d = yp[3];
    float y = ((a.x + a.y) + (a.z + a.w)) + ((b.x + b.y) + (b.z + b.w)) + ((c4.x + c4.y) + (c4.z + c4.w)) +
              ((d.x + d.y) + (d.z + d.w)) + vkrs[(c % 3) * 128 + ptid];
    int t = c * 16 + tt;
    if (t < T) yraw[(size_t)(rowbase + t) * 512 + h * 64 + rg * 8 + row] = y;
  };
  ScanRaw R0, R1;
  R0.rr = R0.rk = R0.rv = R0.qr = R0.qk = R0.qv = R0.av = uint2{0, 0}; R0.dc = float4{0, 0, 0, 0};
  R1 = R0;
  if (!scanner) {
    issue(0, ttb, R0);
    issue(0, ttb + 8, R1);
    prep_item(R0, ttb, bufs, vkrs);
    prep_item(R1, ttb + 8, bufs, vkrs);
    if (nchunk > 1) { issue(1, ttb, R0); issue(1, ttb + 8, R1); }
  }
  __syncthreads();
  for (int c = 0; c < nchunk; ++c) {
    if (scanner) {
      const float* buf = bufs + (c & 1) * (16 * SC_TOK);
      float* ypart = yparts + (c & 1) * 2048;
      const int ntok = min(16, T - c * 16);
      const float* bt0 = buf + j0;
      float4 r4 = *(const float4*)(bt0), w4 = *(const float4*)(bt0 + 64), k4 = *(const float4*)(bt0 + 128),
             a4 = *(const float4*)(bt0 + 192), b4 = *(const float4*)(bt0 + 256);
      float vi = buf[320 + il];
      for (int t2 = 0; t2 < ntok; ++t2) {
        int tn = min(t2 + 1, ntok - 1);
        const float* bn = buf + tn * SC_TOK + j0;
        float4 rn = *(const float4*)(bn), wn = *(const float4*)(bn + 64), kn = *(const float4*)(bn + 128),
               an = *(const float4*)(bn + 192), bnn = *(const float4*)(bn + 256);
        float vn = buf[tn * SC_TOK + 320 + il];
        float2v sa2 = S01 * float2v{a4.x, a4.y} + S23 * float2v{a4.z, a4.w};
        float2v q2 = S01 * float2v{r4.x, r4.y} + S23 * float2v{r4.z, r4.w};
        float2v vv = float2v{vi, vi};
        float2v t01 = S01 * float2v{w4.x, w4.y} + vv * float2v{k4.x, k4.y};
        float2v t23 = S23 * float2v{w4.z, w4.w} + vv * float2v{k4.z, k4.w};
        float sa = red16(sa2.x + sa2.y);
        float2v sv = float2v{sa, sa};
        S01 = t01 + sv * float2v{b4.x, b4.y};
        S23 = t23 + sv * float2v{b4.z, b4.w};
        ypart[t2 * 128 + (tid & 127)] = q2.x + q2.y;
        r4 = rn; w4 = wn; k4 = kn; a4 = an; b4 = bnn; vi = vn;
      }
    } else {
      if (c > 0) yreduce(c - 1);
      if (c + 1 < nchunk) {
        float* nb = bufs + ((c + 1) & 1) * (16 * SC_TOK);
        float* nv = vkrs + ((c + 1) % 3) * 128;
        prep_item(R0, ttb, nb, nv);
        prep_item(R1, ttb + 8, nb, nv);
        if (c + 2 < nchunk) { issue(c + 2, ttb, R0); issue(c + 2, ttb + 8, R1); }
      }
    }
    __syncthreads();
  }
  if (scanner) *(float4*)(s_out + i * 64 + j0) = float4{S01.x, S01.y, S23.x, S23.y};
  else yreduce(nchunk - 1);
  __syncthreads();
}

__device__ void attn_prompt_task(const Params& p, char* smem, int task) {
  const int tid = threadIdx.x, w = tid >> 6, lane = tid & 63, fr = lane & 15, fq = lane >> 4;
  int head = task & 7;
  int qt = (task >> 3) % 65;
  int b = task / (8 * 65);
  int kvh = head >> 2;
  u16* KV = (u16*)smem;
  u16* Ps = (u16*)(smem + 9216) + w * 16 * 200;
  const u16* projb = (const u16*)(p.ws + WS_C) + (size_t)b * LP * NIN;
  u16* mix = (u16*)(p.ws + WS_B);
  int q0 = qt * 64, kstart = q0 - 128;
  int qrow = min(q0 + w * 16 + fr, LP - 1);
  bf16x8 qa[2];
#pragma unroll
  for (int ks = 0; ks < 2; ++ks)
    qa[ks] = *(const bf16x8*)(projb + (size_t)qrow * NIN + 1792 + head * 64 + ks * 32 + fq * 8);
  f32x4 S[12];
#pragma unroll
  for (int i = 0; i < 12; ++i) S[i] = f32x4{0.f, 0.f, 0.f, 0.f};
#pragma unroll
  for (int kt = 0; kt < 3; ++kt) {
    {
      int key = tid >> 2, ch = tid & 3;
      int kp = min(max(kstart + kt * 64 + key, 0), LP - 1);
      const uint4* src = (const uint4*)(projb + (size_t)kp * NIN + 2304 + kvh * 64 + ch * 16);
      uint4 v0 = src[0], v1 = src[1];
      *(uint4*)(KV + key * 72 + ch * 16) = v0;
      *(uint4*)(KV + key * 72 + ch * 16 + 8) = v1;
    }
    __syncthreads();
#pragma unroll
    for (int n = 0; n < 4; ++n)
#pragma unroll
      for (int ks = 0; ks < 2; ++ks) {
        bf16x8 kb = *(const bf16x8*)(KV + (n * 16 + fr) * 72 + ks * 32 + fq * 8);
        S[kt * 4 + n] = mfma16(qa[ks], kb, S[kt * 4 + n]);
      }
    __syncthreads();
  }
  float sink = p.sinks[head];
#pragma unroll
  for (int j = 0; j < 4; ++j) {
    int qpos = q0 + w * 16 + fq * 4 + j;
    float mx = -1e30f;
#pragma unroll
    for (int T = 0; T < 12; ++T) {
      int kpos = kstart + T * 16 + fr;
      bool valid = (kpos >= 0) && (kpos <= qpos) && (qpos - kpos < 128);
      float s = valid ? S[T][j] * 0.125f : -1e30f;
      S[T][j] = s;
      mx = fmaxf(mx, s);
    }
    mx = redmax16(mx);
    mx = fmaxf(mx, sink);
    float sum = 0.f;
#pragma unroll
    for (int T = 0; T < 12; ++T) {
      float e = (S[T][j] > -1e29f) ? __expf(S[T][j] - mx) : 0.f;
      S[T][j] = e;
      sum += e;
    }
    sum = red16(sum) + __expf(sink - mx);
    float inv = 1.f / sum;
#pragma unroll
    for (int T = 0; T < 12; ++T) Ps[(fq * 4 + j) * 200 + T * 16 + fr] = f2bf(S[T][j] * inv);
  }
  f32x4 O[4];
#pragma unroll
  for (int i = 0; i < 4; ++i) O[i] = f32x4{0.f, 0.f, 0.f, 0.f};
#pragma unroll
  for (int kt = 0; kt < 3; ++kt) {
    {
      int key = tid >> 2, ch = tid & 3;
      int kp = min(max(kstart + kt * 64 + key, 0), LP - 1);
      const uint4* src = (const uint4*)(projb + (size_t)kp * NIN + 2432 + kvh * 64 + ch * 16);
      uint4 v0 = src[0], v1 = src[1];
      unsigned e[8] = {v0.x, v0.y, v0.z, v0.w, v1.x, v1.y, v1.z, v1.w};
#pragma unroll
      for (int i = 0; i < 8; ++i) {
        KV[(ch * 16 + 2 * i) * 72 + key] = (u16)(e[i] & 0xffffu);
        KV[(ch * 16 + 2 * i + 1) * 72 + key] = (u16)(e[i] >> 16);
      }
    }
    __syncthreads();
#pragma unroll
    for (int ks = 0; ks < 2; ++ks) {
      bf16x8 pa = *(const bf16x8*)(Ps + fr * 200 + kt * 64 + ks * 32 + fq * 8);
#pragma unroll
      for (int n = 0; n < 4; ++n) {
        bf16x8 vb = *(const bf16x8*)(KV + (n * 16 + fr) * 72 + ks * 32 + fq * 8);
        O[n] = mfma16(pa, vb, O[n]);
      }
    }
    __syncthreads();
  }
#pragma unroll
  for (int n = 0; n < 4; ++n)
#pragma unroll
    for (int j = 0; j < 4; ++j) {
      int q = q0 + w * 16 + fq * 4 + j;
      if (q < LP) mix[((size_t)(b * LP + q)) * 1024 + 512 + head * 64 + n * 16 + fr] = f2bf(O[n][j]);
    }
}

__device__ void attn_sample_task(const Params& p, char* smem, int task) {
  const int tid = threadIdx.x;
  int b = task >> 1, kvh = task & 1;
  const u16* proj = (const u16*)(p.ws + WS_C);
  u16* mix = (u16*)(p.ws + WS_B);
  float* Qs = (float*)smem;
  float* Sc = Qs + 1024;
  {
    int qr = tid >> 4, d4 = (tid & 15) * 4, g = qr >> 2, s = qr & 3;
    const u16* src = proj + (size_t)(TP + b * 4 + s) * NIN + 1792 + (kvh * 4 + g) * 64 + d4;
    uint2 v = *(const uint2*)src;
    *(float4*)(Qs + qr * 64 + d4) = float4{bflo(v.x) * 0.125f, bfhi(v.x) * 0.125f, bflo(v.y) * 0.125f, bfhi(v.y) * 0.125f};
  }
  __syncthreads();
  for (int idx = tid; idx < 132 * 16; idx += 256) {
    int kj = idx >> 4, qr = idx & 15, s = qr & 3;
    bool valid = (kj < 128) ? (kj > s) : (kj - 128 <= s);
    float acc = 0.f;
    const float* q = Qs + qr * 64;
    if (kj < 128) {
      const float4* kr = (const float4*)(p.cache_k + (((size_t)b * 128 + kj) * 2 + kvh) * 64);
#pragma unroll
      for (int d = 0; d < 16; ++d) {
        float4 kv = kr[d];
        acc += kv.x * q[d * 4] + kv.y * q[d * 4 + 1] + kv.z * q[d * 4 + 2] + kv.w * q[d * 4 + 3];
      }
    } else {
      const uint2* kr = (const uint2*)(proj + (size_t)(TP + b * 4 + kj - 128) * NIN + 2304 + kvh * 64);
#pragma unroll
      for (int d = 0; d < 16; ++d) {
        uint2 kv = kr[d];
        acc += bflo(kv.x) * q[d * 4] + bfhi(kv.x) * q[d * 4 + 1] + bflo(kv.y) * q[d * 4 + 2] + bfhi(kv.y) * q[d * 4 + 3];
      }
    }
    Sc[qr * 136 + kj] = valid ? acc : -1e30f;
  }
  __syncthreads();
  {
    int qr = tid >> 4, l = tid & 15, g = qr >> 2;
    float sink = p.sinks[kvh * 4 + g];
    float mx = -1e30f;
    for (int kj = l; kj < 132; kj += 16) mx = fmaxf(mx, Sc[qr * 136 + kj]);
    mx = redmax16(mx);
    mx = fmaxf(mx, sink);
    float sum = 0.f;
    for (int kj = l; kj < 132; kj += 16) {
      float s = Sc[qr * 136 + kj];
      float e = (s > -1e29f) ? __expf(s - mx) : 0.f;
      Sc[qr * 136 + kj] = e;
      sum += e;
    }
    sum = red16(sum) + __expf(sink - mx);
    float inv = 1.f / sum;
    for (int kj = l; kj < 132; kj += 16) Sc[qr * 136 + kj] *= inv;
  }
  __syncthreads();
  {
    int qr = tid >> 4, d4 = (tid & 15) * 4, g = qr >> 2, s = qr & 3;
    float4 o = {0.f, 0.f, 0.f, 0.f};
    for (int kj = 0; kj < 128; ++kj) {
      float pw = Sc[qr * 136 + kj];
      float4 v = *(const float4*)(p.cache_v + (((size_t)b * 128 + kj) * 2 + kvh) * 64 + d4);
      o.x += pw * v.x; o.y += pw * v.y; o.z += pw * v.z; o.w += pw * v.w;
    }
    for (int kj = 128; kj < 132; ++kj) {
      float pw = Sc[qr * 136 + kj];
      uint2 v = *(const uint2*)(proj + (size_t)(TP + b * 4 + kj - 128) * NIN + 2432 + kvh * 64 + d4);
      o.x += pw * bflo(v.x); o.y += pw * bfhi(v.x); o.z += pw * bflo(v.y); o.w += pw * bfhi(v.y);
    }
    *(uint2*)(mix + (size_t)(TP + b * 4 + s) * 1024 + 512 + (kvh * 4 + g) * 64 + d4) =
        uint2{pack2bf(o.x, o.y), pack2bf(o.z, o.w)};
  }
  __syncthreads();
}

__device__ void phase4(const Params& p, char* smem) {
  constexpr int N_PS = 256, N_SS = 8192, N_AP = NB * 65 * 8, N_AS = 256;
  constexpr int N_CV = 32768 / 4, T_WOUT = 16 * 16, T_WQ = 16 * 32;
  int first, stride;
  if (gridDim.x >= 2 * N_PS) {
    if ((int)blockIdx.x < N_PS) {
      int t = blockIdx.x;
      int seq = t >> 3, rg = t & 7, b = seq >> 3, h = seq & 7;
      scan_task(p, smem, b * LP, LP, -1, h, rg, nullptr, p.out + O_WKVP + (size_t)seq * 4096);
      return;
    }
    first = N_PS + (blockIdx.x - N_PS);
    stride = gridDim.x - N_PS;
  } else {
    first = blockIdx.x;
    stride = gridDim.x;
  }
  for (int task = first; task < N_PS + N_SS + N_AP + N_AS + N_CV + T_WOUT + T_WQ; task += stride) {
    int t = task;
    if (t < N_PS) {
      int seq = t >> 3, rg = t & 7, b = seq >> 3, h = seq & 7;
      scan_task(p, smem, b * LP, LP, -1, h, rg, nullptr, p.out + O_WKVP + (size_t)seq * 4096);
      continue;
    }
    t -= N_PS;
    if (t < N_SS) {
      int seq = t >> 3, rg = t & 7, b = seq >> 3, h = seq & 7;
      scan_task(p, smem, TP + b * 4, 4, PREV0 + b, h, rg, p.state_wkv + (size_t)seq * 4096,
                p.out + O_WKVS + (size_t)seq * 4096);
      continue;
    }
    t -= N_SS;
    if (t < N_AP) { attn_prompt_task(p, smem, t); continue; }
    t -= N_AP;
    if (t < N_AS) { attn_sample_task(p, smem, t); continue; }
    t -= N_AS;
    if (t < N_CV) { convert_task(p, t); continue; }
    t -= N_CV;
    if (t < T_WOUT) { transpose_task(p.w_out, 1024, 1024, (u16*)(p.ws + WS_WOUT), t, smem); continue; }
    t -= T_WOUT;
    transpose_task(p.w_query, 1024, 2048, (u16*)(p.ws + WS_WQ), t, smem, p.norm2_g);
  }
}

struct PostC { float mu[3][8], ka[8], rk[8], lw[8], lb[8]; };

__device__ __forceinline__ void post_task(const Params& p, int task, const PostC& C) {
  const int wave = threadIdx.x >> 6, lane = threadIdx.x & 63;
  int row = task * 4 + wave;
  if (row >= TTOK) return;
  const u16* proj = (const u16*)(p.ws + WS_C);
  const float* yraw = p.out;
  const u16* ab = (const u16*)(p.ws + WS_A);
  const u16* gb = (const u16*)(p.ws + WS_G);
  u16* mix = (u16*)(p.ws + WS_B);
  int prow;
  if (row < TP) { int t = row % LP; prow = t > 0 ? row - 1 : -1; }
  else { int r = row - TP; prow = (r & 3) ? row - 1 : PREV0 + (r >> 2); }
  int c0 = lane * 8;
  float y[8];
  {
    float4 a = *(const float4*)(yraw + (size_t)row * 512 + c0), bq = *(const float4*)(yraw + (size_t)row * 512 + c0 + 4);
    y[0] = a.x; y[1] = a.y; y[2] = a.z; y[3] = a.w; y[4] = bq.x; y[5] = bq.y; y[6] = bq.z; y[7] = bq.w;
  }
  float s = 0.f;
#pragma unroll
  for (int e = 0; e < 8; ++e) s += y[e];
  float mean = red8(s) * (1.f / 64.f);
  float vs = 0.f;
#pragma unroll
  for (int e = 0; e < 8; ++e) { float d = y[e] - mean; vs += d * d; }
  float rstd = rsqrtf(red8(vs) * (1.f / 64.f) + 64e-5f);
  float xr[8], xk[8], xv[8];
  auto ld8 = [&](int coff, int mi, float* o) {
    uint4 a = *(const uint4*)(proj + (size_t)row * NIN + coff + c0);
    uint4 q = prow >= 0 ? *(const uint4*)(proj + (size_t)prow * NIN + coff + c0) : uint4{0, 0, 0, 0};
    unsigned ua[4] = {a.x, a.y, a.z, a.w}, uq[4] = {q.x, q.y, q.z, q.w};
#pragma unroll
    for (int e = 0; e < 4; ++e) {
      float x0 = bflo(ua[e]), x1 = bfhi(ua[e]), p0 = bflo(uq[e]), p1 = bfhi(uq[e]);
      float m0 = C.mu[mi][2 * e], m1 = C.mu[mi][2 * e + 1];
      o[2 * e] = x0 + (p0 - x0) * m0;
      o[2 * e + 1] = x1 + (p1 - x1) * m1;
    }
  };
  ld8(0, 0, xr);
  ld8(512, 1, xk);
  ld8(1024, 2, xv);
  float aa[8], gg[8];
  {
    uint4 a = *(const uint4*)(ab + (size_t)row * 512 + c0), g = *(const uint4*)(gb + (size_t)row * 512 + c0);
    unsigned ua[4] = {a.x, a.y, a.z, a.w}, ug[4] = {g.x, g.y, g.z, g.w};
#pragma unroll
    for (int e = 0; e < 4; ++e) {
      aa[2 * e] = bflo(ua[e]); aa[2 * e + 1] = bfhi(ua[e]);
      gg[2 * e] = bflo(ug[e]); gg[2 * e + 1] = bfhi(ug[e]);
    }
  }
  float bs = 0.f;
#pragma unroll
  for (int e = 0; e < 8; ++e) {
    float km = xk[e] * (1.f + (aa[e] - 1.f) * C.ka[e]);
    bs += xr[e] * km * C.rk[e];
  }
  bs = red8(bs);
  unsigned o[4];
#pragma unroll
  for (int e = 0; e < 4; ++e) {
    float v0 = ((y[2 * e] - mean) * rstd * C.lw[2 * e] + C.lb[2 * e] + bs * xv[2 * e]) * gg[2 * e];
    float v1 = ((y[2 * e + 1] - mean) * rstd * C.lw[2 * e + 1] + C.lb[2 * e + 1] + bs * xv[2 * e + 1]) * gg[2 * e + 1];
    o[e] = pack2bf(v0, v1);
  }
  *(uint4*)(mix + (size_t)row * 1024 + c0) = uint4{o[0], o[1], o[2], o[3]};
}

__device__ void phase5(const Params& p) {
  const int lane = threadIdx.x & 63, c0 = lane * 8;
  PostC C;
  auto ld = [&](const float* src, float* dst) {
    float4 a = *(const float4*)(src + c0), b = *(const float4*)(src + c0 + 4);
    dst[0] = a.x; dst[1] = a.y; dst[2] = a.z; dst[3] = a.w; dst[4] = b.x; dst[5] = b.y; dst[6] = b.z; dst[7] = b.w;
  };
  ld(p.mu, C.mu[0]); ld(p.mu + 512, C.mu[1]); ld(p.mu + 1024, C.mu[2]);
  ld(p.k_a, C.ka); ld(p.r_k, C.rk); ld(p.lnx_w, C.lw); ld(p.lnx_b, C.lb);
  for (int task = blockIdx.x; task < TTOK / 4; task += gridDim.x) post_task(p, task, C);
}

__device__ void phase6(const Params& p, char* smem) {
  const u16* mix = (const u16*)(p.ws + WS_B);
  const u16* wt = (const u16*)(p.ws + WS_WOUT);
  constexpr int MT = NOUT / 128, NT = 8;
  constexpr int N_CV = 0;
  const int wave = threadIdx.x >> 6, lane = threadIdx.x & 63;
  for (int task = xcd_vid(); task < MT * NT + N_CV; task += gridDim.x) {
    if (task < MT * NT) {
      int mt, nt;
      grouped_tile(task, MT, NT, mt, nt);
      int o0 = mt * 128;
      int arow = o0 + (o0 < 16384 ? 16 * (o0 / 4096 + 1) : 64);
      const float* xin = (o0 < 16384 ? p.x_prompt + (size_t)o0 * D : p.x_sample + (size_t)(o0 - 16384) * D) + nt * 128;
      float* xo = p.out + (size_t)o0 * D + nt * 128;
      u16* xb = (u16*)(p.ws + WS_X1B) + (size_t)o0 * D + nt * 128;
      float rs[4] = {0.f, 0.f, 0.f, 0.f};
      gemm_tile(mix + (size_t)arow * 1024, 1024, wt + (size_t)nt * 128 * 1024, 1024, 1024, smem,
                [&](int m, int r, int c, f32x4 v) {
                  float4 xi = *(const float4*)(xin + (size_t)r * D + c);
                  float4 xv = float4{xi.x + v[0], xi.y + v[1], xi.z + v[2], xi.w + v[3]};
                  *(float4*)(xo + (size_t)r * D + c) = xv;
                  *(uint2*)(xb + (size_t)r * D + c) = uint2{pack2bf(xv.x, xv.y), pack2bf(xv.z, xv.w)};
                  rs[m] += xv.x * xv.x + xv.y * xv.y + xv.z * xv.z + xv.w * xv.w;
                });
      {
        const int lane_ = threadIdx.x & 63, wid_ = threadIdx.x >> 6, wr_ = wid_ >> 1, wc_ = wid_ & 1;
        float* ssq = (float*)(p.ws + WS_SSQ);
#pragma unroll
        for (int m = 0; m < 4; ++m) {
          float t = rs[m];
          t += __shfl_xor(t, 16, 64);
          t += __shfl_xor(t, 32, 64);
          if ((lane_ >> 4) == 0) ssq[(size_t)(o0 + wr_ * 64 + m * 16 + (lane_ & 15)) * 16 + nt * 2 + wc_] = t;
        }
      }
    }
  }
}

__device__ void phase8(const Params& p, char* smem) {
  const u16* xb = (const u16*)(p.ws + WS_X1B);
  const u16* wt = (const u16*)(p.ws + WS_WQ);
  const float* ssq = (const float*)(p.ws + WS_SSQ);
  u16* q = (u16*)(p.ws + WS_Q);
  constexpr int MT = NOUT / 128, NT = 16, TOT = MT * NT;
  const int lane = threadIdx.x & 63, wr = (threadIdx.x >> 6) >> 1, fr = lane & 15;
  const int G = gridDim.x, full = p.full8, ntask = full + 4 * (TOT - full);
  auto row_rstd = [&](size_t row) {
    const float4* sp = (const float4*)(ssq + row * 16);
    float4 a = sp[0], b = sp[1], c = sp[2], d = sp[3];
    float ss = ((a.x + a.y) + (a.z + a.w)) + ((b.x + b.y) + (b.z + b.w)) + ((c.x + c.y) + (c.z + c.w)) + ((d.x + d.y) + (d.z + d.w));
    return rsqrtf(ss * (1.f / 1024.f) + 1e-5f);
  };
  for (int task = xcd_vid(); task < ntask; task += G) {
    int mt, nt;
    if (task < full) {
      grouped_tile(task, MT, NT, mt, nt);
      u16* crow = q + (size_t)mt * 128 * 2048 + nt * 128;
      float rstd[4];
#pragma unroll
      for (int m = 0; m < 4; ++m) rstd[m] = row_rstd((size_t)mt * 128 + wr * 64 + m * 16 + fr);
      gemm_tile(xb + (size_t)mt * 128 * D, D, wt + (size_t)nt * 128 * D, D, D, smem,
                [&](int m, int r, int c, f32x4 v) {
                  float sc = rstd[m];
                  *(uint2*)(crow + (size_t)r * 2048 + c) = uint2{pack2bf(v[0] * sc, v[1] * sc), pack2bf(v[2] * sc, v[3] * sc)};
                });
    } else {
      int rem = task - full, qd = rem & 3;
      grouped_tile(full + (rem >> 2), MT, NT, mt, nt);
      size_t r0 = (size_t)mt * 128 + qd * 32;
      u16* crow = q + r0 * 2048 + nt * 128;
      float rstd[2];
#pragma unroll
      for (int m = 0; m < 2; ++m) rstd[m] = row_rstd(r0 + m * 16 + fr);
      gemm_qtile(xb + r0 * D, D, wt + (size_t)nt * 128 * D, D, D, smem,
                 [&](int m, int r, int c, f32x4 v) {
                   float sc = rstd[m];
                   *(uint2*)(crow + (size_t)r * 2048 + c) = uint2{pack2bf(v[0] * sc, v[1] * sc), pack2bf(v[2] * sc, v[3] * sc)};
                 });
    }
  }
}

__device__ __forceinline__ unsigned ford(float f) {
  unsigned u = __float_as_uint(f);
  return (u & 0x80000000u) ? ~u : (u | 0x80000000u);
}
__device__ __forceinline__ float fdeord(unsigned k) {
  unsigned u = (k & 0x80000000u) ? (k & 0x7fffffffu) : ~k;
  return __uint_as_float(u);
}
__device__ __forceinline__ unsigned umax_(unsigned a, unsigned b) { return a > b ? a : b; }
__device__ __forceinline__ unsigned umin_(unsigned a, unsigned b) { return a < b ? a : b; }

#define CE_DESC(a, b) { unsigned _x = umax_(a, b), _y = umin_(a, b); a = _x; b = _y; }
#define CE_ASC(a, b) { unsigned _x = umin_(a, b), _y = umax_(a, b); a = _x; b = _y; }

template <int N>
__device__ __forceinline__ void bitonic_sort_desc(unsigned (&k)[N]) {
#pragma unroll
  for (int sz = 2; sz <= N; sz <<= 1) {
#pragma unroll
    for (int st = sz >> 1; st > 0; st >>= 1) {
#pragma unroll
      for (int i = 0; i < N; ++i) {
        int l = i ^ st;
        if (l > i) {
          if ((i & sz) == 0) CE_DESC(k[i], k[l]) else CE_ASC(k[i], k[l])
        }
      }
    }
  }
}
template <int N>
__device__ __forceinline__ void bitonic_merge_desc(unsigned (&k)[N]) {
#pragma unroll
  for (int st = N >> 1; st > 0; st >>= 1) {
#pragma unroll
    for (int i = 0; i < N; ++i) {
      int l = i ^ st;
      if (l > i) CE_DESC(k[i], k[l])
    }
  }
}
__device__ __forceinline__ void cross_merge16(unsigned (&k)[16]) {
#pragma unroll
  for (int x = 16; x <= 32; x <<= 1) {
    unsigned o[16];
#pragma unroll
    for (int i = 0; i < 16; ++i) o[i] = (unsigned)__shfl_xor((int)k[i], x, 64);
#pragma unroll
    for (int i = 0; i < 16; ++i) k[i] = umax_(k[i], o[15 - i]);
    bitonic_merge_desc<16>(k);
  }
}

__device__ __forceinline__ unsigned sel16(const unsigned (&a)[16], int k) {
  unsigned r = a[0];
#pragma unroll
  for (int i = 1; i < 16; ++i) r = (k == i) ? a[i] : r;
  return r;
}

__device__ void topk_unit(const Params& p, const char* smem, int tg, int h) {
  const int tid = threadIdx.x, lane = tid & 63, fr = lane & 15, fq = lane >> 4;
  const u16* q = (const u16*)(p.ws + WS_Q);
  int* idxo = (int*)(p.ws + WS_IDX);
  float* gateo = (float*)(p.ws + WS_GATE);
  const int o0 = tg * 16;
  float v1[16], v2[16];
  unsigned pk1[4] = {0u, 0u, 0u, 0u}, pk2[4] = {0u, 0u, 0u, 0u};
#pragma unroll
  for (int c = 0; c < 2; ++c) {
    bf16x8 qb[4];
#pragma unroll
    for (int ks = 0; ks < 4; ++ks)
      qb[ks] = *(const bf16x8*)(q + (size_t)(o0 + fr) * 2048 + (h * 2 + c) * 128 + ks * 32 + fq * 8);
    f32x4 acc[8];
#pragma unroll
    for (int i = 0; i < 8; ++i) acc[i] = f32x4{0.f, 0.f, 0.f, 0.f};
#pragma unroll
    for (int ks = 0; ks < 4; ++ks) {
#pragma unroll
      for (int mt = 0; mt < 8; ++mt) {
        bf16x8 ka = *(const bf16x8*)(smem + (c * 128 + mt * 16 + fr) * 256 + (((ks * 4 + fq) ^ fr) << 4));
        acc[mt] = mfma16(ka, qb[ks], acc[mt]);
      }
      __builtin_amdgcn_sched_barrier(0);
    }
    unsigned lo[16], hi[16];
#pragma unroll
    for (int mt = 0; mt < 4; ++mt)
#pragma unroll
      for (int j = 0; j < 4; ++j) {
        lo[mt * 4 + j] = (ford(acc[mt][j]) & 0xffffff80u) | (unsigned)(127 - (mt * 16 + fq * 4 + j));
        hi[mt * 4 + j] = (ford(acc[mt + 4][j]) & 0xffffff80u) | (unsigned)(127 - ((mt + 4) * 16 + fq * 4 + j));
      }
    bitonic_sort_desc<16>(lo);
    bitonic_sort_desc<16>(hi);
#pragma unroll
    for (int i = 0; i < 16; ++i) lo[i] = umax_(lo[i], hi[15 - i]);
    bitonic_merge_desc<16>(lo);
    cross_merge16(lo);
#pragma unroll
    for (int i = 0; i < 16; ++i) {
      float val = fdeord(lo[i] & 0xffffff80u);
      unsigned ix = (127u - (lo[i] & 0x7fu)) << ((i & 3) * 8);
      if (c == 0) { v1[i] = val; pk1[i >> 2] |= ix; } else { v2[i] = val; pk2[i >> 2] |= ix; }
    }
  }
  unsigned ck[16];
#define CAND(i, j) ((ford(v1[i] + v2[j]) & 0xffffff00u) | (unsigned)((i) * 16 + (j)))
#define SEL4(slot, A, B, C, Dv) ck[slot] = (fq == 0) ? (A) : (fq == 1) ? (B) : (fq == 2) ? (C) : (Dv);
  SEL4(0, CAND(0, 0), CAND(1, 0), CAND(3, 3), CAND(14, 0))
  SEL4(1, CAND(0, 1), CAND(1, 1), CAND(4, 0), CAND(15, 0))
  SEL4(2, CAND(0, 2), CAND(1, 2), CAND(4, 1), 0u)
  SEL4(3, CAND(0, 3), CAND(1, 3), CAND(4, 2), 0u)
  SEL4(4, CAND(0, 4), CAND(1, 4), CAND(5, 0), 0u)
  SEL4(5, CAND(0, 5), CAND(1, 5), CAND(5, 1), 0u)
  SEL4(6, CAND(0, 6), CAND(1, 6), CAND(6, 0), 0u)
  SEL4(7, CAND(0, 7), CAND(1, 7), CAND(6, 1), 0u)
  SEL4(8, CAND(0, 8), CAND(2, 0), CAND(7, 0), 0u)
  SEL4(9, CAND(0, 9), CAND(2, 1), CAND(7, 1), 0u)
  SEL4(10, CAND(0, 10), CAND(2, 2), CAND(8, 0), 0u)
  SEL4(11, CAND(0, 11), CAND(2, 3), CAND(9, 0), 0u)
  SEL4(12, CAND(0, 12), CAND(2, 4), CAND(10, 0), 0u)
  SEL4(13, CAND(0, 13), CAND(3, 0), CAND(11, 0), 0u)
  SEL4(14, CAND(0, 14), CAND(3, 1), CAND(12, 0), 0u)
  SEL4(15, CAND(0, 15), CAND(3, 2), CAND(13, 0), 0u)
#undef SEL4
#undef CAND
  bitonic_sort_desc<16>(ck);
  cross_merge16(ck);
  float top[16], esum = 0.f;
#pragma unroll
  for (int i = 0; i < 16; ++i) top[i] = fdeord(ck[i] & 0xffffff00u);
  const float tmax = top[0];
#pragma unroll
  for (int i = 0; i < 16; ++i) top[i] = __expf(top[i] - tmax);
#pragma unroll
  for (int i = 0; i < 16; ++i) esum += top[i];
  float inv = 1.f / esum;
  int oi[4];
  float og[4];
#pragma unroll
  for (int jj = 0; jj < 4; ++jj) {
    unsigned kk = (fq == 0) ? ck[jj] : (fq == 1) ? ck[4 + jj] : (fq == 2) ? ck[8 + jj] : ck[12 + jj];
    float tv = (fq == 0) ? top[jj] : (fq == 1) ? top[4 + jj] : (fq == 2) ? top[8 + jj] : top[12 + jj];
    int code = (int)(kk & 0xffu);
    int ci = code >> 4, cj = code & 15;
    unsigned d1 = (ci < 8) ? ((ci < 4) ? pk1[0] : pk1[1]) : ((ci < 12) ? pk1[2] : pk1[3]);
    unsigned d2 = (cj < 8) ? ((cj < 4) ? pk2[0] : pk2[1]) : ((cj < 12) ? pk2[2] : pk2[3]);
    int i1 = (int)((d1 >> ((ci & 3) * 8)) & 0xffu), i2 = (int)((d2 >> ((cj & 3) * 8)) & 0xffu);
    oi[jj] = i1 * 128 + i2;
    og[jj] = tv * inv;
  }
  size_t ob = (size_t)(o0 + fr) * 128 + h * 16 + fq * 4;
  *(int4*)(idxo + ob) = int4{oi[0], oi[1], oi[2], oi[3]};
  *(float4*)(gateo + ob) = float4{og[0], og[1], og[2], og[3]};
}

__device__ void phase9(const Params& p, char* smem) {
  const int w = threadIdx.x >> 6;
  {
    const u16* subk = (const u16*)(p.ws + WS_SUBK);
    for (int i = threadIdx.x; i < 4096; i += 256) {
      int row = i >> 4, lc = i & 15;
      *(uint4*)(smem + row * 256 + ((lc ^ (row & 15)) << 4)) = *(const uint4*)(subk + row * 128 + lc * 8);
    }
    __syncthreads();
  }
  for (int task = blockIdx.x; task < (NOUT / 16) * 2; task += gridDim.x) {
    int tg = task >> 1, h = (task & 1) * 4 + w;
    topk_unit(p, smem, tg, h);
  }
  __syncthreads();
}

#define F4(w, b) __builtin_amdgcn_cvt_scalef32_pk_f32_fp4((w), 1.0f, (b))
__device__ __forceinline__ float dot16f8(const float* h, uint2 u, float acc) {
  const float2v* h2 = (const float2v*)h;
  float2v a2 = {acc, 0.f};
  unsigned w[2] = {u.x, u.y};
#pragma unroll
  for (int i = 0; i < 2; ++i) {
    a2 = __builtin_elementwise_fma(h2[4 * i], F4(w[i], 0), a2);
    a2 = __builtin_elementwise_fma(h2[4 * i + 1], F4(w[i], 1), a2);
    a2 = __builtin_elementwise_fma(h2[4 * i + 2], F4(w[i], 2), a2);
    a2 = __builtin_elementwise_fma(h2[4 * i + 3], F4(w[i], 3), a2);
  }
  return a2.x + a2.y;
}
__device__ __forceinline__ void axpy16f8(float a, uint2 v, float* acc) {
  float2v* c2 = (float2v*)acc;
  const float2v aa = {a, a};
  unsigned w[2] = {v.x, v.y};
#pragma unroll
  for (int i = 0; i < 2; ++i) {
    c2[4 * i] = __builtin_elementwise_fma(aa, F4(w[i], 0), c2[4 * i]);
    c2[4 * i + 1] = __builtin_elementwise_fma(aa, F4(w[i], 1), c2[4 * i + 1]);
    c2[4 * i + 2] = __builtin_elementwise_fma(aa, F4(w[i], 2), c2[4 * i + 2]);
    c2[4 * i + 3] = __builtin_elementwise_fma(aa, F4(w[i], 3), c2[4 * i + 3]);
  }
}
__device__ __forceinline__ float reduce4(float d0, float d1, float d2, float d3) {
  auto s1 = __builtin_amdgcn_permlane32_swap(__float_as_uint(d0), __float_as_uint(d1), false, false);
  float s01 = __uint_as_float(s1[0]) + __uint_as_float(s1[1]);
  auto s2 = __builtin_amdgcn_permlane32_swap(__float_as_uint(d2), __float_as_uint(d3), false, false);
  float s23 = __uint_as_float(s2[0]) + __uint_as_float(s2[1]);
  auto s3 = __builtin_amdgcn_permlane16_swap(__float_as_uint(s01), __float_as_uint(s23), false, false);
  float t = __uint_as_float(s3[0]) + __uint_as_float(s3[1]);
  return red16(t);
}

__device__ void gather_task(const Params& p, int task) {
  const int wave = threadIdx.x >> 6, lane = threadIdx.x & 63;
  int o = task * 4 + wave;
  const unsigned char* eu8 = (const unsigned char*)(p.ws + WS_EU) + lane * 8;
  const unsigned char* ev8 = (const unsigned char*)(p.ws + WS_EV) + lane * 8;
  const float* scu = (const float*)(p.ws + WS_SCU);
  const float* scv = (const float*)(p.ws + WS_SCV);
  const int* idx = (const int*)(p.ws + WS_IDX) + (size_t)o * 128;
  const float* gate = (const float*)(p.ws + WS_GATE) + (size_t)o * 128;
  float* xrow = p.out + (size_t)o * D + lane * 16;
  __attribute__((aligned(8))) float hf[16];
  {
    float x[16];
#pragma unroll
    for (int i = 0; i < 4; ++i) {
      float4 a = ((const float4*)xrow)[i];
      x[4 * i] = a.x; x[4 * i + 1] = a.y; x[4 * i + 2] = a.z; x[4 * i + 3] = a.w;
    }
    float ss2 = 0.f;
#pragma unroll
    for (int i = 0; i < 16; ++i) ss2 += x[i] * x[i];
    ss2 = wave_sum(ss2);
    float sc2 = rsqrtf(ss2 * (1.f / 1024.f) + 1e-5f);
    const float* g2 = p.norm2_g + lane * 16;
#pragma unroll
    for (int i = 0; i < 4; ++i) {
      float4 gg = ((const float4*)g2)[i];
      hf[4 * i] = x[4 * i] * sc2 * gg.x; hf[4 * i + 1] = x[4 * i + 1] * sc2 * gg.y;
      hf[4 * i + 2] = x[4 * i + 2] * sc2 * gg.z; hf[4 * i + 3] = x[4 * i + 3] * sc2 * gg.w;
    }
  }
  __attribute__((aligned(8))) float acc[16];
#pragma unroll
  for (int i = 0; i < 16; ++i) acc[i] = 0.f;
  const int rw = lane >> 4;
  const int kl = (lane & 3) * 4 + ((rw == 1) ? 2 : (rw == 2) ? 1 : rw);
  const int i0 = idx[lane], i1 = idx[64 + lane];
  const float su0 = scu[i0], su1 = scu[i1];
  const float fv0 = gate[lane] * scv[i0], fv1 = gate[64 + lane] * scv[i1];
  for (int kb = 0; kb < 8; ++kb) {
    const int myidx = (kb < 4) ? i0 : i1;
    const int lb = (kb & 3) * 16;
    const float su = __shfl((kb < 4) ? su0 : su1, lb + kl, 64);
    const float fv = __shfl((kb < 4) ? fv0 : fv1, lb + kl, 64);
    float mypre = 0.f;
    uint2 va[16];
    {
      uint2 ua[16];
#pragma unroll
      for (int e = 0; e < 16; ++e) {
        int ei = __builtin_amdgcn_readlane(myidx, lb + e);
        ua[e] = *(const uint2*)(eu8 + (size_t)ei * 512);
      }
#pragma unroll
      for (int e = 0; e < 16; ++e) {
        int ei = __builtin_amdgcn_readlane(myidx, lb + e);
        va[e] = *(const uint2*)(ev8 + (size_t)ei * 512);
      }
#pragma unroll
      for (int g = 0; g < 4; ++g) {
        float d0 = dot16f8(hf, ua[4 * g], 0.f), d1 = dot16f8(hf, ua[4 * g + 1], 0.f), d2 = dot16f8(hf, ua[4 * g + 2], 0.f),
              d3 = dot16f8(hf, ua[4 * g + 3], 0.f);
        float tot = reduce4(d0, d1, d2, d3);
        mypre = ((lane & 3) == g) ? tot : mypre;
      }
    }
    mypre *= su;
    float myact = 0.5f * mypre * (1.f + erff(mypre * 0.70710678118654752f)) * fv;
#pragma unroll
    for (int e = 0; e < 16; ++e) {
      const int e3 = e & 3, e4 = e >> 2;
      const int pr = (e3 == 1) ? 2 : (e3 == 2) ? 1 : e3;
      axpy16f8(rdlane(myact, pr * 16 + e4), va[e], acc);
    }
  }
  float x[16];
#pragma unroll
  for (int i = 0; i < 4; ++i) {
    float4 a = ((const float4*)xrow)[i];
    x[4 * i] = a.x; x[4 * i + 1] = a.y; x[4 * i + 2] = a.z; x[4 * i + 3] = a.w;
  }
  float ss = 0.f;
#pragma unroll
  for (int i = 0; i < 16; ++i) { x[i] += acc[i]; ss += x[i] * x[i]; }
  ss = wave_sum(ss);
  float sc = rsqrtf(ss * (1.f / 1024.f) + 1e-5f);
  const float* g = p.final_g + lane * 16;
#pragma unroll
  for (int i = 0; i < 4; ++i) {
    float4 gg = ((const float4*)g)[i];
    ((float4*)xrow)[i] = float4{x[4 * i] * sc * gg.x, x[4 * i + 1] * sc * gg.y, x[4 * i + 2] * sc * gg.z, x[4 * i + 3] * sc * gg.w};
  }
}

__device__ void gather_task_block(const Params& p, char* smem, int o) {
  const int wave = threadIdx.x >> 6, lane = threadIdx.x & 63;
  const unsigned char* eu8 = (const unsigned char*)(p.ws + WS_EU) + lane * 8;
  const unsigned char* ev8 = (const unsigned char*)(p.ws + WS_EV) + lane * 8;
  const float* scu = (const float*)(p.ws + WS_SCU);
  const float* scv = (const float*)(p.ws + WS_SCV);
  const int* idx = (const int*)(p.ws + WS_IDX) + (size_t)o * 128;
  const float* gate = (const float*)(p.ws + WS_GATE) + (size_t)o * 128;
  float* orow = p.out + (size_t)o * D;
  __attribute__((aligned(8))) float hf[16];
  {
    const float* xrow = orow + lane * 16;
    float x[16];
#pragma unroll
    for (int i = 0; i < 4; ++i) {
      float4 a = ((const float4*)xrow)[i];
      x[4 * i] = a.x; x[4 * i + 1] = a.y; x[4 * i + 2] = a.z; x[4 * i + 3] = a.w;
    }
    float ss2 = 0.f;
#pragma unroll
    for (int i = 0; i < 16; ++i) ss2 += x[i] * x[i];
    ss2 = wave_sum(ss2);
    float sc2 = rsqrtf(ss2 * (1.f / 1024.f) + 1e-5f);
    const float* g2 = p.norm2_g + lane * 16;
#pragma unroll
    for (int i = 0; i < 4; ++i) {
      float4 gg = ((const float4*)g2)[i];
      hf[4 * i] = x[4 * i] * sc2 * gg.x; hf[4 * i + 1] = x[4 * i + 1] * sc2 * gg.y;
      hf[4 * i + 2] = x[4 * i + 2] * sc2 * gg.z; hf[4 * i + 3] = x[4 * i + 3] * sc2 * gg.w;
    }
  }
  __attribute__((aligned(8))) float acc[16];
#pragma unroll
  for (int i = 0; i < 16; ++i) acc[i] = 0.f;
  const int rw = lane >> 4;
  const int kl = (lane & 3) * 4 + ((rw == 1) ? 2 : (rw == 2) ? 1 : rw);
#pragma unroll
  for (int kq = 0; kq < 2; ++kq) {
    const int kb = wave * 2 + kq;
    int myidx = idx[kb * 16 + (lane & 15)];
    int myidx2 = idx[kb * 16 + kl];
    float mygate = gate[kb * 16 + kl];
    float su = scu[myidx2], sv = scv[myidx2];
    float mypre = 0.f;
#pragma unroll
    for (int e8 = 0; e8 < 2; ++e8) {
      uint2 ua[8];
#pragma unroll
      for (int e = 0; e < 8; ++e) {
        int ei = __builtin_amdgcn_readlane(myidx, e8 * 8 + e);
        ua[e] = *(const uint2*)(eu8 + (size_t)ei * 512);
      }
      float d[8];
#pragma unroll
      for (int e = 0; e < 8; ++e) d[e] = dot16f8(hf, ua[e], 0.f);
      float tot0 = reduce4(d[0], d[1], d[2], d[3]);
      float tot1 = reduce4(d[4], d[5], d[6], d[7]);
      mypre = ((lane & 3) == e8 * 2) ? tot0 : mypre;
      mypre = ((lane & 3) == e8 * 2 + 1) ? tot1 : mypre;
    }
    mypre *= su;
    float myact = 0.5f * mypre * (1.f + erff(mypre * 0.70710678118654752f)) * mygate * sv;
#pragma unroll
    for (int e8 = 0; e8 < 2; ++e8) {
      uint2 va[8];
      float a[8];
#pragma unroll
      for (int e = 0; e < 8; ++e) {
        int ei = __builtin_amdgcn_readlane(myidx, e8 * 8 + e);
        const int e3 = e & 3, e4 = e8 * 2 + (e >> 2);
        const int pr = (e3 == 1) ? 2 : (e3 == 2) ? 1 : e3;
        a[e] = rdlane(myact, pr * 16 + e4);
        va[e] = *(const uint2*)(ev8 + (size_t)ei * 512);
      }
#pragma unroll
      for (int e = 0; e < 8; ++e) axpy16f8(a[e], va[e], acc);
    }
  }
  float* part = (float*)smem;
  float* red = part + 4096;
#pragma unroll
  for (int i = 0; i < 4; ++i)
    *(float4*)(part + wave * 1024 + lane * 16 + 4 * i) = float4{acc[4 * i], acc[4 * i + 1], acc[4 * i + 2], acc[4 * i + 3]};
  __syncthreads();
  const int c = threadIdx.x * 4;
  float4 xv = *(const float4*)(orow + c);
#pragma unroll
  for (int k = 0; k < 4; ++k) {
    float4 pv = *(const float4*)(part + k * 1024 + c);
    xv.x += pv.x; xv.y += pv.y; xv.z += pv.z; xv.w += pv.w;
  }
  float ss = wave_sum(xv.x * xv.x + xv.y * xv.y + xv.z * xv.z + xv.w * xv.w);
  if (lane == 0) red[wave] = ss;
  __syncthreads();
  ss = (red[0] + red[1]) + (red[2] + red[3]);
  float sc = rsqrtf(ss * (1.f / 1024.f) + 1e-5f);
  float4 gg = *(const float4*)(p.final_g + c);
  *(float4*)(orow + c) = float4{xv.x * sc * gg.x, xv.y * sc * gg.y, xv.z * sc * gg.z, xv.w * sc * gg.w};
  __syncthreads();
}

__device__ void phase10(const Params& p, char* smem) {
  const int G = gridDim.x, full = p.full10;
  for (int task = blockIdx.x; task < full; task += G) gather_task(p, task);
  for (int o = full * 4 + blockIdx.x; o < NOUT; o += G) gather_task_block(p, smem, o);
}

#define XB_TMO      128
#define XB_XCNT(j)  (256  + 64 * (j))
#define XB_XSUB(j)  (1280 + 64 * (j))
#define XB_XGEN(j)  (2304 + 64 * (j))
#define XB_TOP      3328
#define XB_TOPGEN   3392
#define XCD_BAR_WORDS 3456
#define XB_SPIN_CAP (1u << 20)
__device__ __forceinline__ unsigned xb_ld(unsigned* p) { return __hip_atomic_load(p, __ATOMIC_RELAXED, __HIP_MEMORY_SCOPE_AGENT); }
__device__ __forceinline__ unsigned xb_add(unsigned* p, unsigned v) { return __hip_atomic_fetch_add(p, v, __ATOMIC_RELAXED, __HIP_MEMORY_SCOPE_AGENT); }
__device__ __forceinline__ unsigned xb_xcc_id() { return (unsigned)__builtin_amdgcn_s_getreg((3 << 11) | 20) & 0xFu; }
#define XB_SPIN(cond, bar) do { unsigned _sp = 0; while (cond) { __builtin_amdgcn_s_sleep(1); \
    if ((++_sp & 255u) == 0u) { if (xb_ld(&(bar)[XB_TMO])) break; if (_sp > XB_SPIN_CAP) { atomicAdd(&(bar)[XB_TMO], 1u); break; } } } } while (0)

struct GridBar { int dummy; };

__device__ __forceinline__ GridBar gb_init(unsigned* bar) {
  GridBar b;
  b.dummy = 0;
  if (threadIdx.x == 0) (void)xb_add(&bar[XB_XCNT(xb_xcc_id())], 1u);
  return b;
}
__device__ __forceinline__ void gb_census(unsigned* bar, unsigned x, unsigned& nloc, unsigned& nx) {
  const unsigned G = gridDim.x;
  unsigned sum, cnt, mine, sp = 0u;
  for (;;) {
    sum = 0u; cnt = 0u; mine = 0u;
#pragma unroll
    for (unsigned j = 0; j < 16; ++j) {
      const unsigned c = xb_ld(&bar[XB_XCNT(j)]);
      sum += c; cnt += (c > 0u) ? 1u : 0u; mine = (j == x) ? c : mine;
    }
    if (sum == G) break;
    __builtin_amdgcn_s_sleep(1);
    if ((++sp & 255u) == 0u) { if (xb_ld(&bar[XB_TMO])) break; if (sp > XB_SPIN_CAP) { atomicAdd(&bar[XB_TMO], 1u); break; } }
  }
  nloc = mine > 0u ? mine : 1u; nx = cnt > 0u ? cnt : 1u;
}
template <bool FIRST>
__device__ __forceinline__ void gb_sync(GridBar& b, unsigned* bar) {
  asm volatile("s_waitcnt vmcnt(0)" ::: "memory");
  __syncthreads();
  if (threadIdx.x == 0) {
    const unsigned x = xb_xcc_id();
    __builtin_amdgcn_s_waitcnt(0);
    unsigned* slot = bar + 4096 + 2 * blockIdx.x;
    unsigned nloc, nx;
    if (FIRST) { gb_census(bar, x, nloc, nx); slot[0] = nloc; slot[1] = nx; }
    else { nloc = __hip_atomic_load(&slot[0], __ATOMIC_RELAXED, __HIP_MEMORY_SCOPE_AGENT); nx = __hip_atomic_load(&slot[1], __ATOMIC_RELAXED, __HIP_MEMORY_SCOPE_AGENT); }
    const unsigned old = xb_add(&bar[XB_XSUB(x)], 1u);
    const unsigned gen = old / nloc;
    if (old + 1u == (gen + 1u) * nloc) {
      __builtin_amdgcn_fence(__ATOMIC_RELEASE, "agent");
      asm volatile("s_waitcnt vmcnt(0)" ::: "memory");
      const unsigned og = xb_add(&bar[XB_TOP], 1u);
      const unsigned tg = og / nx;
      if (og + 1u == (tg + 1u) * nx) xb_add(&bar[XB_TOPGEN], 1u);
      else XB_SPIN(xb_ld(&bar[XB_TOPGEN]) == tg, bar);
      __builtin_amdgcn_fence(__ATOMIC_ACQUIRE, "agent");
      xb_add(&bar[XB_XGEN(x)], 1u);
      asm volatile("s_waitcnt vmcnt(0)" ::: "memory");
    } else {
      XB_SPIN(xb_ld(&bar[XB_XGEN(x)]) == gen, bar);
      __builtin_amdgcn_fence(__ATOMIC_ACQUIRE, "agent");
      asm volatile("s_waitcnt vmcnt(0)" ::: "memory");
    }
  }
  __syncthreads();
}

template <int PH>
__device__ __forceinline__ void run_phase(const Params& p, char* smem) {
  if constexpr (PH == 0) phase0(p, smem);
  if constexpr (PH == 1) phase1(p, smem);
  if constexpr (PH == 2) phase2(p);
  if constexpr (PH == 3) phase3(p, smem);
  if constexpr (PH == 4) phase4(p, smem);
  if constexpr (PH == 5) phase5(p);
  if constexpr (PH == 6) phase6(p, smem);
  if constexpr (PH == 8) phase8(p, smem);
  if constexpr (PH == 9) phase9(p, smem);
  if constexpr (PH == 10) phase10(p, smem);
}

template <int LO, int HI>
__device__ __forceinline__ void run_range(const Params& p, char* smem, GridBar& gb) {
  if constexpr (LO < HI) {
    run_phase<LO>(p, smem);
    if constexpr (LO + 1 < HI) {
      if constexpr (LO != 7) gb_sync<LO == 0>(gb, (unsigned*)(p.ws + WS_BAR));
      run_range<LO + 1, HI>(p, smem, gb);
    }
  }
}

template <int LO, int HI>
__global__ void __launch_bounds__(256, 2) fwd_kernel(Params p) {
  __shared__ __attribute__((aligned(16))) char smem[SMEM_BYTES];
  if (p.ws == nullptr) cg::this_grid().sync();
  GridBar gb = gb_init((unsigned*)(p.ws + WS_BAR));
  run_range<LO, HI>(p, smem, gb);
}

template <int PH>
static void launch_one(const Params& p, int grid, hipStream_t stream) {
  fwd_kernel<PH, PH + 1><<<grid, 256, 0, stream>>>(p);
}

extern "C" void kernel_launch(void* const* d_in, const int* in_sizes, int n_in, void* d_out, int out_size, void* d_ws,
                              size_t ws_size, hipStream_t stream) {
  Params p{};
  const float** pp = (const float**)&p;
  for (int i = 0; i < 28; ++i) pp[i] = (const float*)d_in[i];
  p.out = (float*)d_out;
  p.ws = (char*)d_ws;
#if MULTI_LAUNCH
  const int grid = 1024;
  p.full1 = ((MROWS / 128) * 20 / grid) * grid; p.full8 = ((NOUT / 128) * 16 / grid) * grid; p.full10 = ((NOUT / 4) / grid) * grid; p.pad_ = 0;
  launch_one<0>(p, grid, stream);
  launch_one<1>(p, grid, stream);
  launch_one<2>(p, grid, stream);
  launch_one<3>(p, grid, stream);
  launch_one<4>(p, grid, stream);
  launch_one<5>(p, grid, stream);
  launch_one<6>(p, grid, stream);
  launch_one<7>(p, grid, stream);
  launch_one<8>(p, grid, stream);
  launch_one<9>(p, grid, stream);
  launch_one<10>(p, grid, stream);
#else
  static int grid_blocks = 0;
  if (!grid_blocks) {
    int dev = 0, cus = 0, per_cu = 0;
    (void)hipGetDevice(&dev);
    (void)hipDeviceGetAttribute(&cus, hipDeviceAttributeMultiprocessorCount, dev);
    (void)hipOccupancyMaxActiveBlocksPerMultiprocessor(&per_cu, fwd_kernel<0, NPH>, 256, 0);
    if (per_cu < 1) per_cu = 1;
    if (per_cu > 4) per_cu = 4;
    grid_blocks = cus * per_cu;
  }
  (void)hipMemsetAsync((char*)d_ws + WS_BAR, 0, XCD_BAR_WORDS * sizeof(unsigned), stream);
  p.full1 = ((MROWS / 128) * 20 / grid_blocks) * grid_blocks;
  p.full8 = ((NOUT / 128) * 16 / grid_blocks) * grid_blocks;
  p.full10 = ((NOUT / 4) / grid_blocks) * grid_blocks;
  p.pad_ = 0;
  void* args[] = {&p};
  hipError_t e = hipLaunchCooperativeKernel((void*)fwd_kernel<0, NPH>, dim3(grid_blocks), dim3(256), args, 0, stream);
  if (e != hipSuccess) fprintf(stderr, "cooperative launch failed: %s (grid %d)\n", hipGetErrorString(e), grid_blocks);
#endif
}
```
